# Optimizing an MI355X kernel written in HIP

```python
import math
import jax
import jax.numpy as jnp
from jax import lax
import numpy as np

D_MODEL = 1024
BATCH = 8
SEQ = 8192
DEPTH = 4

HEAD_DIM = 64
MIX_WIDTH = D_MODEL
WIDTH_A = MIX_WIDTH // 4
N_HEADS_A = WIDTH_A // HEAD_DIM
DILATED_PAIRS = ((128, 1), (512, 4), (2048, 16))
WIDTH_B = MIX_WIDTH // 4
N_HEADS_B = WIDTH_B // HEAD_DIM
N_KV_B = 2
GROUP_B = N_HEADS_B // N_KV_B
SWA_HALF = 128
WIDTH_C = MIX_WIDTH // 2
DIFF_DIM = HEAD_DIM
N_HEADS_C = WIDTH_C // (2 * DIFF_DIM)
Q_BLOCK = 128
IN_WIDTH = 3 * WIDTH_A + WIDTH_B + 2 * N_KV_B * HEAD_DIM + 3 * WIDTH_C
N_EXPERTS = 32
TOP_K = 4
D_EXPERT = D_MODEL
SWIGLU_LIMIT = 7.0
SWIGLU_ALPHA = 1.702
MOE_BLOCK = 256
N_MOD = 6
RMS_EPS = 1e-6

kernel_name = "hybrid_dilated_swa_diff_moe_encoder"


def rmsnorm(x, g):
    xf = x.astype(jnp.float32)
    y = xf * lax.rsqrt(jnp.mean(xf * xf, axis=-1, keepdims=True) + RMS_EPS)
    return (y * g.astype(jnp.float32)).astype(x.dtype)


def alibi_slopes(n):
    return jnp.exp2(-8.0 * jnp.arange(1, n + 1, dtype=jnp.float32) / n)


def split_points():
    sizes = [WIDTH_A, WIDTH_A, WIDTH_A, WIDTH_B, N_KV_B * HEAD_DIM, N_KV_B * HEAD_DIM,
             WIDTH_C, WIDTH_C, WIDTH_C]
    return [int(v) for v in np.cumsum(sizes)[:-1]]


def banded_attention(q, k, v, half_w, slopes, step, sink=None):
    n, L, hk, g, dk = q.shape
    dv = v.shape[-1]
    blk = half_w
    nb = -(-L // blk)
    lp = nb * blk
    qf = jnp.pad(q.astype(jnp.float32), ((0, 0), (0, lp - L), (0, 0), (0, 0), (0, 0)))
    qf = qf.reshape(n, nb, blk, hk, g, dk)
    pad_kv = ((0, 0), (blk, lp - L + blk), (0, 0), (0, 0))
    kp = jnp.pad(k.astype(jnp.float32), pad_kv)
    vp = jnp.pad(v.astype(jnp.float32), pad_kv)

    def neighbourhood(t):
        return jnp.concatenate(
            [t[:, j * blk: j * blk + lp].reshape(n, nb, blk, hk, t.shape[-1]) for j in range(3)], axis=2)

    kn = neighbourhood(kp)
    vn = neighbourhood(vp)
    s = jnp.einsum("nbqhgd,nbkhd->nbhgqk", qf, kn) * (dk ** -0.5)
    rel = jnp.arange(3 * blk)[None, :] - blk - jnp.arange(blk)[:, None]
    key_pos = (jnp.arange(nb) * blk - blk)[:, None, None] + jnp.arange(3 * blk)[None, None, :]
    valid = (jnp.abs(rel) <= half_w)[None] & (key_pos >= 0) & (key_pos < L)
    dist = (step * jnp.abs(rel)).astype(jnp.float32)
    s = s - slopes.astype(jnp.float32)[:, :, None, None] * dist
    s = jnp.where(valid[None, :, None, None], s, -jnp.inf)
    m = jnp.max(s, axis=-1)
    if sink is not None:
        m = jnp.maximum(m, sink[:, :, None])
    p = jnp.exp(s - m[..., None])
    l = jnp.sum(p, axis=-1)
    if sink is not None:
        l = l + jnp.exp(sink[:, :, None] - m)
    o = jnp.einsum("nbhgqk,nbkhe->nbqhge", p, vn) / jnp.moveaxis(l, -1, 2)[..., None]
    o = o.reshape(n, lp, hk, g, dv)[:, :L]
    m = jnp.moveaxis(m, -1, 2).reshape(n, lp, hk, g)[:, :L]
    l = jnp.moveaxis(l, -1, 2).reshape(n, lp, hk, g)[:, :L]
    return o, m, l


def dilated_attention(q, k, v, slopes):
    b, s, h, dh = q.shape
    outs, maxes, denoms = [], [], []
    for window, dil in DILATED_PAIRS:
        L = s // dil

        def to_res(t):
            return t.reshape(b, L, dil, h, t.shape[-1]).transpose(0, 2, 1, 3, 4).reshape(b * dil, L, h, t.shape[-1])

        def from_res(t):
            t = t.reshape((b, dil, L) + t.shape[2:])
            return jnp.swapaxes(t, 1, 2).reshape((b, s) + t.shape[3:])

        o, m, l = banded_attention(to_res(q)[:, :, :, None, :], to_res(k), to_res(v),
                                   window // (2 * dil), slopes[:, None], dil)
        outs.append(from_res(o[:, :, :, 0]))
        maxes.append(from_res(m[..., 0]))
        denoms.append(from_res(l[..., 0]))
    m_all = jnp.stack(maxes)
    l_all = jnp.stack(denoms)
    o_all = jnp.stack(outs)
    w = l_all * jnp.exp(m_all - jnp.max(m_all, axis=0))
    return jnp.sum(w[..., None] * o_all, axis=0) / jnp.sum(w, axis=0)[..., None]


def diff_attention(q, k, v, lam, slopes):
    b, s, h, _, dk = q.shape
    dv = v.shape[-1]
    nq = s // Q_BLOCK
    qf = q.astype(jnp.float32).reshape(b, nq, Q_BLOCK, h, 2, dk).transpose(1, 0, 2, 3, 4, 5)
    kf = k.astype(jnp.float32)
    vf = v.astype(jnp.float32)
    key_pos = jnp.arange(s)

    def block(args):
        qb, start = args
        sc = jnp.einsum("bqhcd,bkhcd->bhcqk", qb, kf) * (dk ** -0.5)
        dist = jnp.abs(start + jnp.arange(Q_BLOCK)[:, None] - key_pos[None, :]).astype(jnp.float32)
        sc = sc - slopes[:, None, None, None] * dist
        p = jax.nn.softmax(sc, axis=-1)
        a = p[:, :, 0] - lam * p[:, :, 1]
        return jnp.einsum("bhqk,bkhe->bqhe", a, vf)

    o = lax.map(block, (qf, jnp.arange(nq) * Q_BLOCK))
    return o.transpose(1, 0, 2, 3, 4).reshape(b, s, h, dv)


def moe_ffn(h, w_router, b_router, w_gate, b_gate, w_up, b_up, w_down, b_down):
    bsz, s, d = h.shape
    t = bsz * s
    tk = t * TOP_K
    ht = h.reshape(t, d)
    logits = (ht @ w_router + b_router).astype(jnp.float32)
    top_val, top_idx = lax.top_k(logits, TOP_K)
    gates = jax.nn.softmax(top_val, axis=-1)
    flat_e = top_idx.reshape(-1).astype(jnp.int32)
    flat_tok = jnp.repeat(jnp.arange(t, dtype=jnp.int32), TOP_K)
    flat_g = gates.reshape(-1)
    order = jnp.argsort(flat_e)
    se, st, sg = flat_e[order], flat_tok[order], flat_g[order]
    counts = jnp.zeros((N_EXPERTS,), jnp.int32).at[flat_e].add(1)
    padded = (counts + MOE_BLOCK - 1) // MOE_BLOCK * MOE_BLOCK
    pad_end = jnp.cumsum(padded)
    pad_start = pad_end - padded
    start = jnp.cumsum(counts) - counts
    dest = pad_start[se] + (jnp.arange(tk, dtype=jnp.int32) - start[se])
    nb = -(-tk // MOE_BLOCK) + N_EXPERTS
    row_tok = jnp.full((nb * MOE_BLOCK,), t, jnp.int32).at[dest].set(st)
    row_g = jnp.zeros((nb * MOE_BLOCK,), jnp.float32).at[dest].set(sg)
    blk_e = jnp.minimum(jnp.searchsorted(pad_end, jnp.arange(nb) * MOE_BLOCK, side="right"),
                        N_EXPERTS - 1)
    ht_pad = jnp.concatenate([ht, jnp.zeros((1, d), ht.dtype)], axis=0)

    def step(y, inp):
        rows, g, e = inp
        xb = ht_pad[rows]
        a = xb @ w_gate[e] + b_gate[e]
        u = xb @ w_up[e] + b_up[e]
        a = jnp.minimum(a, SWIGLU_LIMIT)
        u = jnp.clip(u, -SWIGLU_LIMIT, SWIGLU_LIMIT)
        hid = a * jax.nn.sigmoid(SWIGLU_ALPHA * a) * (u + 1.0)
        out = (hid @ w_down[e] + b_down[e]) * g[:, None].astype(hid.dtype)
        return y.at[rows].add(out.astype(y.dtype)), None

    y0 = jnp.zeros((t + 1, d), h.dtype)
    y, _ = lax.scan(step, y0, (row_tok.reshape(nb, MOE_BLOCK), row_g.reshape(nb, MOE_BLOCK), blk_e))
    return y[:t].reshape(bsz, s, d)


def setup_inputs(seed: int = 0) -> dict:
    key = jax.random.key(seed)
    ks = jax.random.split(key, 24)
    nrm = jax.random.normal
    f32 = jnp.float32
    d, e, f = D_MODEL, N_EXPERTS, D_EXPERT
    return {
        "x": nrm(ks[0], (BATCH, SEQ, d), f32),
        "c": nrm(ks[1], (BATCH, d), f32),
        "w_ada": nrm(ks[2], (DEPTH, d, N_MOD * d), f32) * (0.5 * d ** -0.5),
        "b_ada": nrm(ks[3], (DEPTH, N_MOD * d), f32) * 0.01,
        "norm1": 1.0 + 0.01 * nrm(ks[4], (DEPTH, d), f32),
        "w_in": nrm(ks[5], (DEPTH, d, IN_WIDTH), f32) * d ** -0.5,
        "sinks": nrm(ks[6], (DEPTH, N_HEADS_B), f32),
        "lambda_q1": nrm(ks[7], (DEPTH, DIFF_DIM), f32) * 0.1,
        "lambda_k1": nrm(ks[8], (DEPTH, DIFF_DIM), f32) * 0.1,
        "lambda_q2": nrm(ks[9], (DEPTH, DIFF_DIM), f32) * 0.1,
        "lambda_k2": nrm(ks[10], (DEPTH, DIFF_DIM), f32) * 0.1,
        "subln": 1.0 + 0.01 * nrm(ks[11], (DEPTH, 2 * DIFF_DIM), f32),
        "w_out": nrm(ks[12], (DEPTH, MIX_WIDTH, d), f32) * MIX_WIDTH ** -0.5,
        "norm2": 1.0 + 0.01 * nrm(ks[13], (DEPTH, d), f32),
        "w_router": nrm(ks[14], (DEPTH, d, e), f32) * d ** -0.5,
        "b_router": nrm(ks[15], (DEPTH, e), f32) * 0.01,
        "w_gate": nrm(ks[16], (DEPTH, e, d, f), f32) * d ** -0.5,
        "b_gate": nrm(ks[17], (DEPTH, e, f), f32) * 0.01,
        "w_up": nrm(ks[18], (DEPTH, e, d, f), f32) * d ** -0.5,
        "b_up": nrm(ks[19], (DEPTH, e, f), f32) * 0.01,
        "w_down": nrm(ks[20], (DEPTH, e, f, d), f32) * f ** -0.5,
        "b_down": nrm(ks[21], (DEPTH, e, d), f32) * 0.01,
        "norm_f": 1.0 + 0.01 * nrm(ks[22], (d,), f32),
    }


def reference(x, c, w_ada, b_ada, norm1, w_in, sinks, lambda_q1, lambda_k1, lambda_q2, lambda_k2,
              subln, w_out, norm2, w_router, b_router, w_gate, b_gate, w_up, b_up, w_down, b_down,
              norm_f):
    b, s, _ = x.shape
    slopes_a = alibi_slopes(N_HEADS_A)
    slopes_b = alibi_slopes(N_HEADS_B).reshape(N_KV_B, GROUP_B)
    slopes_c = alibi_slopes(N_HEADS_C)
    cond = jax.nn.silu(c)
    cuts = split_points()
    for layer in range(DEPTH):
        mod = (cond @ w_ada[layer] + b_ada[layer])[:, None, :]
        sh1, sc1, g1, sh2, sc2, g2 = jnp.split(mod, N_MOD, axis=-1)

        h = rmsnorm(x, norm1[layer]) * (1.0 + sc1) + sh1
        proj = h @ w_in[layer]
        qa, ka, va, qb, kb, vb, qc, kc, vc = jnp.split(proj, cuts, axis=-1)

        o_a = dilated_attention(qa.reshape(b, s, N_HEADS_A, HEAD_DIM), ka.reshape(b, s, N_HEADS_A, HEAD_DIM),
                                va.reshape(b, s, N_HEADS_A, HEAD_DIM), slopes_a)

        o_b, _, _ = banded_attention(qb.reshape(b, s, N_KV_B, GROUP_B, HEAD_DIM),
                                     kb.reshape(b, s, N_KV_B, HEAD_DIM), vb.reshape(b, s, N_KV_B, HEAD_DIM),
                                     SWA_HALF, slopes_b, 1,
                                     sinks[layer].astype(jnp.float32).reshape(N_KV_B, GROUP_B))

        lam_init = 0.8 - 0.6 * math.exp(-0.3 * layer)
        lam = (jnp.exp(jnp.sum(lambda_q1[layer].astype(jnp.float32) * lambda_k1[layer].astype(jnp.float32)))
               - jnp.exp(jnp.sum(lambda_q2[layer].astype(jnp.float32) * lambda_k2[layer].astype(jnp.float32)))
               + lam_init)
        o_c = diff_attention(qc.reshape(b, s, N_HEADS_C, 2, DIFF_DIM), kc.reshape(b, s, N_HEADS_C, 2, DIFF_DIM),
                             vc.reshape(b, s, N_HEADS_C, 2 * DIFF_DIM), lam, slopes_c)
        o_c = rmsnorm(o_c, subln[layer]) * (1.0 - lam_init)

        mixed = jnp.concatenate([o_a.reshape(b, s, WIDTH_A), o_b.reshape(b, s, WIDTH_B),
                                 o_c.reshape(b, s, WIDTH_C)], axis=-1).astype(x.dtype)
        x = x + g1 * (mixed @ w_out[layer])

        h = rmsnorm(x, norm2[layer]) * (1.0 + sc2) + sh2
        x = x + g2 * moe_ffn(h, w_router[layer], b_router[layer], w_gate[layer], b_gate[layer],
                             w_up[layer], b_up[layer], w_down[layer], b_down[layer])
    return rmsnorm(x, norm_f)
```

```cpp
#include <hip/hip_runtime.h>
#include <cstdio>
#include <cstdint>

#define LAS __attribute__((address_space(3)))
#define GAS __attribute__((address_space(1)))
typedef unsigned short bf16_t;
typedef short bf16x8 __attribute__((ext_vector_type(8)));
typedef short s16x4 __attribute__((ext_vector_type(4)));
typedef float f32x4 __attribute__((ext_vector_type(4)));
typedef float f32x2 __attribute__((ext_vector_type(2)));
typedef float f32x16 __attribute__((ext_vector_type(16)));
typedef unsigned u32x4 __attribute__((ext_vector_type(4)));
typedef unsigned u32x2 __attribute__((ext_vector_type(2)));
typedef GAS unsigned gu32;

constexpr int NBATCH = 8, SEQ = 8192, DM = 1024, NTOK = NBATCH * SEQ, DEPTH = 4;
constexpr int INW = 2816;
constexpr int C_QA = 0, C_KA = 256, C_VA = 512, C_QB = 768, C_KB = 1024, C_VB = 1152, C_QC = 1280, C_KC = 1792, C_VC = 2304;
constexpr int NE = 32, TOPK = 4, LCAP = NTOK;
constexpr float RMS_EPS = 1e-6f;
constexpr float LOG2E = 1.4426950408889634f;
constexpr float QSCALE = 0.125f * LOG2E;
constexpr int NWAVES = 8, NTHREADS = 512;
#ifndef C_TILE_SKIP
#define C_TILE_SKIP 1
#endif
constexpr int CW_NRM = 16384;

constexpr size_t MiB = 1u << 20;
constexpr size_t WS_CTL = 0, CTL_ZERO_BYTES = 1 * MiB;
constexpr size_t WS_MODP = 1 * MiB;
constexpr size_t WS_MOD = 4 * MiB;
constexpr size_t WS_LTOK = 5 * MiB;
constexpr size_t WS_LG = 13 * MiB;
constexpr size_t WS_WIN = 21 * MiB;
constexpr size_t WS_WOUT = 43 * MiB;
constexpr size_t WS_WGU = 51 * MiB;
constexpr size_t WS_WDN = 563 * MiB;
constexpr size_t WS_H = 819 * MiB;
constexpr size_t WS_R1 = 947 * MiB;
constexpr size_t WS_MIXED = WS_R1 + 352 * MiB;
constexpr size_t WS_Y = 1475 * MiB;
constexpr size_t WS_INV = WS_MODP;
constexpr size_t WS_XB = WS_Y + 264 * MiB;
constexpr size_t WS_PART = WS_XB + 128 * MiB;
constexpr size_t WS_END = 1987 * MiB;
static_assert(WS_PART + (size_t)NTOK * 4 * 68 * 4 <= WS_END, "d_ws map");
constexpr int CW_TMO = 0, CW_CODE = 1, CW_BAR = 4096, CW_CNT = 8192;

constexpr int RING_BYTES = 131072;
constexpr int BAND_WL = 16896;
constexpr int MISC_OFF = 8 * BAND_WL;
constexpr int LDS_BYTES = MISC_OFF + 16384;
constexpr int MO_BAR = 0, MO_HIST = 64, MO_BASE = 192, MO_TAB = 320, MO_SELE = 1024, MO_SELG = 5120;

#define RLX_AGENT __ATOMIC_RELAXED, __HIP_MEMORY_SCOPE_AGENT
#define LDS_WAIT() asm volatile("s_waitcnt lgkmcnt(0)" ::: "memory")
#define VM_WAIT() asm volatile("s_waitcnt vmcnt(0)" ::: "memory")
__device__ __forceinline__ unsigned cvt_pk_bf16(float lo, float hi) { unsigned r; asm volatile("v_cvt_pk_bf16_f32 %0, %1, %2" : "=v"(r) : "v"(lo), "v"(hi)); return r; }
__device__ __forceinline__ unsigned f2bf(float f) { unsigned u = __builtin_bit_cast(unsigned, f); return (u + 0x7fffu + ((u >> 16) & 1u)) >> 16; }
__device__ __forceinline__ unsigned pk2(float lo, float hi) { return f2bf(lo) | (f2bf(hi) << 16); }
typedef int i32x8 __attribute__((ext_vector_type(8)));
typedef int i32x4 __attribute__((ext_vector_type(4)));
__device__ __forceinline__ unsigned pk4_fp8_nc(float a, float b, float c, float d) {
    unsigned w = 0u; w = (unsigned)__builtin_amdgcn_cvt_pk_fp8_f32(a, b, (int)w, false); w = (unsigned)__builtin_amdgcn_cvt_pk_fp8_f32(c, d, (int)w, true); return w;
}
__device__ __forceinline__ unsigned pk4_fp8(float a, float b, float c, float d) {
    a = fminf(fmaxf(a, -448.f), 448.f); b = fminf(fmaxf(b, -448.f), 448.f); c = fminf(fmaxf(c, -448.f), 448.f); d = fminf(fmaxf(d, -448.f), 448.f);
    unsigned w = 0u; w = (unsigned)__builtin_amdgcn_cvt_pk_fp8_f32(a, b, (int)w, false); w = (unsigned)__builtin_amdgcn_cvt_pk_fp8_f32(c, d, (int)w, true); return w;
}
constexpr float W8_SCALE = 64.f, H8_SCALE = 8.f, HID8_SCALE = 4.f, Y8_SCALE = 64.f;
__device__ __forceinline__ float bf_lo(unsigned u) { return __builtin_bit_cast(float, u << 16); }
__device__ __forceinline__ float bf_hi(unsigned u) { return __builtin_bit_cast(float, u & 0xffff0000u); }
__device__ __forceinline__ int lane_id() { unsigned ones = ~0u; asm volatile("" : "+s"(ones)); return (int)__builtin_amdgcn_mbcnt_hi(ones, __builtin_amdgcn_mbcnt_lo(ones, 0u)); }
template <int CTRL> __device__ __forceinline__ float dpp_mov(float v) { return __builtin_bit_cast(float, __builtin_amdgcn_update_dpp(0, __builtin_bit_cast(int, v), CTRL, 0xf, 0xf, true)); }
__device__ __forceinline__ float row16_sum(float v) { v += dpp_mov<0xB1>(v); v += dpp_mov<0x4E>(v); v += dpp_mov<0x141>(v); v += dpp_mov<0x140>(v); return v; }
__device__ __forceinline__ float row16_max(float v) { v = fmaxf(v, dpp_mov<0xB1>(v)); v = fmaxf(v, dpp_mov<0x4E>(v)); v = fmaxf(v, dpp_mov<0x141>(v)); v = fmaxf(v, dpp_mov<0x140>(v)); return v; }
__device__ __forceinline__ float x16_sum(float v) { const auto r = __builtin_amdgcn_permlane16_swap(__float_as_uint(v), __float_as_uint(v), false, false); return __uint_as_float(r[0]) + __uint_as_float(r[1]); }
__device__ __forceinline__ float x32_sum(float v) { const auto r = __builtin_amdgcn_permlane32_swap(__float_as_uint(v), __float_as_uint(v), false, false); return __uint_as_float(r[0]) + __uint_as_float(r[1]); }
__device__ __forceinline__ float wave_sum(float v) { return x32_sum(x16_sum(row16_sum(v))); }

#define XB_TMO      128
#define XB_XCNT(j)  (256  + 64 * (j))
#define XB_XSUB(j)  (1280 + 64 * (j))
#define XB_XGEN(j)  (2304 + 64 * (j))
#define XB_TOP      3328
#define XB_TOPGEN   3392
#define XCD_BAR_WORDS 3456
#define XB_SPIN_CAP (1u << 20)

__device__ __forceinline__ unsigned xb_ld(unsigned* p)              { return __hip_atomic_load(p, __ATOMIC_RELAXED, __HIP_MEMORY_SCOPE_AGENT); }
__device__ __forceinline__ unsigned xb_add(unsigned* p, unsigned v) { return __hip_atomic_fetch_add(p, v, __ATOMIC_RELAXED, __HIP_MEMORY_SCOPE_AGENT); }
__device__ __forceinline__ unsigned xb_xcc_id() { return (unsigned)__builtin_amdgcn_s_getreg((3 << 11) | 20) & 0xFu; }
#define XB_SPIN(cond, bar) do { unsigned _sp = 0; while (cond) { __builtin_amdgcn_s_sleep(1); \
    if ((++_sp & 255u) == 0u) { if (xb_ld(&(bar)[XB_TMO])) break; if (_sp > XB_SPIN_CAP) { atomicAdd(&(bar)[XB_TMO], 1u); break; } } } } while (0)

struct XcdBarrier { unsigned* bar; unsigned x; volatile LAS unsigned* st; };
__device__ __forceinline__ XcdBarrier xcd_barrier_post(unsigned* bar, volatile LAS unsigned* st) {
    XcdBarrier b; b.bar = bar; b.x = xb_xcc_id(); b.st = st;
    if (threadIdx.x == 0) (void)xb_add(&bar[XB_XCNT(b.x)], 1u);
    return b;
}
__device__ __forceinline__ void xcd_barrier_complete(unsigned* bar, unsigned x, unsigned& nloc, unsigned& nx) {
    const unsigned G = gridDim.x * gridDim.y * gridDim.z;
    unsigned sum, cnt, mine, sp = 0u;
    for (;;) {
        sum = 0u; cnt = 0u; mine = 0u;
#pragma unroll
        for (unsigned j = 0; j < 16; ++j) { const unsigned c = xb_ld(&bar[XB_XCNT(j)]); sum += c; cnt += (c > 0u) ? 1u : 0u; mine = (j == x) ? c : mine; }
        if (sum == G) break;
        __builtin_amdgcn_s_sleep(1);
        if ((++sp & 255u) == 0u) { if (xb_ld(&bar[XB_TMO])) break; if (sp > XB_SPIN_CAP) { atomicAdd(&bar[XB_TMO], 1u); break; } }
    }
    nloc = mine > 0u ? mine : 1u; nx = cnt > 0u ? cnt : 1u;
}
__device__ __forceinline__ void xcd_barrier(const XcdBarrier& b) {
    asm volatile("s_waitcnt vmcnt(0)" ::: "memory");
    __syncthreads();
    if (threadIdx.x == 0) {
        unsigned* bar = b.bar;
        __builtin_amdgcn_s_waitcnt(0);
        unsigned nloc = b.st[0], nx = b.st[1];
        if (nloc == 0u) { xcd_barrier_complete(bar, b.x, nloc, nx); b.st[0] = nloc; b.st[1] = nx; }
        const unsigned old = xb_add(&bar[XB_XSUB(b.x)], 1u);
        const unsigned gen = old / nloc;
        if (old + 1u == (gen + 1u) * nloc) {
            __builtin_amdgcn_fence(__ATOMIC_RELEASE, "agent");
            asm volatile("s_waitcnt vmcnt(0)" ::: "memory");
            const unsigned og = xb_add(&bar[XB_TOP], 1u);
            const unsigned tg = og / nx;
            if (og + 1u == (tg + 1u) * nx) xb_add(&bar[XB_TOPGEN], 1u);
            else XB_SPIN(xb_ld(&bar[XB_TOPGEN]) == tg, bar);
            __builtin_amdgcn_fence(__ATOMIC_ACQUIRE, "agent");
            xb_add(&bar[XB_XGEN(b.x)], 1u);
            asm volatile("s_waitcnt vmcnt(0)" ::: "memory");
        } else {
            XB_SPIN(xb_ld(&bar[XB_XGEN(b.x)]) == gen, bar);
            __builtin_amdgcn_fence(__ATOMIC_ACQUIRE, "agent");
            asm volatile("s_waitcnt vmcnt(0)" ::: "memory");
        }
    }
    __syncthreads();
}

__device__ __forceinline__ unsigned ld_untracked(const void* p) { unsigned v; asm volatile("global_load_dword %0, %1, off" : "=v"(v) : "v"(p) : "memory"); return v; }
namespace pg8 {
constexpr int BM = 256, BK = 64, HALF = 128, HTB = HALF * BK * 2, STAGE_BYTES = 8 * HTB, NXCD = 8, WGM = 8;
__host__ __device__ __forceinline__ int lds_byte(int r, int c) { const int st = (r >> 4) * 2 + (c >> 5), rr = r & 15, cc = c & 31, ob = rr * 64 + cc * 2; return st * 1024 + (ob ^ (((ob >> 9) & 1) << 5)); }
__host__ __device__ __forceinline__ void stage_rc(int b, int& R, int& C) { const int st = b / 1024, sb = b % 1024, swz = sb ^ (((sb >> 9) & 1) << 5); R = (st >> 1) * 16 + swz / 64; C = (st & 1) * 32 + (swz % 64) / 2; }
__host__ __device__ __forceinline__ int perm32(int rho) { const int n = rho >> 4, i = rho & 15; return 8 * (i >> 2) + 4 * n + (i & 3); }

struct Unit { int pm, pn; };
struct Gemm { const bf16_t* A; const bf16_t* Bt; int K; };

struct StaticOrder {
    int nM, nN, nwg, G, c;
    __device__ void init(int M, int N, int G_, int c_) { nM = M / BM; nN = N / BM; nwg = nM * nN; G = G_; c = c_; }
    __device__ bool next(int i, Unit& u) const {
        const long L = (long)i * G + c; if (L >= nwg) return false;
        int wgid = (int)L; { const int q = nwg / NXCD, r = nwg % NXCD, xcd = wgid % NXCD, off = wgid / NXCD; wgid = (xcd < r ? xcd * (q + 1) : r * (q + 1) + (xcd - r) * q) + off; }
        const int nig = WGM * nN, gid = wgid / nig, fm = gid * WGM, gsz = (nM - fm) < WGM ? (nM - fm) : WGM;
        u.pm = fm + ((wgid % nig) % gsz); u.pn = (wgid % nig) / gsz; return true;
    }
    __device__ __forceinline__ unsigned arow(const Unit&, int) const { return 0u; }
    __device__ __forceinline__ unsigned arow_raw(const Unit&, int) const { return 0u; }
};

struct PanelOrder {
    int nN, nP, G, vcu;
    __device__ bool next(int i, Unit& u) const { const int p = vcu + (i / nN) * G; if (p >= nP) return false; u.pm = p; u.pn = i % nN; return true; }
    __device__ __forceinline__ unsigned arow(const Unit&, int) const { return 0u; }
    __device__ __forceinline__ unsigned arow_raw(const Unit&, int) const { return 0u; }
};
template <int N> __device__ __forceinline__ void wait_v() { asm volatile("s_waitcnt vmcnt(%0)" :: "n"(N) : "memory"); }
template <class Epi, class Sched, bool GATHER, bool FP8 = false>
__device__ __forceinline__ void gemm_phase(LAS unsigned char* lds, const Gemm g, const Sched& S, const Epi& E, int wave_in) {
    int tid_ = wave_in * 64 + lane_id(); asm volatile("" : "+v"(tid_));
    const int tid = tid_, wid = __builtin_amdgcn_readfirstlane(tid >> 6), lane = tid & 63, wr = wid >> 2, wc = wid & 3, fr = lane & 15, fq = lane >> 4;
    int K_ = g.K; asm volatile("" : "+s"(K_));
    const int K = K_, nt = K / BK;
    unsigned voffA[2], voffB[2]; int Rr[2], Cb[2];
#pragma unroll
    for (int i = 0; i < 2; ++i) { int R, C; stage_rc(tid * 16 + i * 8192, R, C); const int Rb = Epi::PERM ? ((R & ~31) + perm32(R & 31)) : R;
        Rr[i] = R; Cb[i] = C * 2; voffA[i] = (unsigned)(R * K + C) * 2u; voffB[i] = (unsigned)(Rb * K + C) * 2u; }
    const size_t kstep = (size_t)(BK * 2);
    const size_t hstep = (size_t)HALF * K * 2;
    const size_t tstep = 2 * hstep;
    const unsigned ldsw = (unsigned)wid * 1024u;
    const int aoff = lds_byte(wr * 64 + fr, fq * 8), boff = lds_byte(wc * 32 + fr, fq * 8);
#define PG8_SA(b, h) (((b) * 2 + (h)) * HTB)
#define PG8_SB(b, h) ((4 + (b) * 2 + (h)) * HTB)
#define PG8_STAGE(bufoff, gbase, voff) do { _Pragma("unroll") for (int _i = 0; _i < 2; ++_i) \
        __builtin_amdgcn_global_load_lds((const unsigned*)((const char*)(gbase) + (voff)[_i]), (LAS unsigned*)(lds + (bufoff) + ldsw + _i * 8192), 16, 0, 0); } while (0)
#define PG8_STGA(b, h, base, vs) do { if constexpr (GATHER) { PG8_STAGE(PG8_SA(b, h), (base), vs[h]); } else { PG8_STAGE(PG8_SA(b, h), (base) + (h) * hstep, voffA); } } while (0)
#define PG8_LDA(dst, b, h) do { _Pragma("unroll") for (int m = 0; m < 4; ++m) _Pragma("unroll") for (int k = 0; k < 2; ++k) dst[m][k] = *(const LAS bf16x8*)(lds + PG8_SA(b, h) + aoff + m * 2048 + k * 1024); } while (0)
#define PG8_LDB(dst, b, h) do { _Pragma("unroll") for (int n = 0; n < 2; ++n) _Pragma("unroll") for (int k = 0; k < 2; ++k) dst[n][k] = *(const LAS bf16x8*)(lds + PG8_SB(b, h) + boff + n * 2048 + k * 1024); } while (0)
#define PG8_CAT(x, y) __builtin_shufflevector(__builtin_bit_cast(i32x4, (x)), __builtin_bit_cast(i32x4, (y)), 0, 1, 2, 3, 4, 5, 6, 7)
#define PG8_MMA(ai, bj, At, Bt) do { __builtin_amdgcn_s_setprio(1); \
        if constexpr (FP8) { _Pragma("unroll") for (int m = 0; m < 4; ++m) _Pragma("unroll") for (int n = 0; n < 2; ++n) \
            { const i32x8 a8_ = PG8_CAT(Bt[n][0], Bt[n][1]), b8_ = PG8_CAT(At[m][0], At[m][1]); \
              asm volatile("v_mfma_scale_f32_16x16x128_f8f6f4 %0, %1, %2, %0, %3, %3 op_sel_hi:[0,0,0]" : "+v"(acc[ai][bj][m][n]) : "v"(a8_), "v"(b8_), "v"(one8)); } } \
        else { _Pragma("unroll") for (int m = 0; m < 4; ++m) _Pragma("unroll") for (int n = 0; n < 2; ++n) _Pragma("unroll") for (int k = 0; k < 2; ++k) \
            acc[ai][bj][m][n] = __builtin_amdgcn_mfma_f32_16x16x32_bf16(Bt[n][k], At[m][k], acc[ai][bj][m][n], 0, 0, 0); } \
        __builtin_amdgcn_s_setprio(0); } while (0)
#define PG8_PIECE(bufoff, gbase, voff, i) __builtin_amdgcn_global_load_lds((const unsigned*)((const char*)(gbase) + (voff)[i]), (LAS unsigned*)(lds + (bufoff) + ldsw + (i) * 8192), 16, 0, 0)
#define PG8_PCA(b, h, base, vs, i) do { if constexpr (GATHER) { PG8_PIECE(PG8_SA(b, h), (base), vs[h], i); } else { PG8_PIECE(PG8_SA(b, h), (base) + (h) * hstep, voffA, i); } PG8_SCHED; } while (0)
#define PG8_PCB(b, h, base, i) do { PG8_PIECE(PG8_SB(b, h), (base) + (h) * hstep, voffB, i); PG8_SCHED; } while (0)
#define PG8_MMAH(ai, bj, At, Bt, HK) do { __builtin_amdgcn_s_setprio(1); \
        if constexpr (FP8) { _Pragma("unroll") for (int m = 0; m < 4; ++m) _Pragma("unroll") for (int n = 0; n < 2; ++n) \
            { const i32x8 a8_ = PG8_CAT(Bt[n][0], Bt[n][1]), b8_ = PG8_CAT(At[m][0], At[m][1]); \
              asm volatile("v_mfma_scale_f32_16x16x128_f8f6f4 %0, %1, %2, %0, %3, %3 op_sel_hi:[0,0,0]" : "+v"(acc[ai][bj][m][n]) : "v"(a8_), "v"(b8_), "v"(one8)); HK(m * 2 + n); } } \
        else { _Pragma("unroll") for (int k = 0; k < 2; ++k) _Pragma("unroll") for (int m = 0; m < 4; ++m) { _Pragma("unroll") for (int n = 0; n < 2; ++n) \
            acc[ai][bj][m][n] = __builtin_amdgcn_mfma_f32_16x16x32_bf16(Bt[n][k], At[m][k], acc[ai][bj][m][n], 0, 0, 0); HK(k * 4 + m); } } \
        __builtin_amdgcn_s_setprio(0); } while (0)
#define PG8_WAIT_V(n) asm volatile("s_waitcnt vmcnt(" #n ")" ::: "memory")
#define PG8_WAIT_L(n) asm volatile("s_waitcnt lgkmcnt(" #n ")" ::: "memory")
#define PG8_BAR __builtin_amdgcn_s_barrier()
#define PG8_SCHED __builtin_amdgcn_sched_barrier(0)
    Unit cur, nxt; int ui = 0;
    if (!S.next(0, cur)) return;
    int one8 = 0x7f7f7f7f; asm volatile("" : "+v"(one8));
    f32x4 acc[2][2][4][2];
#pragma unroll
    for (int a = 0; a < 2; ++a)
#pragma unroll
        for (int b = 0; b < 2; ++b)
#pragma unroll
            for (int m = 0; m < 4; ++m)
#pragma unroll
                for (int n = 0; n < 2; ++n) acc[a][b][m][n] = (f32x4){0.f, 0.f, 0.f, 0.f};
    bf16x8 At[4][2], B0[2][2], B1[2][2];
    unsigned vc[2][2], vn[2][2], v2[2][2];
#pragma unroll
    for (int h = 0; h < 2; ++h)
#pragma unroll
        for (int i = 0; i < 2; ++i) { vc[h][i] = GATHER ? S.arow(cur, h * HALF + Rr[i]) * (unsigned)(K * 2) + (unsigned)Cb[i] : 0u; vn[h][i] = vc[h][i]; v2[h][i] = vc[h][i]; }
    const char* cA = GATHER ? (const char*)g.A : (const char*)g.A + (size_t)cur.pm * tstep; const char* cB = (const char*)g.Bt + (size_t)cur.pn * tstep;
    PG8_STAGE(PG8_SB(0, 0), cB, voffB); PG8_STAGE(PG8_SB(0, 1), cB + hstep, voffB); PG8_STGA(0, 0, cA, vc); PG8_STGA(0, 1, cA, vc);
    if (wr == 1) PG8_BAR;
    PG8_WAIT_V(2); PG8_BAR;
    constexpr bool PEEL = FP8;
    PG8_STAGE(PG8_SB(1, 0), cB + kstep, voffB); PG8_STGA(1, 0, cA + kstep, vc); PG8_STAGE(PG8_SB(1, 1), cB + hstep + kstep, voffB);
    PG8_STGA(1, 1, cA + kstep, vc); PG8_WAIT_V(8);
    PG8_BAR;
    constexpr int XW = Epi::NVM + Epi::NPRE + (GATHER ? 4 : 0);
    { LAS unsigned* dump = (LAS unsigned*)(lds + STAGE_BYTES + (unsigned)wave_in * 256u);
#pragma unroll
      for (int s_ = 0; s_ < Epi::NVM; ++s_) __builtin_amdgcn_global_load_lds((const unsigned*)g.Bt, dump, 4, 0, 0); }
#define PG8_ITER(FIRST) do { \
            const bool last = !(FIRST) && (t == nt - 2); \
            const char* a1 = cA + (size_t)(t + 1) * kstep; \
            const char* a2 = last ? nA : cA + (size_t)(t + 2) * kstep; const char* b2 = last ? nB : cB + (size_t)(t + 2) * kstep; \
            const char* a3 = a2 + kstep; const char* b3 = b2 + kstep; \
            if (GATHER) { \
                _Pragma("unroll") for (int h = 0; h < 2; ++h) _Pragma("unroll") for (int i = 0; i < 2; ++i) v2[h][i] = last ? vn[h][i] : vc[h][i]; \
            } \
              \
            PG8_LDB(B0, 0, 0); PG8_LDB(B1, 0, 1); PG8_SCHED; PG8_LDA(At, 0, 0); if (!(FIRST)) PG8_STGA(1, 1, a1, vc); \
            if (FIRST) wait_v<8 + XW>(); else wait_v<8>(); PG8_WAIT_L(0); PG8_BAR; PG8_MMA(0, 0, At, B0); PG8_MMA(0, 1, At, B1); PG8_BAR; PG8_SCHED; \
              \
            PG8_LDA(At, 0, 1); PG8_STAGE(PG8_SB(0, 0), b2, voffB); PG8_STAGE(PG8_SB(0, 1), b2 + hstep, voffB); PG8_STGA(0, 0, a2, v2); \
            if (FIRST) wait_v<8 + XW>(); else wait_v<8>(); PG8_WAIT_L(0); PG8_BAR; PG8_MMA(1, 0, At, B0); PG8_MMA(1, 1, At, B1); PG8_BAR; PG8_SCHED; \
              \
            PG8_LDB(B0, 1, 0); PG8_LDB(B1, 1, 1); PG8_SCHED; PG8_LDA(At, 1, 0); PG8_STGA(0, 1, a2, v2); \
            if (FIRST) wait_v<8 + XW>(); else wait_v<8>(); PG8_WAIT_L(0); PG8_BAR; PG8_MMA(0, 0, At, B0); PG8_MMA(0, 1, At, B1); PG8_BAR; PG8_SCHED; \
              \
            PG8_LDA(At, 1, 1); PG8_STAGE(PG8_SB(1, 0), b3, voffB); PG8_STAGE(PG8_SB(1, 1), b3 + hstep, voffB); PG8_STGA(1, 0, a3, v2); \
            PG8_WAIT_V(8); PG8_WAIT_L(0); PG8_BAR; PG8_MMA(1, 0, At, B0); PG8_MMA(1, 1, At, B1); PG8_BAR; PG8_SCHED; \
        } while (0)
#define PG8_H1A(j) if ((j) == 3 && !(FIRST_)) PG8_PCA(1, 1, a1, vc, 0)
#define PG8_H1B(j) if ((j) == 3 && !(FIRST_)) PG8_PCA(1, 1, a1, vc, 1)
#define PG8_H2A(j) if ((j) == 1) PG8_PCB(0, 0, b2, 0); else if ((j) == 3) PG8_PCB(0, 0, b2, 1); else if ((j) == 5) PG8_PCB(0, 1, b2, 0)
#define PG8_H2B(j) if ((j) == 1) PG8_PCB(0, 1, b2, 1); else if ((j) == 3) PG8_PCA(0, 0, a2, v2, 0); else if ((j) == 5) PG8_PCA(0, 0, a2, v2, 1)
#define PG8_H3A(j) if ((j) == 3) PG8_PCA(0, 1, a2, v2, 0)
#define PG8_H3B(j) if ((j) == 3) PG8_PCA(0, 1, a2, v2, 1)
#define PG8_H4A(j) if ((j) == 1) PG8_PCB(1, 0, b3, 0); else if ((j) == 3) PG8_PCB(1, 0, b3, 1); else if ((j) == 5) PG8_PCB(1, 1, b3, 0)
#define PG8_H4B(j) if ((j) == 1) PG8_PCB(1, 1, b3, 1); else if ((j) == 3) PG8_PCA(1, 0, a3, v2, 0); else if ((j) == 5) PG8_PCA(1, 0, a3, v2, 1)
#define PG8_ITER2(FIRST) do { \
            const bool FIRST_ = (FIRST); \
            const bool last = !(FIRST) && (t == nt - 2); \
            const char* a1 = cA + (size_t)(t + 1) * kstep; \
            const char* a2 = last ? nA : cA + (size_t)(t + 2) * kstep; const char* b2 = last ? nB : cB + (size_t)(t + 2) * kstep; \
            const char* a3 = a2 + kstep; const char* b3 = b2 + kstep; \
            if (GATHER) { \
                _Pragma("unroll") for (int h = 0; h < 2; ++h) _Pragma("unroll") for (int i = 0; i < 2; ++i) v2[h][i] = last ? vn[h][i] : vc[h][i]; \
            } \
            PG8_LDB(B0, 0, 0); PG8_LDB(B1, 0, 1); PG8_SCHED; PG8_LDA(At, 0, 0); \
            if (FIRST) wait_v<8 + XW>(); else wait_v<6>(); PG8_WAIT_L(0); PG8_BAR; PG8_MMAH(0, 0, At, B0, PG8_H1A); PG8_MMAH(0, 1, At, B1, PG8_H1B); PG8_BAR; PG8_SCHED; \
            PG8_LDA(At, 0, 1); \
            if (FIRST) wait_v<2 + XW>(); else wait_v<2>(); PG8_WAIT_L(0); PG8_BAR; PG8_MMAH(1, 0, At, B0, PG8_H2A); PG8_MMAH(1, 1, At, B1, PG8_H2B); PG8_BAR; PG8_SCHED; \
            PG8_LDB(B0, 1, 0); PG8_LDB(B1, 1, 1); PG8_SCHED; PG8_LDA(At, 1, 0); \
            if (FIRST) wait_v<6 + XW>(); else wait_v<6>(); PG8_WAIT_L(0); PG8_BAR; PG8_MMAH(0, 0, At, B0, PG8_H3A); PG8_MMAH(0, 1, At, B1, PG8_H3B); PG8_BAR; PG8_SCHED; \
            PG8_LDA(At, 1, 1); \
            wait_v<2>(); PG8_WAIT_L(0); PG8_BAR; PG8_MMAH(1, 0, At, B0, PG8_H4A); PG8_MMAH(1, 1, At, B1, PG8_H4B); PG8_BAR; PG8_SCHED; \
        } while (0)
    constexpr bool MD = FP8;
#define PG8_IT(FIRST) do { if constexpr (MD) PG8_ITER2(FIRST); else PG8_ITER(FIRST); } while (0)
    for (;;) {
        const bool has_next = S.next(ui + 1, nxt);
        if (GATHER && has_next && !PEEL) {
            int t2 = wave_in * 64 + lane_id(); asm volatile("" : "+v"(t2));
#pragma unroll
            for (int i = 0; i < 2; ++i) { int R, C; stage_rc(t2 * 16 + i * 8192, R, C);
#pragma unroll
                for (int h = 0; h < 2; ++h) vn[h][i] = S.arow(nxt, h * HALF + R) * (unsigned)(K * 2) + (unsigned)(C * 2); }
        }
        if (GATHER && PEEL) {
            int t2 = wave_in * 64 + lane_id(); asm volatile("" : "+v"(t2));
#pragma unroll
            for (int i = 0; i < 2; ++i) { int R, C; stage_rc(t2 * 16 + i * 8192, R, C);
#pragma unroll
                for (int h = 0; h < 2; ++h) vn[h][i] = S.arow_raw(has_next ? nxt : cur, h * HALF + R); }
        }
        typename Epi::Pre pre = E.preload(cur, wr, wc, fr, fq);
        const char* nA = has_next ? (GATHER ? (const char*)g.A : (const char*)g.A + (size_t)nxt.pm * tstep) : cA; const char* nB = has_next ? (const char*)g.Bt + (size_t)nxt.pn * tstep : cB;
        if constexpr (PEEL) { int t = 0; PG8_IT(true); }
        if (GATHER && PEEL) {
            int t2 = wave_in * 64 + lane_id(); asm volatile("" : "+v"(t2));
#pragma unroll
            for (int i = 0; i < 2; ++i) { int R, C; stage_rc(t2 * 16 + i * 8192, R, C);
#pragma unroll
                for (int h = 0; h < 2; ++h) vn[h][i] = (vn[h][i] >> 2) * (unsigned)(K * 2) + (unsigned)(C * 2); }
        }
        if constexpr (PEEL) {
#pragma unroll 1
            for (int t = 2; t < nt; t += 2) PG8_IT(false); }
        else {
#pragma unroll 1
            for (int t = 0; t < nt; t += 2) PG8_IT(t == 0); }
        PG8_STGA(1, 1, nA + kstep, vn);
        if (wr == 0) PG8_BAR;
        if constexpr (FP8) asm volatile("s_nop 15\n\ts_nop 15" ::: "memory");
        E(acc, cur, wr, wc, fr, fq, pre);
        if (!has_next) break;
#pragma unroll
        for (int a = 0; a < 2; ++a)
#pragma unroll
            for (int b = 0; b < 2; ++b)
#pragma unroll
                for (int m = 0; m < 4; ++m)
#pragma unroll
                    for (int n = 0; n < 2; ++n) acc[a][b][m][n] = (f32x4){0.f, 0.f, 0.f, 0.f};
        cur = nxt; cA = nA; cB = nB; ++ui;
#pragma unroll
        for (int h = 0; h < 2; ++h)
#pragma unroll
            for (int i = 0; i < 2; ++i) vc[h][i] = vn[h][i];
        if (wr == 1) PG8_BAR;
    }
    PG8_WAIT_V(0);
    PG8_BAR;
#undef PG8_SA
#undef PG8_SB
#undef PG8_STAGE
#undef PG8_STGA
#undef PG8_LDA
#undef PG8_LDB
#undef PG8_MMA
#undef PG8_CAT
#undef PG8_WAIT_V
#undef PG8_WAIT_L
#undef PG8_BAR
#undef PG8_SCHED
#undef PG8_ITER
#undef PG8_ITER2
#undef PG8_IT
#undef PG8_PIECE
#undef PG8_PCA
#undef PG8_PCB
#undef PG8_MMAH
#undef PG8_H1A
#undef PG8_H1B
#undef PG8_H2A
#undef PG8_H2B
#undef PG8_H3A
#undef PG8_H3B
#undef PG8_H4A
#undef PG8_H4B
}
}

struct Frame {
    LAS unsigned char* lds;
    LAS unsigned char* misc;
    gu32* ctl;
    int tid, lane, wave, vcu, G, wave0;
    const float *x_in, *c_in, *w_ada, *b_ada, *norm1, *w_in, *sinks, *lq1, *lk1, *lq2, *lk2, *subln, *w_out, *norm2, *w_router, *b_router, *w_gate, *b_gate, *w_up, *b_up, *w_down, *b_down, *norm_f;
    float* out;
    float *modp, *mod, *part; int* ltok; float* lg; int* inv;
    bf16_t *WIN, *WOUT, *WGU, *WDN, *H, *PROJ, *MIXED, *HIDDEN, *Y, *XB;
};

__device__ __forceinline__ void p0_transpose_tile(const float* src, int N, bf16_t* dst, int ldd, LAS float* scr, int lane) {
#pragma unroll
    for (int i = 0; i < 32; ++i) { const int kk = 2 * i + (lane >> 5); scr[kk * 33 + (lane & 31)] = src[(size_t)kk * N + (lane & 31)]; }
    LDS_WAIT(); asm volatile("" ::: "memory");
    const int c = lane & 7;
#pragma unroll
    for (int j = 0; j < 4; ++j) { const int n = (lane >> 3) + 8 * j; const LAS float* s = scr + (8 * c) * 33 + n;
        u32x4 o; o.x = pk2(s[0 * 33], s[1 * 33]); o.y = pk2(s[2 * 33], s[3 * 33]); o.z = pk2(s[4 * 33], s[5 * 33]); o.w = pk2(s[6 * 33], s[7 * 33]);
        *(GAS u32x4*)(dst + (size_t)n * ldd + 8 * c) = o; }
    LDS_WAIT(); asm volatile("" ::: "memory");
}
__device__ __forceinline__ void p0_transpose_tile8(const float* src, int N, unsigned char* dst, int ldd, LAS float* scr, int lane) {
#pragma unroll
    for (int i = 0; i < 32; ++i) { const int kk = 2 * i + (lane >> 5); scr[kk * 33 + (lane & 31)] = src[(size_t)kk * N + (lane & 31)]; }
    LDS_WAIT(); asm volatile("" ::: "memory");
    const int c = lane & 7;
#pragma unroll
    for (int j = 0; j < 4; ++j) { const int n = (lane >> 3) + 8 * j; const LAS float* s = scr + (8 * c) * 33 + n;
        u32x2 o; o.x = pk4_fp8(s[0 * 33] * W8_SCALE, s[1 * 33] * W8_SCALE, s[2 * 33] * W8_SCALE, s[3 * 33] * W8_SCALE); o.y = pk4_fp8(s[4 * 33] * W8_SCALE, s[5 * 33] * W8_SCALE, s[6 * 33] * W8_SCALE, s[7 * 33] * W8_SCALE);
        *(GAS u32x2*)(dst + (size_t)n * ldd + 8 * c) = o; }
    LDS_WAIT(); asm volatile("" ::: "memory");
}
__device__ __forceinline__ void p0_prologue(Frame& F) {
    LAS float* cond = (LAS float*)F.lds;
    for (int i = F.tid; i < NBATCH * DM; i += NTHREADS) { const float v = F.c_in[i]; cond[i] = v / (1.f + __expf(-v)); }
    __syncthreads();
    LAS float* scr = (LAS float*)(F.lds + 32768 + F.wave * 8448);
    const int gw = F.vcu * NWAVES + F.wave, NGW = F.G * NWAVES;
    constexpr int I_MOD = DEPTH * 24 * 4;
    constexpr int I_IN = DEPTH * 16 * 88, I_OUT = DEPTH * 16 * 32, I_E = DEPTH * NE * 16 * 32;
    constexpr int NITEMS = I_MOD + I_IN + I_OUT + 3 * I_E;
    for (int it = gw; it < NITEMS; it += NGW) {
        int r = it;
        if (r < I_MOD) {
            const int kq = r & 3, cg = (r >> 2) % 24, L = (r >> 2) / 24, col = cg * 256 + 4 * F.lane;
            f32x4 acc[NBATCH];
#pragma unroll
            for (int b = 0; b < NBATCH; ++b) acc[b] = (f32x4){0.f, 0.f, 0.f, 0.f};
            const float* wp = F.w_ada + ((size_t)L * DM + kq * 256) * 6144 + col;
            for (int k4 = 0; k4 < 64; ++k4) {
                f32x4 w[4];
#pragma unroll
                for (int j = 0; j < 4; ++j) w[j] = *(const GAS f32x4*)(wp + (size_t)(k4 * 4 + j) * 6144);
#pragma unroll
                for (int b = 0; b < NBATCH; ++b) { const f32x4 cv = *(const LAS f32x4*)(cond + b * DM + kq * 256 + k4 * 4);
                    acc[b] += w[0] * cv.x + w[1] * cv.y + w[2] * cv.z + w[3] * cv.w; }
            }
#pragma unroll
            for (int b = 0; b < NBATCH; ++b) *(GAS f32x4*)(F.modp + (((size_t)kq * DEPTH + L) * NBATCH + b) * 6144 + col) = acc[b];
            continue;
        }
        r -= I_MOD;
        if (r < I_IN) { const int L = r / (16 * 88), q = r % (16 * 88), kb = q / 88, nb = q % 88;
            p0_transpose_tile(F.w_in + ((size_t)L * DM + kb * 64) * INW + nb * 32, INW, F.WIN + ((size_t)L * INW + nb * 32) * DM + kb * 64, DM, scr, F.lane); continue; }
        r -= I_IN;
        if (r < I_OUT) { const int L = r / 512, q = r % 512, kb = q / 32, nb = q % 32;
            p0_transpose_tile(F.w_out + ((size_t)L * DM + kb * 64) * DM + nb * 32, DM, F.WOUT + ((size_t)L * DM + nb * 32) * DM + kb * 64, DM, scr, F.lane); continue; }
        r -= I_OUT;
        { const int which = r / I_E, q0 = r % I_E, le = q0 / 512, q = q0 % 512, kb = q / 32, nb = q % 32, n0 = nb * 32;
          unsigned char* WGU8 = (unsigned char*)F.WGU; unsigned char* WDN8 = (unsigned char*)F.WDN;
          if (which == 0) p0_transpose_tile8(F.w_gate + ((size_t)le * DM + kb * 64) * DM + n0, DM, WGU8 + ((size_t)le * 2048 + (n0 >> 7) * 256 + (n0 & 127)) * DM + kb * 64, DM, scr, F.lane);
          else if (which == 1) p0_transpose_tile8(F.w_up + ((size_t)le * DM + kb * 64) * DM + n0, DM, WGU8 + ((size_t)le * 2048 + (n0 >> 7) * 256 + 128 + (n0 & 127)) * DM + kb * 64, DM, scr, F.lane);
          else p0_transpose_tile8(F.w_down + ((size_t)le * DM + kb * 64) * DM + n0, DM, WDN8 + ((size_t)le * DM + n0) * DM + kb * 64, DM, scr, F.lane); }
    }
}
__device__ __forceinline__ void p0b_modsum(Frame& F) {
    const int gt = F.vcu * NTHREADS + F.tid, NGT = F.G * NTHREADS;
    for (int i = gt; i < DEPTH * NBATCH * 6144 / 4; i += NGT) {
        const int e = i * 4, L = e / (NBATCH * 6144), j = e % 6144;
        f32x4 s = *(const GAS f32x4*)(F.b_ada + (size_t)L * 6144 + j);
#pragma unroll
        for (int kq = 0; kq < 4; ++kq) s += *(const GAS f32x4*)(F.modp + (size_t)kq * DEPTH * NBATCH * 6144 + e);
        *(GAS f32x4*)(F.mod + e) = s;
    }
}

template <int MODE>
__device__ __forceinline__ void p1_rows(Frame& F, int L, float g2mul = 1.0f) {
    const int gw = F.vcu * NWAVES + F.wave, NGW = F.G * NWAVES, lane = F.lane;
    const float* gain = (MODE == 2) ? F.norm_f : F.norm1 + (size_t)L * DM;
    f32x4 gn[4];
#pragma unroll
    for (int j = 0; j < 4; ++j) gn[j] = *(const GAS f32x4*)(gain + 4 * lane + 256 * j);
    for (int chunk = gw; chunk < NTOK / 32; chunk += NGW) {
        const int m0 = chunk * 32, b = m0 >> 13;
        f32x4 sc[4], sh[4], g2[4];
#pragma unroll
        for (int j = 0; j < 4; ++j) {
            if (MODE != 2) { const float* mp = F.mod + ((size_t)L * NBATCH + b) * 6144; sh[j] = *(const GAS f32x4*)(mp + 0 * DM + 4 * lane + 256 * j); sc[j] = *(const GAS f32x4*)(mp + 1 * DM + 4 * lane + 256 * j); }
            if (MODE != 0) { const float* mq = F.mod + ((size_t)(L - 1) * NBATCH + b) * 6144; g2[j] = *(const GAS f32x4*)(mq + 5 * DM + 4 * lane + 256 * j) * (g2mul * (1.0f / Y8_SCALE)); }
        }
        f32x4 xa[4], xb[4]; unsigned ya[4][4], yb[4][4];
        int pst = 0; i32x4 iv = {0, 0, 0, 0};
        if (MODE != 0) {
            const int c = (int)__hip_atomic_load((unsigned*)(F.ctl + CW_CNT + ((L - 1) * NE + (lane & 31)) * 16), RLX_AGENT);
            const int p = (c + 255) & ~255;
#pragma unroll
            for (int e2 = 0; e2 < 31; ++e2) { const int v_ = __builtin_amdgcn_readlane(p, e2); pst += ((lane & 31) > e2) ? v_ : 0; }
            iv = *(const GAS i32x4*)(F.inv + ((size_t)m0 + (lane & 31)) * 4);
        }
#define P1_LOAD(X, Yv, mrow) do { const size_t m_ = (size_t)(mrow); \
            _Pragma("unroll") for (int j = 0; j < 4; ++j) { if (MODE == 0) X[j] = *(const GAS f32x4*)(F.x_in + m_ * DM + 4 * lane + 256 * j); \
                else { const u32x2 xb_ = *(const GAS u32x2*)(F.XB + m_ * DM + 4 * lane + 256 * j); X[j] = (f32x4){bf_lo(xb_.x), bf_hi(xb_.x), bf_lo(xb_.y), bf_hi(xb_.y)}; } } \
            if (MODE != 0) { const int li_ = (int)(m_ - (size_t)m0); \
                _Pragma("unroll") for (int k = 0; k < TOPK; ++k) { const int w_ = __builtin_amdgcn_readlane(k == 0 ? iv.x : k == 1 ? iv.y : k == 2 ? iv.z : iv.w, li_); \
                    const size_t row_ = (size_t)(__builtin_amdgcn_readlane(pst, w_ & 255) + (w_ >> 8)); \
                    _Pragma("unroll") for (int j = 0; j < 4; ++j) Yv[j][k] = *(const GAS unsigned*)((const unsigned char*)F.Y + row_ * DM + 4 * lane + 256 * j); } } } while (0)
#define P1_PROC(X, Yv, mrow) do { const size_t m = (size_t)(mrow); f32x4 v[4]; \
            _Pragma("unroll") for (int j = 0; j < 4; ++j) { v[j] = X[j]; \
                if (MODE != 0) { f32x4 ys = (f32x4){0.f, 0.f, 0.f, 0.f}; \
                    _Pragma("unroll") for (int k = 0; k < TOPK; ++k) { const f32x2 ylo = __builtin_amdgcn_cvt_pk_f32_fp8((int)Yv[j][k], false), yhi = __builtin_amdgcn_cvt_pk_f32_fp8((int)Yv[j][k], true); ys += (f32x4){ylo.x, ylo.y, yhi.x, yhi.y}; } \
                    v[j] += g2[j] * ys; } } \
            float ss = 0.f; \
            _Pragma("unroll") for (int j = 0; j < 4; ++j) ss += (v[j].x * v[j].x + v[j].y * v[j].y) + (v[j].z * v[j].z + v[j].w * v[j].w); \
            const float rs = 1.0f / sqrtf(wave_sum(ss) * (1.f / DM) + RMS_EPS); \
            if (MODE == 2) { _Pragma("unroll") for (int j = 0; j < 4; ++j) *(GAS f32x4*)(F.out + m * DM + 4 * lane + 256 * j) = v[j] * rs * gn[j]; } \
            else { _Pragma("unroll") for (int j = 0; j < 4; ++j) { { u32x2 xo_; xo_.x = pk2(v[j].x, v[j].y); xo_.y = pk2(v[j].z, v[j].w); *(GAS u32x2*)(F.XB + m * DM + 4 * lane + 256 * j) = xo_; } \
                    const f32x4 h = (v[j] * rs * gn[j]) * (sc[j] + 1.0f) + sh[j]; \
                    u32x2 o; o.x = pk2(h.x, h.y); o.y = pk2(h.z, h.w); \
                    *(GAS u32x2*)(F.H + m * DM + 4 * lane + 256 * j) = o; } } } while (0)
        P1_LOAD(xa, ya, m0);
        for (int i = 0; i < 32; i += 2) {
            P1_LOAD(xb, yb, m0 + i + 1);
            P1_PROC(xa, ya, m0 + i);
            if (i + 2 < 32) P1_LOAD(xa, ya, m0 + i + 2);
            P1_PROC(xb, yb, m0 + i + 1);
        }
#undef P1_LOAD
#undef P1_PROC
    }
}

constexpr int MO_RS = 9216, MO_BIASP = 10240, MO_PART = 10368;
__device__ __forceinline__ void p5_route(Frame& F, int L, int LC) {
    const int lane = F.lane, r32 = lane & 31, hi = lane >> 5;
    LAS float* Wl = (LAS float*)F.lds;
    LAS int* hist = (LAS int*)(F.misc + MO_HIST); LAS int* base = (LAS int*)(F.misc + MO_BASE);
    LAS int* sel_e = (LAS int*)(F.misc + MO_SELE); LAS float* sel_g = (LAS float*)(F.misc + MO_SELG);
    LAS float* rsl = (LAS float*)(F.misc + MO_RS); LAS float* biasp = (LAS float*)(F.misc + MO_BIASP); LAS float* part = (LAS float*)(F.misc + MO_PART);
    const float* Wr = F.w_router + (size_t)L * DM * NE;
    f32x4 gn[4];
#pragma unroll
    for (int j = 0; j < 4; ++j) gn[j] = *(const GAS f32x4*)(F.norm2 + (size_t)L * DM + 4 * lane + 256 * j);
    for (int blk = F.vcu; blk < NTOK / 256; blk += F.G) {
        const int tok0 = blk * 256 + F.wave * 32, b = tok0 >> 13;
        const float* mp = F.mod + ((size_t)L * NBATCH + b) * 6144;
        if (F.tid < NE) hist[F.tid] = 0;
        for (int it = F.tid; it < (DM / 8) * NE; it += NTHREADS) { const int kg = it >> 5, e = it & 31, k0 = kg * 8;
            const f32x4 n0 = *(const GAS f32x4*)(F.norm2 + (size_t)L * DM + k0), n1 = *(const GAS f32x4*)(F.norm2 + (size_t)L * DM + k0 + 4);
            const f32x4 s0 = *(const GAS f32x4*)(mp + 4 * DM + k0), s1 = *(const GAS f32x4*)(mp + 4 * DM + k0 + 4);
            float w[8];
#pragma unroll
            for (int i = 0; i < 8; ++i) w[i] = Wr[(size_t)(k0 + i) * NE + e] * ((i < 4 ? n0[i & 3] : n1[i & 3]) * (1.0f + (i < 4 ? s0[i & 3] : s1[i & 3])));
            u32x4 hv, mv;
#pragma unroll
            for (int i = 0; i < 4; ++i) { const unsigned hb = cvt_pk_bf16(w[2 * i], w[2 * i + 1]); hv[i] = hb; mv[i] = cvt_pk_bf16(w[2 * i] - bf_lo(hb), w[2 * i + 1] - bf_hi(hb)); }
            const int off = ((kg * 32) + e) * 16;
            *(LAS u32x4*)((LAS unsigned char*)Wl + off) = hv; *(LAS u32x4*)((LAS unsigned char*)Wl + 65536 + off) = mv; }
        { const int e = lane & 31, k0 = F.wave * 128 + hi * 64; float acc = 0.f;
#pragma unroll 8
          for (int k = 0; k < 64; ++k) acc = __builtin_fmaf(mp[3 * DM + k0 + k], Wr[(size_t)(k0 + k) * NE + e], acc);
          part[(F.wave * 2 + hi) * 32 + e] = acc; }
        f32x4 sc[4], sh[4];
#pragma unroll
        for (int j = 0; j < 4; ++j) { sh[j] = *(const GAS f32x4*)(mp + 3 * DM + 4 * lane + 256 * j); sc[j] = *(const GAS f32x4*)(mp + 4 * DM + 4 * lane + 256 * j); }
        f32x4 xa[4], xb[4];
#define P5_LOAD(X, mrow) do { _Pragma("unroll") for (int j = 0; j < 4; ++j) { const u32x2 xb_ = *(const GAS u32x2*)(F.XB + (size_t)(mrow) * DM + 4 * lane + 256 * j); X[j] = (f32x4){bf_lo(xb_.x), bf_hi(xb_.x), bf_lo(xb_.y), bf_hi(xb_.y)}; } } while (0)
#define P5_PROC(X, mrow, irow) do { const size_t m = (size_t)(mrow); float ss = 0.f; \
            _Pragma("unroll") for (int j = 0; j < 4; ++j) ss += (X[j].x * X[j].x + X[j].y * X[j].y) + (X[j].z * X[j].z + X[j].w * X[j].w); \
            const float rs = 1.0f / sqrtf(wave_sum(ss) * (1.f / DM) + RMS_EPS); \
            _Pragma("unroll") for (int j = 0; j < 4; ++j) { const f32x4 h = ((X[j] * rs * gn[j]) * (sc[j] + 1.0f) + sh[j]) * H8_SCALE; \
                *(GAS unsigned*)((unsigned char*)F.H + m * DM + 4 * lane + 256 * j) = pk4_fp8(h.x, h.y, h.z, h.w); } \
            if (lane == 0) rsl[F.wave * 32 + (irow)] = rs; } while (0)
        P5_LOAD(xa, tok0);
        for (int i = 0; i < 32; i += 2) {
            P5_LOAD(xb, tok0 + i + 1);
            P5_PROC(xa, tok0 + i, i);
            if (i + 2 < 32) P5_LOAD(xa, tok0 + i + 2);
            P5_PROC(xb, tok0 + i + 1, i + 1);
        }
#undef P5_LOAD
#undef P5_PROC
        __syncthreads();
        if (F.tid < NE) { float s = F.b_router[L * NE + F.tid];
#pragma unroll
            for (int p = 0; p < 16; ++p) s += part[p * 32 + F.tid];
            biasp[F.tid] = s; }
        __syncthreads();
        {
            f32x16 a0, a1;
#pragma unroll
            for (int r = 0; r < 16; ++r) { a0[r] = 0.f; a1[r] = 0.f; }
            const bf16_t* xr = F.XB + ((size_t)tok0 + r32) * DM + 8 * hi;
            const LAS unsigned char* wl = (const LAS unsigned char*)Wl + (hi * 32 + r32) * 16;
#pragma unroll 4
            for (int j = 0; j < 64; ++j) {
                const bf16x8 xv = *(const GAS bf16x8*)(xr + 16 * j);
                const bf16x8 wh = *(const LAS bf16x8*)(wl + j * 1024), wm = *(const LAS bf16x8*)(wl + 65536 + j * 1024);
                a0 = __builtin_amdgcn_mfma_f32_32x32x16_bf16(wh, xv, a0, 0, 0, 0); a1 = __builtin_amdgcn_mfma_f32_32x32x16_bf16(wm, xv, a1, 0, 0, 0);
            }
            const float rs = rsl[F.wave * 32 + r32];
            float v[16];
#pragma unroll
            for (int r = 0; r < 16; ++r) v[r] = (a0[r] + a1[r]) * rs + biasp[(r & 3) + 8 * (r >> 2) + 4 * hi];
            float tv[4]; int ti[4];
#pragma unroll
            for (int rd = 0; rd < 4; ++rd) {
                float bv = v[0]; int bi = 4 * hi;
#pragma unroll
                for (int r = 1; r < 16; ++r) { const int ei = (r & 3) + 8 * (r >> 2) + 4 * hi; if (v[r] > bv) { bv = v[r]; bi = ei; } }
                { const auto rv_ = __builtin_amdgcn_permlane32_swap(__float_as_uint(bv), __float_as_uint(bv), false, false); const auto ri_ = __builtin_amdgcn_permlane32_swap((unsigned)bi, (unsigned)bi, false, false);
                  const float v0_ = __uint_as_float(rv_[0]), v1_ = __uint_as_float(rv_[1]); const int i0_ = (int)ri_[0], i1_ = (int)ri_[1];
                  const bool up_ = (v1_ > v0_) || (v1_ == v0_ && i1_ < i0_); bv = up_ ? v1_ : v0_; bi = up_ ? i1_ : i0_; }
                tv[rd] = bv; ti[rd] = bi;
#pragma unroll
                for (int r = 0; r < 16; ++r) { const int ei = (r & 3) + 8 * (r >> 2) + 4 * hi; if (ei == bi) v[r] = -INFINITY; }
            }
            const float e1 = __expf(tv[1] - tv[0]), e2 = __expf(tv[2] - tv[0]), e3 = __expf(tv[3] - tv[0]); const float inv = 1.0f / (1.0f + e1 + e2 + e3);
#pragma unroll
            for (int kk = 0; kk < 2; ++kk) {
                const int me = hi ? (kk ? ti[3] : ti[2]) : (kk ? ti[1] : ti[0]);
                const float mg = (hi ? (kk ? e3 : e2) : (kk ? e1 : 1.0f)) * inv;
                const int pos = __hip_atomic_fetch_add(&hist[me], 1, __ATOMIC_RELAXED, __HIP_MEMORY_SCOPE_WORKGROUP);
                const int a = (F.wave * 32 + r32) * 4 + 2 * hi + kk;
                sel_e[a] = me | (pos << 8); sel_g[a] = mg;
            }
        }
        __syncthreads();
        if (F.tid < NE) base[F.tid] = (int)__hip_atomic_fetch_add((unsigned*)(F.ctl + CW_CNT + (LC * NE + F.tid) * 16), (unsigned)hist[F.tid], RLX_AGENT);
        __syncthreads();
        for (int a = F.tid; a < 1024; a += NTHREADS) { const int se = sel_e[a], ex = se & 255, pos = se >> 8, slot = base[ex] + pos;
            F.ltok[(size_t)ex * LCAP + slot] = (blk * 256 + (a >> 2)) * 4 + (a & 3); F.lg[(size_t)ex * LCAP + slot] = sel_g[a];
            F.inv[(size_t)blk * 1024 + a] = ex | (slot << 8); }
        __syncthreads();
    }
}

struct EpiProj {
    static constexpr bool PERM = true; static constexpr int NVM = 16;
    struct Pre {}; static constexpr int NPRE = 0;
    __device__ __forceinline__ Pre preload(const pg8::Unit&, int, int, int, int) const { return Pre{}; }
    __device__ __forceinline__ void operator()(const f32x4 (&acc)[2][2][4][2], const pg8::Unit& u, int wr, int wc, int fr, int fq, const Pre&) const { (*this)(acc, u, wr, wc, fr, fq); }
    bf16_t* O; unsigned* nrm;
    __device__ __forceinline__ void operator()(const f32x4 (&acc)[2][2][4][2], const pg8::Unit& u, int wr, int wc, int fr, int fq) const {
        const int row0 = u.pm * 256 + wr * 64 + fr, col0 = u.pn * 256 + wc * 32 + 8 * fq;
        const float sc = (u.pn == 0 || u.pn == 3 || u.pn == 5 || u.pn == 6) ? QSCALE : 1.0f;
        float nmx[2] = {0.f, 0.f};
#pragma unroll
        for (int ai = 0; ai < 2; ++ai)
#pragma unroll
            for (int m = 0; m < 4; ++m) { bf16_t* rowp = O + (size_t)(row0 + ai * 128 + m * 16) * INW + col0;
#pragma unroll
                for (int bj = 0; bj < 2; ++bj) { const f32x4 v0 = acc[ai][bj][m][0] * sc, v1 = acc[ai][bj][m][1] * sc;
                    u32x4 w; w.x = cvt_pk_bf16(v0[0], v0[1]); w.y = cvt_pk_bf16(v0[2], v0[3]); w.z = cvt_pk_bf16(v1[0], v1[1]); w.w = cvt_pk_bf16(v1[2], v1[3]);
                    *(GAS u32x4*)(rowp + bj * 128) = w;
                    if (C_TILE_SKIP && u.pn >= 5 && u.pn <= 8) {
                        float q = (v0[0] * v0[0] + v0[1] * v0[1]) + (v0[2] * v0[2] + v0[3] * v0[3]) + (v1[0] * v1[0] + v1[1] * v1[1]) + (v1[2] * v1[2] + v1[3] * v1[3]);
                        q = x32_sum(x16_sum(q)); nmx[bj] = fmaxf(nmx[bj], q); } } }
        if (C_TILE_SKIP && u.pn >= 5 && u.pn <= 8) {
#pragma unroll
            for (int bj = 0; bj < 2; ++bj) { float v = row16_max(nmx[bj]);
                if (fr == 0 && fq == 0) { const int b = u.pm >> 5, qk = u.pn >= 7, blk = (u.pn - (qk ? 7 : 5)) * 8 + bj * 4 + wc;
                    atomicMax(nrm + (b * 2 + qk) * 16 + blk, __float_as_uint(v)); } }
        }
    }
};
struct EpiOut {
    static constexpr bool PERM = false; static constexpr int NVM = 32;
    struct Pre {}; static constexpr int NPRE = 0;
    __device__ __forceinline__ Pre preload(const pg8::Unit&, int, int, int, int) const { return Pre{}; }
    __device__ __forceinline__ void operator()(const f32x4 (&acc)[2][2][4][2], const pg8::Unit& u, int wr, int wc, int fr, int fq, const Pre&) const { (*this)(acc, u, wr, wc, fr, fq); }
    bf16_t* X; const float* g1; float gmul;
    __device__ __forceinline__ void operator()(const f32x4 (&acc)[2][2][4][2], const pg8::Unit& u, int wr, int wc, int fr, int fq) const {
        const int b = u.pm >> 5, col0 = u.pn * 256 + wc * 32 + 4 * fq;
        f32x4 gv[2][2];
#pragma unroll
        for (int bj = 0; bj < 2; ++bj)
#pragma unroll
            for (int n = 0; n < 2; ++n) gv[bj][n] = *(const GAS f32x4*)(g1 + (size_t)b * 6144 + col0 + bj * 128 + n * 16) * gmul;
#pragma unroll
        for (int ai = 0; ai < 2; ++ai) {
            u32x2 xv[4][2][2];
#pragma unroll
            for (int m = 0; m < 4; ++m)
#pragma unroll
                for (int bj = 0; bj < 2; ++bj)
#pragma unroll
                    for (int n = 0; n < 2; ++n) xv[m][bj][n] = *(const GAS u32x2*)(X + (size_t)(u.pm * 256 + ai * 128 + wr * 64 + m * 16 + fr) * DM + col0 + bj * 128 + n * 16);
#pragma unroll
            for (int m = 0; m < 4; ++m)
#pragma unroll
                for (int bj = 0; bj < 2; ++bj)
#pragma unroll
                    for (int n = 0; n < 2; ++n) { const u32x2 xb = xv[m][bj][n]; const f32x4 o = (f32x4){bf_lo(xb.x), bf_hi(xb.x), bf_lo(xb.y), bf_hi(xb.y)} + gv[bj][n] * acc[ai][bj][m][n];
                        u32x2 w; w.x = cvt_pk_bf16(o[0], o[1]); w.y = cvt_pk_bf16(o[2], o[3]);
                        *(GAS u32x2*)(X + (size_t)(u.pm * 256 + ai * 128 + wr * 64 + m * 16 + fr) * DM + col0 + bj * 128 + n * 16) = w; }
            asm volatile("" ::: "memory");
        }
    }
};
struct EpiGU {
    static constexpr bool PERM = true; static constexpr int NVM = 8;
    unsigned char* Hd; const float* bg; const float* bu;
    struct Pre { float b; }; static constexpr int NPRE = 1;
    __device__ __forceinline__ Pre preload(const pg8::Unit& u, int wr, int wc, int fr, int fq) const {
        const int e = u.pn >> 3, pnl = u.pn & 7, hc = pnl * 128 + wc * 32 + 8 * fq; Pre p;
        p.b = __uint_as_float(ld_untracked(((fr & 8) ? bu : bg) + (size_t)e * DM + hc + (fr & 7)));
        return p;
    }
    __device__ __forceinline__ void operator()(const f32x4 (&acc)[2][2][4][2], const pg8::Unit& u, int wr, int wc, int fr, int fq, const Pre& pre) const {
        const int pnl = u.pn & 7, hc = pnl * 128 + wc * 32 + 8 * fq;
        constexpr float ds = 1.0f / (W8_SCALE * H8_SCALE);
        f32x4 bgv[2], buv[2];
        { const int base4 = (lane_id() & 48) * 4;
#pragma unroll
          for (int n = 0; n < 2; ++n)
#pragma unroll
            for (int i = 0; i < 4; ++i) { bgv[n][i] = __int_as_float(__builtin_amdgcn_ds_bpermute(base4 + (n * 4 + i) * 4, __float_as_int(pre.b)));
                                          buv[n][i] = __int_as_float(__builtin_amdgcn_ds_bpermute(base4 + (8 + n * 4 + i) * 4, __float_as_int(pre.b))); } }
#pragma unroll
        for (int ai = 0; ai < 2; ++ai)
#pragma unroll
            for (int m = 0; m < 4; ++m) {
                float hv[8];
#pragma unroll
                for (int n = 0; n < 2; ++n) { const f32x4 a4 = acc[ai][0][m][n] * ds + bgv[n], u4 = acc[ai][1][m][n] * ds + buv[n];
#pragma unroll
                    for (int i = 0; i < 4; ++i) { const float a = fminf(a4[i], 7.0f), uu = fminf(fmaxf(u4[i], -7.0f), 7.0f);
                        const float sg = __builtin_amdgcn_rcpf(1.0f + __builtin_amdgcn_exp2f(-1.702f * LOG2E * a));
                        hv[n * 4 + i] = (a * sg) * __builtin_fmaf(uu, HID8_SCALE, HID8_SCALE); } }
                u32x2 w; w.x = pk4_fp8_nc(hv[0], hv[1], hv[2], hv[3]); w.y = pk4_fp8_nc(hv[4], hv[5], hv[6], hv[7]);
                *(GAS u32x2*)(Hd + (size_t)(u.pm * 256 + ai * 128 + wr * 64 + m * 16 + fr) * DM + hc) = w; }
    }
};
struct EpiDown {
    static constexpr bool PERM = true; static constexpr int NVM = 16;
    unsigned char* Y; const float* bd; const LAS int* tab; const float* lg;
    struct Pre { float b; float g[2]; }; static constexpr int NPRE = 3;
    __device__ __forceinline__ Pre preload(const pg8::Unit& u, int wr, int wc, int fr, int fq) const {
        const int e = u.pn >> 2, pnl = u.pn & 3, col0 = pnl * 256 + wc * 32 + 8 * fq;
        const int pstart = tab[32 + e], cnt = tab[64 + e]; Pre p;
        p.b = __uint_as_float(ld_untracked(bd + (size_t)e * DM + col0 + (fr >> 3) * 128 + (fr & 7)));
#pragma unroll
        for (int ai = 0; ai < 2; ++ai) { const int i = u.pm * 256 + ai * 128 + wr * 64 + fq * 16 + fr - pstart; p.g[ai] = __uint_as_float(ld_untracked(lg + (size_t)e * LCAP + (i < cnt ? i : 0))); }
        return p;
    }
    __device__ __forceinline__ void operator()(const f32x4 (&acc)[2][2][4][2], const pg8::Unit& u, int wr, int wc, int fr, int fq, const Pre& pre) const {
        const int pnl = u.pn & 3, col0 = pnl * 256 + wc * 32 + 8 * fq;
        f32x4 bv[2][2]; float gt[2][4];
        { const int l_ = lane_id(), base4 = (l_ & 48) * 4, fr4 = (l_ & 15) * 4;
#pragma unroll
          for (int bj = 0; bj < 2; ++bj)
#pragma unroll
            for (int n = 0; n < 2; ++n)
#pragma unroll
                for (int i = 0; i < 4; ++i) bv[bj][n][i] = __int_as_float(__builtin_amdgcn_ds_bpermute(base4 + (bj * 8 + n * 4 + i) * 4, __float_as_int(pre.b)));
#pragma unroll
          for (int ai = 0; ai < 2; ++ai)
#pragma unroll
            for (int m = 0; m < 4; ++m) gt[ai][m] = __int_as_float(__builtin_amdgcn_ds_bpermute(m * 64 + fr4, __float_as_int(pre.g[ai]))); }
#pragma unroll
        for (int ai = 0; ai < 2; ++ai)
#pragma unroll
            for (int m = 0; m < 4; ++m) {
                const int row = u.pm * 256 + ai * 128 + wr * 64 + m * 16 + fr;
                {
                    unsigned char* rowp = Y + (size_t)row * DM + col0; const float g_ = gt[ai][m] * Y8_SCALE;
#pragma unroll
                    for (int bj = 0; bj < 2; ++bj) { constexpr float ds = 1.0f / (W8_SCALE * HID8_SCALE); const f32x4 v0 = (acc[ai][bj][m][0] * ds + bv[bj][0]) * g_, v1 = (acc[ai][bj][m][1] * ds + bv[bj][1]) * g_;
                        u32x2 w; w.x = pk4_fp8(v0[0], v0[1], v0[2], v0[3]); w.y = pk4_fp8(v1[0], v1[1], v1[2], v1[3]);
                        *(GAS u32x2*)(rowp + bj * 128) = w; }
                }
            }
    }
};
struct MoeSched {
    const LAS int* tab; int NTs  , NBk, G, vcu; const int* ltok;
    __device__ __forceinline__ bool next(int i, pg8::Unit& u) const {
        const int L = i * G + vcu, per = 32 << NTs, chunk = L / per, rem = L % per, pnl = rem & ((1 << NTs) - 1), rb = chunk * 32 + (rem >> NTs);
        if (rb >= NBk) return false;
        const int pe = tab[lane_id() & 31];
        const unsigned long long bal = __ballot(pe <= rb * 256);
        const int e = __popc((unsigned)bal);
        u.pm = rb; u.pn = (e << NTs) + pnl; return true;
    }
    __device__ __forceinline__ unsigned arow(const pg8::Unit& u, int r) const {
        const int e = u.pn >> NTs, i = u.pm * 256 + r - tab[32 + e];
        return (i < tab[64 + e]) ? ((unsigned)ltok[(size_t)e * LCAP + i] >> 2) : 0u;
    }
    __device__ __forceinline__ unsigned arow_raw(const pg8::Unit& u, int r) const {
        const int e = u.pn >> NTs, i = u.pm * 256 + r - tab[32 + e];
        return ld_untracked(ltok + (size_t)e * LCAP + (i < tab[64 + e] ? i : 0));
    }
};
__device__ __forceinline__ void moe_table(Frame& F, int L) {
    LAS int* tab = (LAS int*)(F.misc + MO_TAB);
    if (F.tid < 64) {
        const int e = F.tid & 31;
        const int c = (int)__hip_atomic_load((unsigned*)(F.ctl + CW_CNT + (L * NE + e) * 16), RLX_AGENT);
        int p = (c + 255) & ~255, incl = p;
#pragma unroll
        for (int e2 = 0; e2 < 31; ++e2) { const int v_ = __builtin_amdgcn_readlane(p, e2); incl += (e > e2) ? v_ : 0; }
        if (F.tid < 32) { tab[e] = incl; tab[32 + e] = incl - p; tab[64 + e] = c; if (e == 31) tab[96] = incl >> 8; }
    }
    __syncthreads();
}

namespace att {
typedef short v4i16_t __attribute__((ext_vector_type(4)));
typedef LAS const char* lds_cptr;
__device__ __forceinline__ int crow(int r, int hi) { return (r & 3) + 8 * (r >> 2) + 4 * hi; }
__device__ __forceinline__ void glds16(const void* gsrc, unsigned lds_dst) { unsigned keep;
    asm volatile("s_mov_b32 %0, m0\n\ts_mov_b32 m0, %2\n\ts_nop 0\n\tglobal_load_lds_dwordx4 %1, off\n\ts_mov_b32 m0, %0" : "=&s"(keep) : "v"(gsrc), "s"(lds_dst) : "memory"); }
__device__ __forceinline__ void glds16s(const void* sbase, unsigned voff, unsigned lds_dst) { unsigned keep;
    asm volatile("s_mov_b32 %0, m0\n\ts_mov_b32 m0, %3\n\ts_nop 0\n\tglobal_load_lds_dwordx4 %1, %2\n\ts_mov_b32 m0, %0" : "=&s"(keep) : "v"(voff), "s"(sbase), "s"(lds_dst) : "memory"); }
__device__ __forceinline__ u32x2 vtr2(lds_cptr p) { return __builtin_bit_cast(u32x2, __builtin_amdgcn_ds_read_tr16_b64_v4i16((LAS v4i16_t*)p)); }
__device__ __forceinline__ bf16x8 vcat(u32x2 lo, u32x2 hv) { return __builtin_bit_cast(bf16x8, (u32x4){lo.x, lo.y, hv.x, hv.y}); }
__device__ __forceinline__ s16x4 vtr(lds_cptr p) { return __builtin_bit_cast(s16x4, __builtin_amdgcn_ds_read_tr16_b64_v4i16((LAS v4i16_t*)p)); }
#define ATT_WAIT_BAR(N) asm volatile("s_waitcnt vmcnt(" #N ") lgkmcnt(0)\n\ts_barrier" ::: "memory")
#define ATT_MFMA(a, b, c) __builtin_amdgcn_mfma_f32_32x32x16_bf16((a), (b), (c), 0, 0, 0)
__device__ __forceinline__ bf16x8 pack8(const f32x16& p, int s) {
    u32x4 w; w.x = cvt_pk_bf16(p[8 * s + 0], p[8 * s + 1]); w.y = cvt_pk_bf16(p[8 * s + 2], p[8 * s + 3]); w.z = cvt_pk_bf16(p[8 * s + 4], p[8 * s + 5]); w.w = cvt_pk_bf16(p[8 * s + 6], p[8 * s + 7]);
    return __builtin_bit_cast(bf16x8, w);
}
__device__ __forceinline__ u32x4 pair16(u32x2 w0, u32x2 w1) {
    const auto x = __builtin_amdgcn_permlane32_swap(w0.x, w1.x, false, false);
    const auto y = __builtin_amdgcn_permlane32_swap(w0.y, w1.y, false, false);
    return (u32x4){x[0], y[0], x[1], y[1]};
}
__device__ __forceinline__ float xmax32(float v) { const auto r = __builtin_amdgcn_permlane32_swap(__float_as_uint(v), __float_as_uint(v), false, false); return fmaxf(__uint_as_float(r[0]), __uint_as_float(r[1])); }
__device__ __forceinline__ float xsum32(float v) { const auto r = __builtin_amdgcn_permlane32_swap(__float_as_uint(v), __float_as_uint(v), false, false); return __uint_as_float(r[0]) + __uint_as_float(r[1]); }
__device__ __forceinline__ float max16(const f32x16& p) {
    float a = fmaxf(fmaxf(p[0], p[1]), fmaxf(p[2], p[3])), b = fmaxf(fmaxf(p[4], p[5]), fmaxf(p[6], p[7]));
    float c = fmaxf(fmaxf(p[8], p[9]), fmaxf(p[10], p[11])), d = fmaxf(fmaxf(p[12], p[13]), fmaxf(p[14], p[15]));
    return fmaxf(fmaxf(a, b), fmaxf(c, d));
}
__device__ __forceinline__ float sum16(const f32x16& p) {
    float a = (p[0] + p[1]) + (p[2] + p[3]), b = (p[4] + p[5]) + (p[6] + p[7]), c = (p[8] + p[9]) + (p[10] + p[11]), d = (p[12] + p[13]) + (p[14] + p[15]);
    return (a + b) + (c + d);
}

constexpr int C_KSLOT = 16384, C_VRING = 65536;
#define SBAR() __builtin_amdgcn_sched_barrier(0)
#define PIN(x) asm volatile("" : "+v"(x))
#define MX3(a, b, c) __builtin_fmaxf(__builtin_fmaxf((a), (b)), (c))
#define EX2(v) __builtin_amdgcn_exp2f(v)
#define PAF(k) __builtin_bit_cast(bf16x8, pw##k)
#define VRD(i) do { vl_[i] = vtr2(vp_ + (((i) & 3) * 4096 + ((i) >> 2) * 1024)); vh_[i] = vtr2(vp_ + (((i) & 3) * 4096 + ((i) >> 2) * 1024 + 512)); } while (0)
#define VFR(i) vcat(vl_[i], vh_[i])
#define FMAMK(d, a, K, c) asm("v_fmamk_f32 %0, %1, %3, %2" : "=v"(d) : "v"(a), "v"(c), "i"(__builtin_bit_cast(int, (float)(K))))
#define ATTC_STEP(C0, C1, P0, P1, t, GK, GV, GL) do { SBAR(); \
    const lds_cptr kc_ = kp0 + (((t) & 3) << 14); float sacc = P0[0] + P0[1]; \
    kf[2] = *(const LAS bf16x8*)(KXA(kc_, 1) + 0); C0 = ATT_MFMA(kf[0], qr[0], C0); sacc += P0[2]; sacc += P0[3]; sacc += P0[4]; sacc += P0[5]; PIN(sacc); pw0[0] = cvt_pk_bf16(P0[0], P0[1]); pw0[1] = cvt_pk_bf16(P0[2], P0[3]); PIN(pw0); SBAR(); \
    kf[3] = *(const LAS bf16x8*)(KXA(kc_, 1) + 4096); C1 = ATT_MFMA(kf[1], qr[0], C1); sacc += P0[6]; sacc += P0[7]; sacc += P0[8]; sacc += P0[9]; PIN(sacc); pw0[2] = cvt_pk_bf16(P0[4], P0[5]); pw0[3] = cvt_pk_bf16(P0[6], P0[7]); PIN(pw0); SBAR(); \
    kf[4] = *(const LAS bf16x8*)(KXA(kc_, 2) + 0); C0 = ATT_MFMA(kf[2], qr[1], C0); sacc += P0[10]; sacc += P0[11]; sacc += P0[12]; sacc += P0[13]; PIN(sacc); pw1[0] = cvt_pk_bf16(P0[8], P0[9]); pw1[1] = cvt_pk_bf16(P0[10], P0[11]); PIN(pw1); SBAR(); \
    kf[5] = *(const LAS bf16x8*)(KXA(kc_, 2) + 4096); C1 = ATT_MFMA(kf[3], qr[1], C1); sacc += P0[14]; sacc += P0[15]; sacc += P1[0]; sacc += P1[1]; PIN(sacc); pw1[2] = cvt_pk_bf16(P0[12], P0[13]); pw1[3] = cvt_pk_bf16(P0[14], P0[15]); PIN(pw1); SBAR(); \
    kf[6] = *(const LAS bf16x8*)(KXA(kc_, 3) + 0); C0 = ATT_MFMA(kf[4], qr[2], C0); sacc += P1[2]; sacc += P1[3]; sacc += P1[4]; sacc += P1[5]; PIN(sacc); pw2[0] = cvt_pk_bf16(P1[0], P1[1]); pw2[1] = cvt_pk_bf16(P1[2], P1[3]); PIN(pw2); SBAR(); \
    kf[7] = *(const LAS bf16x8*)(KXA(kc_, 3) + 4096); C1 = ATT_MFMA(kf[5], qr[2], C1); sacc += P1[6]; sacc += P1[7]; sacc += P1[8]; sacc += P1[9]; PIN(sacc); pw2[2] = cvt_pk_bf16(P1[4], P1[5]); pw2[3] = cvt_pk_bf16(P1[6], P1[7]); PIN(pw2); SBAR(); \
    C0 = ATT_MFMA(kf[6], qr[3], C0); sacc += P1[10]; sacc += P1[11]; sacc += P1[12]; sacc += P1[13]; PIN(sacc); pw3[0] = cvt_pk_bf16(P1[8], P1[9]); pw3[1] = cvt_pk_bf16(P1[10], P1[11]); PIN(pw3); SBAR(); \
    C1 = ATT_MFMA(kf[7], qr[3], C1); sacc += P1[14]; sacc += P1[15]; PIN(sacc); pw3[2] = cvt_pk_bf16(P1[12], P1[13]); pw3[3] = cvt_pk_bf16(P1[14], P1[15]); PIN(pw3); SBAR(); \
    l_reg += sacc; \
    if (GK) { C_DMA_K((t) + 3, ((((t) + 3) & 3) << 14)); } if (GV) { C_DMA_V((t) + 1, sl_next); } \
    const lds_cptr vp_ = vp0 + sl_prev; const lds_cptr kn_ = kp0 + ((((t) + 1) & 3) << 14); \
    const int tn_ = (t) + 1; float sg_ = (tn_ < tm) ? slope2 : -slope2; PIN(sg_); \
    u32x2 vl_[16], vh_[16]; \
    VRD(0); VRD(1); SBAR(); \
    VRD(2); o[0] = ATT_MFMA(VFR(0), PAF(0), o[0]); float ma_ = MX3(C0[0], C0[1], C0[2]); float mb_ = MX3(C0[3], C0[4], C0[5]); ma_ = MX3(ma_, C0[6], C0[7]); mb_ = MX3(mb_, C0[8], C0[9]); PIN(ma_); PIN(mb_); SBAR(); \
    VRD(3); o[1] = ATT_MFMA(VFR(1), PAF(0), o[1]); ma_ = MX3(ma_, C0[10], C0[11]); mb_ = MX3(mb_, C0[12], C0[13]); ma_ = MX3(ma_, C0[14], C0[15]); mb_ = MX3(mb_, C1[0], C1[1]); PIN(ma_); PIN(mb_); SBAR(); \
    VRD(4); o[2] = ATT_MFMA(VFR(2), PAF(0), o[2]); ma_ = MX3(ma_, C1[2], C1[3]); mb_ = MX3(mb_, C1[4], C1[5]); ma_ = MX3(ma_, C1[6], C1[7]); mb_ = MX3(mb_, C1[8], C1[9]); PIN(ma_); PIN(mb_); SBAR(); \
    VRD(5); o[3] = ATT_MFMA(VFR(3), PAF(0), o[3]); ma_ = MX3(ma_, C1[10], C1[11]); mb_ = MX3(mb_, C1[12], C1[13]); ma_ = MX3(ma_, C1[14], C1[15]); PIN(ma_); PIN(mb_); SBAR(); \
    { float rm_ = __builtin_fmaxf(ma_, mb_); { auto rr_ = __builtin_amdgcn_permlane32_swap(__float_as_uint(rm_), __float_as_uint(rm_), false, false); rm_ = __builtin_fmaxf(__uint_as_float(rr_[0]), __uint_as_float(rr_[1])); } \
      resc = false; \
      if (__builtin_expect(__any(rm_ > 8.0f), 0)) { const float dl_ = __builtin_fmaxf(rm_, 0.f); m += dl_; \
        _Pragma("unroll") for (int r_ = 0; r_ < 16; ++r_) { C0[r_] -= dl_; C1[r_] -= dl_; } \
        fsc = __builtin_amdgcn_exp2f(-dl_); l_reg *= fsc; resc = true; rm_ -= dl_; } \
      pz = __all(rm_ < -150.0f); } \
    const float ib_ = sg_ * ((float)(64 * tn_ + 4 * hi) - qf) - m; SBAR(); \
    VRD(6); o[0] = ATT_MFMA(VFR(4), PAF(1), o[0]); C0[0] = EX2(C0[0]); C0[1] = EX2(C0[1]); C0[2] = EX2(C0[2]); FMAMK(P0[0], sg_, 0.0f, ib_); FMAMK(P0[1], sg_, 1.0f, ib_); FMAMK(P0[2], sg_, 2.0f, ib_); PIN(C0); PIN(P0); SBAR(); \
    VRD(7); o[1] = ATT_MFMA(VFR(5), PAF(1), o[1]); C0[3] = EX2(C0[3]); C0[4] = EX2(C0[4]); C0[5] = EX2(C0[5]); FMAMK(P0[3], sg_, 3.0f, ib_); FMAMK(P0[4], sg_, 8.0f, ib_); FMAMK(P0[5], sg_, 9.0f, ib_); PIN(C0); PIN(P0); SBAR(); \
    VRD(8); o[2] = ATT_MFMA(VFR(6), PAF(1), o[2]); C0[6] = EX2(C0[6]); C0[7] = EX2(C0[7]); FMAMK(P0[6], sg_, 10.0f, ib_); FMAMK(P0[7], sg_, 11.0f, ib_); PIN(C0); PIN(P0); SBAR(); \
    VRD(9); o[3] = ATT_MFMA(VFR(7), PAF(1), o[3]); C0[8] = EX2(C0[8]); C0[9] = EX2(C0[9]); C0[10] = EX2(C0[10]); FMAMK(P0[8], sg_, 16.0f, ib_); FMAMK(P0[9], sg_, 17.0f, ib_); FMAMK(P0[10], sg_, 18.0f, ib_); PIN(C0); PIN(P0); SBAR(); \
    VRD(10); o[0] = ATT_MFMA(VFR(8), PAF(2), o[0]); C0[11] = EX2(C0[11]); C0[12] = EX2(C0[12]); C0[13] = EX2(C0[13]); FMAMK(P0[11], sg_, 19.0f, ib_); FMAMK(P0[12], sg_, 24.0f, ib_); FMAMK(P0[13], sg_, 25.0f, ib_); PIN(C0); PIN(P0); SBAR(); \
    VRD(11); o[1] = ATT_MFMA(VFR(9), PAF(2), o[1]); C0[14] = EX2(C0[14]); C0[15] = EX2(C0[15]); FMAMK(P0[14], sg_, 26.0f, ib_); FMAMK(P0[15], sg_, 27.0f, ib_); PIN(C0); PIN(P0); SBAR(); \
    if (GL) { kf[0] = *(const LAS bf16x8*)(KXA(kn_, 0) + 0); } VRD(12); o[2] = ATT_MFMA(VFR(10), PAF(2), o[2]); C1[0] = EX2(C1[0]); C1[1] = EX2(C1[1]); C1[2] = EX2(C1[2]); FMAMK(P1[0], sg_, 32.0f, ib_); FMAMK(P1[1], sg_, 33.0f, ib_); FMAMK(P1[2], sg_, 34.0f, ib_); PIN(C1); PIN(P1); SBAR(); \
    if (GL) { kf[1] = *(const LAS bf16x8*)(KXA(kn_, 0) + 4096); } VRD(13); o[3] = ATT_MFMA(VFR(11), PAF(2), o[3]); C1[3] = EX2(C1[3]); C1[4] = EX2(C1[4]); C1[5] = EX2(C1[5]); FMAMK(P1[3], sg_, 35.0f, ib_); FMAMK(P1[4], sg_, 40.0f, ib_); FMAMK(P1[5], sg_, 41.0f, ib_); PIN(C1); PIN(P1); SBAR(); \
    VRD(14); o[0] = ATT_MFMA(VFR(12), PAF(3), o[0]); C1[6] = EX2(C1[6]); C1[7] = EX2(C1[7]); FMAMK(P1[6], sg_, 42.0f, ib_); FMAMK(P1[7], sg_, 43.0f, ib_); PIN(C1); PIN(P1); SBAR(); \
    VRD(15); o[1] = ATT_MFMA(VFR(13), PAF(3), o[1]); C1[8] = EX2(C1[8]); C1[9] = EX2(C1[9]); C1[10] = EX2(C1[10]); FMAMK(P1[8], sg_, 48.0f, ib_); FMAMK(P1[9], sg_, 49.0f, ib_); FMAMK(P1[10], sg_, 50.0f, ib_); PIN(C1); PIN(P1); SBAR(); \
    o[2] = ATT_MFMA(VFR(14), PAF(3), o[2]); C1[11] = EX2(C1[11]); C1[12] = EX2(C1[12]); C1[13] = EX2(C1[13]); FMAMK(P1[11], sg_, 51.0f, ib_); FMAMK(P1[12], sg_, 56.0f, ib_); FMAMK(P1[13], sg_, 57.0f, ib_); PIN(C1); PIN(P1); SBAR(); \
    o[3] = ATT_MFMA(VFR(15), PAF(3), o[3]); C1[14] = EX2(C1[14]); C1[15] = EX2(C1[15]); FMAMK(P1[14], sg_, 58.0f, ib_); FMAMK(P1[15], sg_, 59.0f, ib_); PIN(C1); PIN(P1); SBAR(); \
    if (tn_ == tm) { const float db_ = (float)(64 * tn_ + 4 * hi) - qf; \
      _Pragma("unroll") for (int r_ = 0; r_ < 16; ++r_) { const float c_ = (float)((r_ & 3) + 8 * (r_ >> 2)); \
        P0[r_] = __builtin_fmaf(-__builtin_fabsf(db_ + c_), slope2, -m); P1[r_] = __builtin_fmaf(-__builtin_fabsf(db_ + (32.f + c_)), slope2, -m); } } \
    } while (0)

__device__ __forceinline__ bool attnC_unit(const bf16_t* P, bf16_t* MX, const float* gainv  , int b, int h, int qb, float slope2, float lam, float post, LAS unsigned char* shm, int wid, int lane, int T0, int NT, volatile LAS unsigned* badw) {
    const int r32 = lane & 31, hi = lane >> 5, rg = wid & 3, mp = wid >> 2;
    const size_t rowbase = (size_t)b * SEQ;
    const int q0 = qb * 128 + rg * 32, tm = (q0 >> 6) - T0;
    const bf16_t* qp = P + (rowbase + q0 + r32) * INW + C_QC + h * 128 + mp * 64 + hi * 8;
    bf16x8 qr[4];
#pragma unroll
    for (int d0 = 0; d0 < 4; ++d0) qr[d0] = *(const GAS bf16x8*)(qp + d0 * 16);
    const bf16_t* kbase = P + (rowbase + (size_t)T0 * 64) * INW + C_KC + h * 128;
    const bf16_t* vbase = P + (rowbase + (size_t)T0 * 64) * INW + C_VC + h * 128;
    const int c4 = wid >> 1, ks0 = 2 * (wid & 1);
    const int frow = 8 * wid + (lane >> 3);
    const unsigned voffk = (unsigned)(frow * INW + (((lane & 7) ^ ((frow >> 1) & 7)) * 8)) * 2u;
    const unsigned voffv = (unsigned)((16 * ks0 + (lane >> 2)) * INW + c4 * 32 + (lane & 3) * 8) * 2u;
    const unsigned lds0 = (unsigned)(size_t)shm;
    const unsigned d_k1 = lds0 + wid * 1024, d_k2 = lds0 + 8192 + wid * 1024, d_v0 = lds0 + C_VRING + (2 * wid) * 1024, d_v1 = d_v0 + 1024;
#define C_DMA_K(t, slot) do { const bf16_t* _b = kbase + (size_t)(t) * 64 * INW; \
        glds16s(_b, voffk, (unsigned)__builtin_amdgcn_readfirstlane(d_k1 + (slot))); glds16s(_b + 64, voffk, (unsigned)__builtin_amdgcn_readfirstlane(d_k2 + (slot))); } while (0)
#define C_DMA_V(t, slot) do { const bf16_t* _b = vbase + (size_t)(t) * 64 * INW; \
        glds16s(_b, voffv, (unsigned)__builtin_amdgcn_readfirstlane(d_v0 + (slot))); glds16s(_b + 16 * INW, voffv, (unsigned)__builtin_amdgcn_readfirstlane(d_v1 + (slot))); } while (0)
    const lds_cptr shm3 = (lds_cptr)shm;
    const lds_cptr kp0 = shm3 + mp * 8192 + r32 * 128 + ((hi ^ ((r32 >> 1) & 7)) * 16);
#define KXA(base, d0) ((lds_cptr)(size_t)((unsigned)(size_t)(base) ^ (unsigned)((d0) << 5)))
    const lds_cptr vp0 = shm3 + C_VRING + ((lane >> 4) & 1) * 32 + (lane & 3) * 8 + (4 * hi + ((lane & 15) >> 2)) * 64;
    if (C_TILE_SKIP == 1 && wid == 0 && lane == 0) *badw = 0u;
    C_DMA_K(0, 0); C_DMA_V(0, 0); C_DMA_K(1, C_KSLOT);
    float m = 0.f, l_reg = 0.f, fsc = 1.f; bool resc = false, pz = false; (void)pz;
    f32x16 o[4];
#pragma unroll
    for (int c = 0; c < 4; ++c)
#pragma unroll
        for (int r = 0; r < 16; ++r) o[c][r] = 0.f;
    const float qf = (float)(q0 + r32 - 64 * T0);
    f32x16 pA0, pA1, pB0, pB1; bf16x8 kf[8]; u32x4 pw0, pw1, pw2, pw3;
    int sl_prev = 0, sl_cur = 0, sl_next = C_KSLOT;
#define C_ROT() do { sl_prev = sl_cur; sl_cur = sl_next; sl_next = (sl_next == 2 * C_KSLOT) ? 0 : sl_next + C_KSLOT; } while (0)
#define C_RESC() do { if (resc) { _Pragma("unroll") for (int c_ = 0; c_ < 4; ++c_) _Pragma("unroll") for (int r_ = 0; r_ < 16; ++r_) o[c_][r_] *= fsc; } } while (0)
#define C_INIT(X0, X1, tn) do { const float db_ = (float)(64 * (tn) + 4 * hi) - qf; \
        _Pragma("unroll") for (int r_ = 0; r_ < 16; ++r_) { const float c_ = (float)((r_ & 3) + 8 * (r_ >> 2)); \
            X0[r_] = __builtin_fmaf(-__builtin_fabsf(db_ + c_), slope2, -m); X1[r_] = __builtin_fmaf(-__builtin_fabsf(db_ + (32.f + c_)), slope2, -m); } } while (0)
#define C_KLOAD8(kp) do { _Pragma("unroll") for (int j_ = 0; j_ < 8; ++j_) kf[j_] = *(const LAS bf16x8*)(KXA((kp), j_ >> 1) + (j_ & 1) * 4096); } while (0)
    C_DMA_K(2, 2 * C_KSLOT);
    C_INIT(pA0, pA1, 0);
    ATT_WAIT_BAR(6);
    C_KLOAD8(kp0);
#pragma unroll
    for (int i = 0; i < 8; ++i) { if (i & 1) pA1 = ATT_MFMA(kf[i], qr[i >> 1], pA1); else pA0 = ATT_MFMA(kf[i], qr[i >> 1], pA0); }
    { float rm = fmaxf(max16(pA0), max16(pA1)); rm = xmax32(rm);
      if (__any(rm > 8.0f)) { const float dl = fmaxf(rm, 0.f); m += dl;
#pragma unroll
          for (int r = 0; r < 16; ++r) { pA0[r] -= dl; pA1[r] -= dl; } }
#pragma unroll
      for (int r = 0; r < 16; ++r) { pA0[r] = EX2(pA0[r]); pA1[r] = EX2(pA1[r]); } }
    ATT_WAIT_BAR(0);
    C_DMA_K(3, 3 * C_KSLOT); C_DMA_V(1, C_KSLOT);
    C_ROT();
    { const lds_cptr k1_ = kp0 + C_KSLOT; kf[0] = *(const LAS bf16x8*)(k1_); kf[1] = *(const LAS bf16x8*)(k1_ + 4096); }
    C_INIT(pB0, pB1, 1);
    if (wid >= 4) __builtin_amdgcn_s_setprio(1);
    int t = 1;
    for (; t + 5 < NT; t += 2) {
        ATTC_STEP(pB0, pB1, pA0, pA1, t, true, true, true);     ATT_WAIT_BAR(4); C_RESC(); C_ROT();
        ATTC_STEP(pA0, pA1, pB0, pB1, t + 1, true, true, true); ATT_WAIT_BAR(4); C_RESC(); C_ROT();
    }
#define C_ENDW(tt) do { if ((tt) + 3 < NT) { ATT_WAIT_BAR(4); } else if ((tt) + 2 < NT) { ATT_WAIT_BAR(2); } else { ATT_WAIT_BAR(0); } } while (0)
    for (; t + 1 < NT; t += 2) {
        ATTC_STEP(pB0, pB1, pA0, pA1, t, (t + 3 < NT), (t + 1 < NT), (t + 1 < NT));         C_ENDW(t);     C_RESC(); C_ROT();
        ATTC_STEP(pA0, pA1, pB0, pB1, t + 1, (t + 4 < NT), (t + 2 < NT), (t + 2 < NT));     C_ENDW(t + 1); C_RESC(); C_ROT();
    }
    ATTC_STEP(pB0, pB1, pA0, pA1, NT - 1, false, false, false); C_RESC();
    __builtin_amdgcn_s_setprio(0);
    { l_reg += sum16(pB0) + sum16(pB1);
      const bf16x8 q0_ = pack8(pB0, 0), q1_ = pack8(pB0, 1), q2_ = pack8(pB1, 0), q3_ = pack8(pB1, 1);
      const lds_cptr vp = vp0 + sl_cur;
#pragma unroll
      for (int c = 0; c < 4; ++c)
#pragma unroll
          for (int s = 0; s < 4; ++s) {
              const bf16x8 vf = vcat(vtr2(vp + c * 4096 + s * 1024), vtr2(vp + c * 4096 + s * 1024 + 512));
              o[c] = ATT_MFMA(vf, s == 0 ? q0_ : s == 1 ? q1_ : s == 2 ? q2_ : q3_, o[c]);
          } }
    if (C_TILE_SKIP == 1 && NT < SEQ / 64) {
        const int NF = SEQ / 64 - NT;
        ATT_WAIT_BAR(0);
#define C_FAR(i) (((i) < T0) ? (i) - T0 : (i) - T0 + NT)
#define C_DMA_KF(trel, slot) do { const bf16_t* _b = kbase + (ptrdiff_t)(trel) * 64 * INW; \
        glds16s(_b, voffk, (unsigned)__builtin_amdgcn_readfirstlane(d_k1 + (slot))); glds16s(_b + 64, voffk, (unsigned)__builtin_amdgcn_readfirstlane(d_k2 + (slot))); } while (0)
        const int NP = NF >> 1;
        C_DMA_KF(C_FAR(0), 0); C_DMA_KF(C_FAR(1), C_KSLOT);
        if (NP > 1) { C_DMA_KF(C_FAR(2), 2 * C_KSLOT); C_DMA_KF(C_FAR(3), 3 * C_KSLOT); }
        bool badl = false;
        int s0 = 0, s2 = 4 * C_KSLOT;
        for (int p = 0; p < NP; ++p) {
            if (p + 1 < NP) { ATT_WAIT_BAR(4); } else { ATT_WAIT_BAR(0); }
            if (p + 2 < NP) { C_DMA_KF(C_FAR(2 * p + 4), s2); C_DMA_KF(C_FAR(2 * p + 5), s2 + C_KSLOT); }
            f32x16 c[2][2];
#pragma unroll
            for (int u = 0; u < 2; ++u)
#pragma unroll
                for (int r = 0; r < 16; ++r) { c[u][0][r] = 0.f; c[u][1][r] = 0.f; }
#pragma unroll
            for (int j = 0; j < 8; ++j)
#pragma unroll
                for (int u = 0; u < 2; ++u) { const bf16x8 kfj = *(const LAS bf16x8*)(KXA(kp0 + s0 + u * C_KSLOT, j >> 1) + (j & 1) * 4096);
                    c[u][j & 1] = ATT_MFMA(kfj, qr[j >> 1], c[u][j & 1]); }
#pragma unroll
            for (int u = 0; u < 2; ++u) {
                const int trel = C_FAR(2 * p + u);
                const float dmin = (trel < tm) ? (qf - (float)(64 * trel + 63)) : ((float)(64 * trel) - qf);
                badl |= !(fmaxf(max16(c[u][0]), max16(c[u][1])) - slope2 * dmin - m < -150.0f);
            }
            s0 = (s0 == 4 * C_KSLOT) ? 0 : s0 + 2 * C_KSLOT; s2 = (s2 == 4 * C_KSLOT) ? 0 : s2 + 2 * C_KSLOT;
        }
        if (__any(badl) && lane == 0) *badw = 1u;
#undef C_FAR
#undef C_DMA_KF
    }
#undef C_DMA_K
#undef C_DMA_V
#undef C_ROT
#undef C_RESC
#undef C_INIT
#undef C_KLOAD8
#undef KXA
#undef C_ENDW
    float l = xsum32(l_reg);
    const float inv = 1.0f / l;
    ATT_WAIT_BAR(0);
    LAS float* x2 = (LAS float*)shm + rg * 4096;
    if (mp == 1) {
        const float sc = inv * lam;
#pragma unroll
        for (int c = 0; c < 4; ++c)
#pragma unroll
            for (int r = 0; r < 16; ++r) x2[(c * 16 + r) * 64 + lane] = o[c][r] * sc;
    }
    ATT_WAIT_BAR(0);
    if (mp == 0) {
        float ss = 0.f;
#pragma unroll
        for (int c = 0; c < 4; ++c)
#pragma unroll
            for (int r = 0; r < 16; ++r) { const float v = o[c][r] * inv - x2[(c * 16 + r) * 64 + lane]; o[c][r] = v; ss += v * v; }
        ss = xsum32(ss);
        const float rn = post / sqrtf(ss * (1.0f / 128.0f) + RMS_EPS);
        bf16_t* op = MX + (rowbase + q0 + r32) * DM + 512 + h * 128;
#pragma unroll
        for (int c = 0; c < 4; ++c)
#pragma unroll
            for (int g = 0; g < 4; g += 2) { const f32x4 gv0 = *(const GAS f32x4*)(gainv + 32 * c + 8 * g + 4 * hi), gv1 = *(const GAS f32x4*)(gainv + 32 * c + 8 * g + 8 + 4 * hi);
                u32x2 w0, w1;
                w0.x = cvt_pk_bf16(o[c][4 * g + 0] * rn * gv0.x, o[c][4 * g + 1] * rn * gv0.y); w0.y = cvt_pk_bf16(o[c][4 * g + 2] * rn * gv0.z, o[c][4 * g + 3] * rn * gv0.w);
                w1.x = cvt_pk_bf16(o[c][4 * g + 4] * rn * gv1.x, o[c][4 * g + 5] * rn * gv1.y); w1.y = cvt_pk_bf16(o[c][4 * g + 6] * rn * gv1.z, o[c][4 * g + 7] * rn * gv1.w);
                *(GAS u32x4*)(op + 32 * c + 8 * (g + hi)) = pair16(w0, w1); }
    }
    VM_WAIT();
    const bool bad = (C_TILE_SKIP == 1) && (*badw != 0u);
    ATT_WAIT_BAR(0);
    return bad;
}
#undef SBAR
#undef PIN
#undef MX3
#undef EX2
#undef PAF
#undef VRD
#undef VFR
#undef FMAMK

template <int MODE> __device__ __forceinline__ void band_desc(int n, int q0, int& kb, int& ks, int& W) {
    if (MODE == 1) { if (n < 3) { kb = q0 - 1024 + 1024 * n; ks = 16; W = 1024; } else { kb = q0 - 256 + 256 * (n - 3); ks = 4; W = 256; } }
    else if (MODE == 2) { kb = q0 - 64 + 64 * n; ks = 1; W = 64; }
    else { kb = q0 - 128 + 64 * n; ks = 1; W = 128; }
}
constexpr int BK_S = 1056, BV_OFF = 8 * BK_S, BV_S = 4224;
template <int MODE, int NQ>
__device__ __forceinline__ void band_task(const bf16_t* P, size_t rowbase, int kcol, int vcol, int q0, const float (&slope2)[NQ], int qtok,
                                          const bf16_t* const (&qp)[NQ]  , float (&m)[NQ], float (&l)[NQ], f32x16 (&o)[NQ][2], LAS unsigned char* wl, int lane_in) {
    const int lane = lane_id(); (void)lane_in;
    const int r32 = lane & 31, hi = lane >> 5;
    const unsigned kbase_l = (unsigned)(size_t)((lds_cptr)wl + r32 * 128 + ((hi ^ ((r32 >> 1) & 7)) * 16));
    const lds_cptr vp = (lds_cptr)wl + BV_OFF + ((lane >> 4) & 1) * 32 + (lane & 3) * 8 + (4 * hi + ((lane & 15) >> 2)) * 64;
    const unsigned ldsk = (unsigned)(size_t)wl;
    const float qf = (float)qtok;
    constexpr int NTL = MODE == 1 ? 7 : (MODE == 2 ? 3 : 5);
    unsigned mask = 0u;
#pragma unroll
    for (int n = 0; n < NTL; ++n) { int kb, ks, W; band_desc<MODE>(n, q0, kb, ks, W); if (!(kb + ks * 63 < 0 || kb >= SEQ)) mask |= 1u << n; }
    if (!mask) return;
    u32x4 vr[8];
    const int lrow = lane >> 3, lch = lane & 7;
    LAS unsigned char* vw = wl + BV_OFF + (lch >> 2) * BV_S + lrow * 64 + (lch & 3) * 16;
    const bf16_t* kgb = P + rowbase * INW + kcol; const char* vgb = (const char*)(P + rowbase * INW + vcol);
#define BAND_DMAK(n_) do { int kb_, ks_, W_; band_desc<MODE>((n_), q0, kb_, ks_, W_); \
        _Pragma("unroll") for (int i = 0; i < 8; ++i) { const int row_ = lrow + 8 * i; int kt = kb_ + ks_ * row_; kt = kt < 0 ? 0 : (kt > SEQ - 1 ? SEQ - 1 : kt); \
            glds16s(kgb, (unsigned)(kt * INW + ((lch ^ ((row_ >> 1) & 7)) * 8)) * 2u, (unsigned)__builtin_amdgcn_readfirstlane(ldsk + i * 1024)); } } while (0)
#define BAND_LOADV(n_) do { int kb_, ks_, W_; band_desc<MODE>((n_), q0, kb_, ks_, W_); \
        _Pragma("unroll") for (int i = 0; i < 8; ++i) { int kt = kb_ + ks_ * (lrow + 8 * i); kt = kt < 0 ? 0 : (kt > SEQ - 1 ? SEQ - 1 : kt); \
            vr[i] = *(const GAS u32x4*)(vgb + (unsigned)((kt * INW + lch * 8) * 2)); } } while (0)
    bf16x8 qr[4];
    if (NQ == 1) {
#pragma unroll
        for (int d0 = 0; d0 < 4; ++d0) qr[d0] = *(const GAS bf16x8*)(qp[0] + d0 * 16); }
    LDS_WAIT();
    { const int n0 = __builtin_ctz(mask); BAND_DMAK(n0); BAND_LOADV(n0); }
    while (mask) {
        const int n = __builtin_ctz(mask); mask &= mask - 1u;
        const int nn = mask ? __builtin_ctz(mask) : -1;
        int kb, ks, W; band_desc<MODE>(n, q0, kb, ks, W);
        float ksf = (float)ks; asm volatile("" : "+v"(ksf));
        const float dlo = fmaxf(-qf, -(float)W), dhi = fminf((float)W, (float)(SEQ - 1) - qf);
        VM_WAIT();
#pragma unroll
        for (int i = 0; i < 8; ++i) *(LAS u32x4*)(vw + i * 512) = vr[i];
        if (nn >= 0) BAND_LOADV(nn);
        const float dbase = (float)kb - qf + ksf * (float)(4 * hi);
#pragma unroll
        for (int qi = 0; qi < NQ; ++qi) {
            if (NQ > 1) {
#pragma unroll
                for (int d0 = 0; d0 < 4; ++d0) qr[d0] = *(const GAS bf16x8*)(qp[qi] + d0 * 16); }
            f32x16 p0, p1;
#pragma unroll
            for (int r = 0; r < 16; ++r) { p0[r] = 0.f; p1[r] = 0.f; }
#pragma unroll
            for (int d0 = 0; d0 < 4; ++d0) { const lds_cptr ka_ = (lds_cptr)(size_t)(kbase_l ^ (unsigned)(d0 << 5));
                const bf16x8 a0 = *(const LAS bf16x8*)(ka_), a1 = *(const LAS bf16x8*)(ka_ + 4096);
                p0 = ATT_MFMA(a0, qr[d0], p0); p1 = ATT_MFMA(a1, qr[d0], p1);
            }
            if (qi == NQ - 1 && nn >= 0) { LDS_WAIT(); BAND_DMAK(nn); }
#pragma unroll
            for (int r = 0; r < 16; ++r) { const float c = (float)((r & 3) + 8 * (r >> 2));
                const float d0 = __builtin_fmaf(ksf, c, dbase), d1 = __builtin_fmaf(ksf, 32.f + c, dbase);
                p0[r] = (d0 >= dlo && d0 <= dhi) ? __builtin_fmaf(-__builtin_fabsf(d0), slope2[qi], p0[r]) : -INFINITY;
                p1[r] = (d1 >= dlo && d1 <= dhi) ? __builtin_fmaf(-__builtin_fabsf(d1), slope2[qi], p1[r]) : -INFINITY; }
            float mx = fmaxf(max16(p0), max16(p1));
            mx = xmax32(mx);
            if (__any(mx > m[qi] + 8.0f)) {
                const float mn = fmaxf(m[qi], mx), f = __builtin_amdgcn_exp2f(m[qi] - mn);
                l[qi] *= f; m[qi] = mn;
#pragma unroll
                for (int c = 0; c < 2; ++c)
#pragma unroll
                    for (int r = 0; r < 16; ++r) o[qi][c][r] *= f;
            }
#pragma unroll
            for (int r = 0; r < 16; ++r) { p0[r] = __builtin_amdgcn_exp2f(p0[r] - m[qi]); p1[r] = __builtin_amdgcn_exp2f(p1[r] - m[qi]); }
            l[qi] += sum16(p0) + sum16(p1);
            bf16x8 pw[4]; pw[0] = pack8(p0, 0); pw[1] = pack8(p0, 1); pw[2] = pack8(p1, 0); pw[3] = pack8(p1, 1);
#pragma unroll
            for (int c = 0; c < 2; ++c)
#pragma unroll
                for (int s = 0; s < 4; ++s) {
                    const bf16x8 vf = vcat(vtr2(vp + c * BV_S + s * 1024), vtr2(vp + c * BV_S + s * 1024 + 512));
                    o[qi][c] = ATT_MFMA(vf, pw[s], o[qi][c]);
                }
        }
    }
#undef BAND_DMAK
#undef BAND_LOADV
}
__device__ __forceinline__ void band_store(bf16_t* op  , int hi, const f32x16 (&o)[2], float inv) {
#pragma unroll
    for (int c = 0; c < 2; ++c)
#pragma unroll
        for (int g = 0; g < 4; g += 2) { u32x2 w0, w1;
            w0.x = cvt_pk_bf16(o[c][4 * g + 0] * inv, o[c][4 * g + 1] * inv); w0.y = cvt_pk_bf16(o[c][4 * g + 2] * inv, o[c][4 * g + 3] * inv);
            w1.x = cvt_pk_bf16(o[c][4 * g + 4] * inv, o[c][4 * g + 5] * inv); w1.y = cvt_pk_bf16(o[c][4 * g + 6] * inv, o[c][4 * g + 7] * inv);
            *(GAS u32x4*)(op + 32 * c + 8 * (g + hi)) = pair16(w0, w1); }
}
}

template <int DAB, int DC>
__device__ __forceinline__ void p3_attention(Frame& F, int L) {
    const int lane = F.lane, r32 = lane & 31, hi = lane >> 5, wid = F.wave;
    LAS unsigned char* wl = F.lds + wid * BAND_WL;
    for (int rep = 0; rep < DAB; ++rep) {
    for (int bt = F.vcu; bt < NBATCH * 4 * 16; bt += F.G) {
        const int b = bt >> 6, h = (bt >> 4) & 3, blk = bt & 15;
        const float sl1[1] = {__builtin_amdgcn_exp2f(-2.0f * (float)(h + 1)) * LOG2E};
        const size_t rowbase = (size_t)b * SEQ;
        for (int rr = 0; rr < 2; ++rr) {
            const int lane = lane_id(), r32 = lane & 31, hi = lane >> 5;
            const int q0 = blk * 512 + rr * 8 + wid, qtok = q0 + 16 * r32;
            const bf16_t* const qp[1] = {F.PROJ + (rowbase + qtok) * INW + C_QA + h * 64 + hi * 8};
            float m[1] = {-1e30f}, l[1] = {0.f}; f32x16 o[1][2];
#pragma unroll
            for (int c = 0; c < 2; ++c)
#pragma unroll
                for (int r = 0; r < 16; ++r) o[0][c][r] = 0.f;
            att::band_task<1, 1>(F.PROJ, rowbase, C_KA + h * 64, C_VA + h * 64, q0, sl1, qtok, qp, m, l, o, wl, lane);
            float* pp = F.part + ((rowbase + qtok) * 4 + h) * 68;
#pragma unroll
            for (int c = 0; c < 2; ++c)
#pragma unroll
                for (int g = 0; g < 4; ++g) *(GAS f32x4*)(pp + 32 * c + 8 * g + 4 * hi) = (f32x4){o[0][c][4 * g], o[0][c][4 * g + 1], o[0][c][4 * g + 2], o[0][c][4 * g + 3]};
            if (hi == 0) pp[64] = m[0];
            pp[65 + hi] = l[0];
        }
        VM_WAIT(); __syncthreads(); __builtin_amdgcn_fence(__ATOMIC_ACQUIRE, "agent"); VM_WAIT();
        for (int rr = 0; rr < 2; ++rr) {
            const int lane = lane_id(), r32 = lane & 31, hi = lane >> 5;
            const int q0 = blk * 512 + (rr * 8 + wid) * 32, qtok = q0 + r32;
            const bf16_t* const qp[1] = {F.PROJ + (rowbase + qtok) * INW + C_QA + h * 64 + hi * 8};
            const float* pp = F.part + ((rowbase + qtok) * 4 + h) * 68;
            f32x16 o[1][2];
#pragma unroll
            for (int c = 0; c < 2; ++c)
#pragma unroll
                for (int g = 0; g < 4; ++g) { const f32x4 t = *(const GAS f32x4*)(pp + 32 * c + 8 * g + 4 * hi); o[0][c][4 * g] = t[0]; o[0][c][4 * g + 1] = t[1]; o[0][c][4 * g + 2] = t[2]; o[0][c][4 * g + 3] = t[3]; }
            float m[1] = {pp[64]}, l[1] = {pp[65 + hi]};
            att::band_task<2, 1>(F.PROJ, rowbase, C_KA + h * 64, C_VA + h * 64, q0, sl1, qtok, qp, m, l, o, wl, lane);
            att::band_store(F.MIXED + (rowbase + qtok) * DM + h * 64, hi, o[0], 1.0f / att::xsum32(l[0]));
        }
        __syncthreads();
    }
    for (int bt = F.vcu; bt < NBATCH * 2 * 32; bt += F.G) {
        const int b = bt >> 6, hk = (bt >> 5) & 1, blk = bt & 31;
        const size_t rowbase = (size_t)b * SEQ;
        const int lane = lane_id(), r32 = lane & 31, hi = lane >> 5;
        const int q0 = blk * 256 + wid * 32, qtok = q0 + r32;
        float sl2[2], m[2], l[2]; f32x16 o[2][2];
        const bf16_t* const qp[2] = {F.PROJ + (rowbase + qtok) * INW + C_QB + (2 * hk) * 64 + hi * 8, F.PROJ + (rowbase + qtok) * INW + C_QB + (2 * hk + 1) * 64 + hi * 8};
#pragma unroll
        for (int g = 0; g < 2; ++g) { const int hq = 2 * hk + g;
            sl2[g] = __builtin_amdgcn_exp2f(-2.0f * (float)(hq + 1)) * LOG2E;
            m[g] = F.sinks[L * 4 + hq] * LOG2E; l[g] = 0.5f;
#pragma unroll
            for (int c = 0; c < 2; ++c)
#pragma unroll
                for (int r = 0; r < 16; ++r) o[g][c][r] = 0.f; }
        att::band_task<0, 2>(F.PROJ, rowbase, C_KB + hk * 64, C_VB + hk * 64, q0, sl2, qtok, qp, m, l, o, wl, lane);
#pragma unroll
        for (int g = 0; g < 2; ++g) att::band_store(F.MIXED + (rowbase + qtok) * DM + 256 + (2 * hk + g) * 64, hi, o[g], 1.0f / att::xsum32(l[g]));
    }
    }
    VM_WAIT(); LDS_WAIT();
    __syncthreads();
    {
        float lam_init = 0.8f - 0.6f * __expf(-0.3f * (float)L);
        const float s1 = wave_sum(F.lq1[L * 64 + lane] * F.lk1[L * 64 + lane]), s2 = wave_sum(F.lq2[L * 64 + lane] * F.lk2[L * 64 + lane]);
        const float lam = __expf(s1) - __expf(s2) + lam_init;
        for (int rep = 0; rep < DC; ++rep)
        for (int uid = F.vcu; uid < 2048; uid += F.G) {
            const int i = uid >> 8, v = uid & 255, bh = 4 * (v >> 5) + (i >> 1), qb = (i & 1) * 32 + (v & 31), b = bh >> 2, h = bh & 3;
            const float slope2 = __builtin_amdgcn_exp2f(-2.0f * (float)(h + 1)) * LOG2E;
            int T0 = 0, NT = SEQ / 64;
            if (C_TILE_SKIP) {
                const unsigned* nq = (const unsigned*)(F.ctl + CW_NRM + L * 256) + (b * 2 + 0) * 16 + h * 4; const unsigned* nk = nq + 16;
                float R2 = 0.f;
#pragma unroll
                for (int c = 0; c < 2; ++c) R2 = fmaxf(R2, sqrtf(__uint_as_float(nq[c * 2]) * __uint_as_float(nk[c * 2])) + sqrtf(__uint_as_float(nq[c * 2 + 1]) * __uint_as_float(nk[c * 2 + 1])));
                const float Dstar = (C_TILE_SKIP == 1) ? (150.0f + 8.0f + 0.4f * R2) / slope2
                                                       : (120.0f * LOG2E + 2.0f * 1.02f * R2) / slope2;
                if (Dstar < 16384.f) {
                    const int D = (int)Dstar + 1, qlo = qb * 128, qhi = qb * 128 + 127;
                    int tlo = (qlo - D - 63 + 63) / 64; if (qlo - D - 63 <= 0) tlo = 0;
                    int thi = (qhi + D) / 64; if (thi > SEQ / 64 - 1) thi = SEQ / 64 - 1;
                    if (((thi - tlo + 1) & 1) != 0) { if (tlo > 0) --tlo; else ++thi; }
                    if (thi > SEQ / 64 - 1) { thi = SEQ / 64 - 1; if (((thi - tlo + 1) & 1) != 0) --tlo; }
                    if (thi - tlo + 1 >= 4 && tlo >= 0) { T0 = tlo; NT = thi - tlo + 1; }
                }
            }
            volatile LAS unsigned* badw = (volatile LAS unsigned*)(F.misc + MO_HIST);
            const bool bad = att::attnC_unit(F.PROJ, F.MIXED, F.subln + L * 128, b, h, qb, slope2, lam, 1.0f - lam_init, F.lds, wid, lane, T0, NT, badw);
            if (bad) (void)att::attnC_unit(F.PROJ, F.MIXED, F.subln + L * 128, b, h, qb, slope2, lam, 1.0f - lam_init, F.lds, wid, lane, 0, SEQ / 64, badw);
        }
    }
}

struct Args { const float* in[23]; float* out; unsigned char* ws; };
typedef const __attribute__((address_space(4))) Args* kargs_t;
__device__ __forceinline__ void refresh(Frame& F) {
    kargs_t ap = (kargs_t)__builtin_amdgcn_kernarg_segment_ptr(); asm volatile("" : "+s"(ap));
    int w = F.wave0; asm volatile("" : "+s"(w)); int l = lane_id(); asm volatile("" : "+v"(l));
    F.tid = w * 64 + l; F.lane = l; F.wave = w;
    unsigned char* ws = ap->ws;
    F.ctl = (gu32*)(ws + WS_CTL);
    F.x_in = ap->in[0]; F.c_in = ap->in[1]; F.w_ada = ap->in[2]; F.b_ada = ap->in[3]; F.norm1 = ap->in[4]; F.w_in = ap->in[5]; F.sinks = ap->in[6];
    F.lq1 = ap->in[7]; F.lk1 = ap->in[8]; F.lq2 = ap->in[9]; F.lk2 = ap->in[10]; F.subln = ap->in[11]; F.w_out = ap->in[12]; F.norm2 = ap->in[13];
    F.w_router = ap->in[14]; F.b_router = ap->in[15]; F.w_gate = ap->in[16]; F.b_gate = ap->in[17]; F.w_up = ap->in[18]; F.b_up = ap->in[19];
    F.w_down = ap->in[20]; F.b_down = ap->in[21]; F.norm_f = ap->in[22]; F.out = ap->out;
    F.modp = (float*)(ws + WS_MODP); F.mod = (float*)(ws + WS_MOD); F.ltok = (int*)(ws + WS_LTOK); F.lg = (float*)(ws + WS_LG);
    F.WIN = (bf16_t*)(ws + WS_WIN); F.WOUT = (bf16_t*)(ws + WS_WOUT); F.WGU = (bf16_t*)(ws + WS_WGU); F.WDN = (bf16_t*)(ws + WS_WDN);
    F.H = (bf16_t*)(ws + WS_H); F.PROJ = (bf16_t*)(ws + WS_R1); F.MIXED = (bf16_t*)(ws + WS_MIXED); F.HIDDEN = (bf16_t*)(ws + WS_R1); F.Y = (bf16_t*)(ws + WS_Y); F.XB = (bf16_t*)(ws + WS_XB); F.part = (float*)(ws + WS_PART); F.inv = (int*)(ws + WS_INV);
}
__global__ void __launch_bounds__(NTHREADS, 2) fwd_kernel(Args args) {
    extern __shared__ __attribute__((aligned(16))) unsigned char lds[];
    Frame F;
    F.lds = (LAS unsigned char*)lds; F.misc = F.lds + MISC_OFF;
    F.wave0 = __builtin_amdgcn_readfirstlane((int)threadIdx.x >> 6);
    F.G = gridDim.x; { const int bx = blockIdx.x; F.vcu = (F.G % 8 == 0) ? (bx % 8) * (F.G / 8) + bx / 8 : bx; }
    refresh(F);
    for (int u = F.tid; u < 256; u += NTHREADS) ((LAS unsigned*)F.misc)[u] = 0u;
    __syncthreads();
    XcdBarrier bar = xcd_barrier_post((unsigned*)(F.ctl + CW_BAR), (volatile LAS unsigned*)(F.misc + MO_BAR));
    (void)bar;
#define GRID_BAR() do { kargs_t ap_ = (kargs_t)__builtin_amdgcn_kernarg_segment_ptr(); asm volatile("" : "+s"(ap_)); XcdBarrier b_; \
        b_.bar = (unsigned*)(ap_->ws + WS_CTL) + CW_BAR; b_.x = xb_xcc_id(); b_.st = (volatile LAS unsigned*)(F.misc + MO_BAR); xcd_barrier(b_); } while (0)

#ifndef PH_MASK
#define PH_MASK 0xffff
#endif
#define PH(k) ((PH_MASK >> (k)) & 1)
#ifndef DUP_MASK
#define DUP_MASK 0
#endif
#define DUP(k) (1 + ((DUP_MASK >> (k)) & 1))
    if (PH(0)) { for (int rep = 0; rep < DUP(0); ++rep) { p0_prologue(F); __syncthreads(); } GRID_BAR();
    refresh(F); p0b_modsum(F); GRID_BAR(); }
    for (int L = 0; L < DEPTH; ++L) {
        refresh(F);
        if (PH(1)) { if (L == 0) p1_rows<0>(F, L); else p1_rows<1>(F, L); if (DUP(6) > 1) { __syncthreads(); if (L == 0) p1_rows<0>(F, L); else p1_rows<1>(F, L, 0.0f); } }
        const bool own_panels = false;
        if (own_panels) { VM_WAIT(); __syncthreads(); __builtin_amdgcn_fence(__ATOMIC_ACQUIRE, "agent"); VM_WAIT(); } else { GRID_BAR(); }
        refresh(F);
        if (PH(2)) for (int rep = 0; rep < DUP(1); ++rep) { pg8::Gemm g{F.H, F.WIN + (size_t)L * INW * DM, DM}; EpiProj E{F.PROJ, (unsigned*)(F.ctl + CW_NRM + L * 256)};
          if (own_panels) { pg8::PanelOrder S{INW / 256, NTOK / 256, F.G, F.vcu}; pg8::gemm_phase<EpiProj, pg8::PanelOrder, false>(F.lds, g, S, E, F.wave); }
          else { pg8::StaticOrder S; S.init(NTOK, INW, F.G, (int)blockIdx.x); pg8::gemm_phase<EpiProj, pg8::StaticOrder, false>(F.lds, g, S, E, F.wave); } }
        GRID_BAR();
        refresh(F);
        if (PH(3)) p3_attention<DUP(2), DUP(3)>(F, L);
        GRID_BAR();
        refresh(F);
        const bool own_panels4 = (F.G == NTOK / 256);
        if (PH(4)) for (int rep = 0; rep < DUP(7); ++rep) { pg8::Gemm g{F.MIXED, F.WOUT + (size_t)L * DM * DM, DM}; EpiOut E{F.XB, F.mod + (size_t)L * NBATCH * 6144 + 2 * DM, rep ? 0.0f : 1.0f};
          if (own_panels4) { pg8::PanelOrder S{DM / 256, NTOK / 256, F.G, F.vcu}; pg8::gemm_phase<EpiOut, pg8::PanelOrder, false>(F.lds, g, S, E, F.wave); }
          else { pg8::StaticOrder S; S.init(NTOK, DM, F.G, (int)blockIdx.x); pg8::gemm_phase<EpiOut, pg8::StaticOrder, false>(F.lds, g, S, E, F.wave); } }
        if (own_panels4) { VM_WAIT(); __syncthreads(); __builtin_amdgcn_fence(__ATOMIC_ACQUIRE, "agent"); VM_WAIT(); } else { GRID_BAR(); }
        refresh(F);
        if (PH(5)) { p5_route(F, L, L); if (DUP(8) > 1) { __syncthreads(); p5_route(F, L, L + 4); } }
        GRID_BAR();
        refresh(F);
        moe_table(F, L);
        if (PH(7)) for (int rep = 0; rep < DUP(4); ++rep) { const LAS int* tab = (const LAS int*)(F.misc + MO_TAB);
          pg8::Gemm g{F.H, (const bf16_t*)((const unsigned char*)F.WGU + (size_t)L * NE * 2048 * DM), DM / 2}; MoeSched S{tab, 3, tab[96], F.G, F.vcu, F.ltok};
          EpiGU E{(unsigned char*)F.HIDDEN, F.b_gate + (size_t)L * NE * DM, F.b_up + (size_t)L * NE * DM};
          pg8::gemm_phase<EpiGU, MoeSched, true, true>(F.lds, g, S, E, F.wave); }
        GRID_BAR();
        refresh(F);
        if (PH(8)) for (int rep = 0; rep < DUP(5); ++rep) { const LAS int* tab = (const LAS int*)(F.misc + MO_TAB);
          pg8::Gemm g{F.HIDDEN, (const bf16_t*)((const unsigned char*)F.WDN + (size_t)L * NE * DM * DM), DM / 2}; MoeSched S{tab, 2, tab[96], F.G, F.vcu, F.ltok};
          EpiDown E{(unsigned char*)F.Y, F.b_down + (size_t)L * NE * DM, tab, F.lg};
          pg8::gemm_phase<EpiDown, MoeSched, false, true>(F.lds, g, S, E, F.wave); }
        GRID_BAR();
    }
    refresh(F);
    if (PH(9)) p1_rows<2>(F, DEPTH);
}

extern "C" void kernel_launch(void* const* d_in, const int* in_sizes, int n_in, void* d_out, int out_size, void* d_ws, size_t ws_size, hipStream_t stream) {
    static int grid = 0;
    if (grid == 0) {
        if (n_in != 23 || in_sizes[0] != NTOK * DM || out_size != NTOK * DM || ws_size < WS_END) {
            fprintf(stderr, "kernel_launch: unexpected shapes/workspace: n_in %d in0 %d out %d ws %zu (need %zu); nothing launched\n", n_in, n_in > 0 ? in_sizes[0] : -1, out_size, ws_size, (size_t)WS_END); grid = -1; return; }
        int dev = 0, cus = 0, per_cu = 0;
        if (hipGetDevice(&dev) != hipSuccess || hipDeviceGetAttribute(&cus, hipDeviceAttributeMultiprocessorCount, dev) != hipSuccess) { grid = -1; return; }
        if (hipFuncSetAttribute((const void*)fwd_kernel, hipFuncAttributeMaxDynamicSharedMemorySize, LDS_BYTES) != hipSuccess) { fprintf(stderr, "kernel_launch: hipFuncSetAttribute failed\n"); grid = -1; return; }
        if (hipOccupancyMaxActiveBlocksPerMultiprocessor(&per_cu, (const void*)fwd_kernel, NTHREADS, LDS_BYTES) != hipSuccess || per_cu < 1)
            fprintf(stderr, "kernel_launch: note: occupancy query reports %d workgroups per CU\n", per_cu);
        (void)hipGetLastError();
        grid = cus;
    }
    if (grid < 0) return;
    if (hipMemsetAsync((char*)d_ws + WS_CTL, 0, CTL_ZERO_BYTES, stream) != hipSuccess) return;
    Args a{};
    for (int i = 0; i < 23; ++i) a.in[i] = (const float*)d_in[i];
    a.out = (float*)d_out; a.ws = (unsigned char*)d_ws;
    hipLaunchKernelGGL(fwd_kernel, dim3(grid), dim3(NTHREADS), LDS_BYTES, stream, a);
}
```

```cpp
#include <hip/hip_runtime.h>
#include <cstdio>
#include <cstdint>

#define LAS __attribute__((address_space(3)))
#define GAS __attribute__((address_space(1)))
typedef unsigned short bf16_t;
typedef short bf16x8 __attribute__((ext_vector_type(8)));
typedef short s16x4 __attribute__((ext_vector_type(4)));
typedef float f32x4 __attribute__((ext_vector_type(4)));
typedef float f32x2 __attribute__((ext_vector_type(2)));
typedef float f32x16 __attribute__((ext_vector_type(16)));
typedef unsigned u32x4 __attribute__((ext_vector_type(4)));
typedef unsigned u32x2 __attribute__((ext_vector_type(2)));
typedef GAS unsigned gu32;

constexpr int NBATCH = 8, SEQ = 8192, DM = 1024, NTOK = NBATCH * SEQ, DEPTH = 4;
constexpr int INW = 2816;
constexpr int C_QA = 0, C_KA = 256, C_VA = 512, C_QB = 768, C_KB = 1024, C_VB = 1152, C_QC = 1280, C_KC = 1792, C_VC = 2304;
constexpr int NE = 32, TOPK = 4, LCAP = NTOK;
constexpr float RMS_EPS = 1e-6f;
constexpr float LOG2E = 1.4426950408889634f;
constexpr float QSCALE = 0.125f * LOG2E;
constexpr int NWAVES = 8, NTHREADS = 512;
#ifndef C_TILE_SKIP
#define C_TILE_SKIP 1
#endif
constexpr int CW_NRM = 16384;

constexpr size_t MiB = 1u << 20;
constexpr size_t WS_CTL = 0, CTL_ZERO_BYTES = 1 * MiB;
constexpr size_t WS_MODP = 1 * MiB;
constexpr size_t WS_MOD = 4 * MiB;
constexpr size_t WS_LTOK = 5 * MiB;
constexpr size_t WS_LG = 13 * MiB;
constexpr size_t WS_WIN = 21 * MiB;
constexpr size_t WS_WOUT = 43 * MiB;
constexpr size_t WS_WGU = 51 * MiB;
constexpr size_t WS_WDN = 563 * MiB;
constexpr size_t WS_H = 819 * MiB;
constexpr size_t WS_R1 = 947 * MiB;
constexpr size_t WS_MIXED = WS_R1 + 352 * MiB;
constexpr size_t WS_Y = 1475 * MiB;
constexpr size_t WS_INV = WS_MODP;
constexpr size_t WS_XB = WS_Y + 264 * MiB;
constexpr size_t WS_PART = WS_XB + 128 * MiB;
constexpr size_t WS_END = 1987 * MiB;
static_assert(WS_PART + (size_t)NTOK * 4 * 68 * 4 <= WS_END, "d_ws map");
constexpr int CW_TMO = 0, CW_CODE = 1, CW_BAR = 4096, CW_CNT = 8192;

constexpr int RING_BYTES = 131072;
constexpr int BAND_WL = 16896;
constexpr int MISC_OFF = 8 * BAND_WL;
constexpr int EPI_STG = 1024, EPI_STG_ROW = 144, EPI_STG_GRP = 64 * EPI_STG_ROW;
constexpr int LDS_BYTES = MISC_OFF + EPI_STG + 2 * EPI_STG_GRP;
constexpr int MO_BAR = 0, MO_HIST = 64, MO_BASE = 192, MO_TAB = 320, MO_SELE = 1024, MO_SELG = 5120;

#define RLX_AGENT __ATOMIC_RELAXED, __HIP_MEMORY_SCOPE_AGENT
#define LDS_WAIT() asm volatile("s_waitcnt lgkmcnt(0)" ::: "memory")
#define VM_WAIT() asm volatile("s_waitcnt vmcnt(0)" ::: "memory")
__device__ __forceinline__ unsigned cvt_pk_bf16(float lo, float hi) { unsigned r; asm volatile("v_cvt_pk_bf16_f32 %0, %1, %2" : "=v"(r) : "v"(lo), "v"(hi)); return r; }
__device__ __forceinline__ unsigned f2bf(float f) { unsigned u = __builtin_bit_cast(unsigned, f); return (u + 0x7fffu + ((u >> 16) & 1u)) >> 16; }
__device__ __forceinline__ unsigned pk2(float lo, float hi) { return f2bf(lo) | (f2bf(hi) << 16); }
typedef int i32x8 __attribute__((ext_vector_type(8)));
typedef int i32x4 __attribute__((ext_vector_type(4)));
__device__ __forceinline__ unsigned pk4_fp8_nc(float a, float b, float c, float d) {
    unsigned w = 0u; w = (unsigned)__builtin_amdgcn_cvt_pk_fp8_f32(a, b, (int)w, false); w = (unsigned)__builtin_amdgcn_cvt_pk_fp8_f32(c, d, (int)w, true); return w;
}
__device__ __forceinline__ unsigned pk4_fp8(float a, float b, float c, float d) {
    a = fminf(fmaxf(a, -448.f), 448.f); b = fminf(fmaxf(b, -448.f), 448.f); c = fminf(fmaxf(c, -448.f), 448.f); d = fminf(fmaxf(d, -448.f), 448.f);
    unsigned w = 0u; w = (unsigned)__builtin_amdgcn_cvt_pk_fp8_f32(a, b, (int)w, false); w = (unsigned)__builtin_amdgcn_cvt_pk_fp8_f32(c, d, (int)w, true); return w;
}
constexpr float W8_SCALE = 64.f, H8_SCALE = 8.f, HID8_SCALE = 4.f, Y8_SCALE = 64.f;
__device__ __forceinline__ float bf_lo(unsigned u) { return __builtin_bit_cast(float, u << 16); }
__device__ __forceinline__ float bf_hi(unsigned u) { return __builtin_bit_cast(float, u & 0xffff0000u); }
__device__ __forceinline__ int lane_id() { unsigned ones = ~0u; asm volatile("" : "+s"(ones)); return (int)__builtin_amdgcn_mbcnt_hi(ones, __builtin_amdgcn_mbcnt_lo(ones, 0u)); }
template <int CTRL> __device__ __forceinline__ float dpp_mov(float v) { return __builtin_bit_cast(float, __builtin_amdgcn_update_dpp(0, __builtin_bit_cast(int, v), CTRL, 0xf, 0xf, true)); }
__device__ __forceinline__ float row16_sum(float v) { v += dpp_mov<0xB1>(v); v += dpp_mov<0x4E>(v); v += dpp_mov<0x141>(v); v += dpp_mov<0x140>(v); return v; }
__device__ __forceinline__ float row16_max(float v) { v = fmaxf(v, dpp_mov<0xB1>(v)); v = fmaxf(v, dpp_mov<0x4E>(v)); v = fmaxf(v, dpp_mov<0x141>(v)); v = fmaxf(v, dpp_mov<0x140>(v)); return v; }
__device__ __forceinline__ float x16_sum(float v) { const auto r = __builtin_amdgcn_permlane16_swap(__float_as_uint(v), __float_as_uint(v), false, false); return __uint_as_float(r[0]) + __uint_as_float(r[1]); }
__device__ __forceinline__ float x32_sum(float v) { const auto r = __builtin_amdgcn_permlane32_swap(__float_as_uint(v), __float_as_uint(v), false, false); return __uint_as_float(r[0]) + __uint_as_float(r[1]); }
__device__ __forceinline__ float wave_sum(float v) { return x32_sum(x16_sum(row16_sum(v))); }

#define XB_TMO      128
#define XB_XCNT(j)  (256  + 64 * (j))
#define XB_XSUB(j)  (1280 + 64 * (j))
#define XB_XGEN(j)  (2304 + 64 * (j))
#define XB_TOP      3328
#define XB_TOPGEN   3392
#define XCD_BAR_WORDS 3456
#define XB_SPIN_CAP (1u << 20)

__device__ __forceinline__ unsigned xb_ld(unsigned* p)              { return __hip_atomic_load(p, __ATOMIC_RELAXED, __HIP_MEMORY_SCOPE_AGENT); }
__device__ __forceinline__ unsigned xb_add(unsigned* p, unsigned v) { return __hip_atomic_fetch_add(p, v, __ATOMIC_RELAXED, __HIP_MEMORY_SCOPE_AGENT); }
__device__ __forceinline__ unsigned xb_xcc_id() { return (unsigned)__builtin_amdgcn_s_getreg((3 << 11) | 20) & 0xFu; }
#define XB_SPIN(cond, bar) do { unsigned _sp = 0; while (cond) { __builtin_amdgcn_s_sleep(1); \
    if ((++_sp & 255u) == 0u) { if (xb_ld(&(bar)[XB_TMO])) break; if (_sp > XB_SPIN_CAP) { atomicAdd(&(bar)[XB_TMO], 1u); break; } } } } while (0)

struct XcdBarrier { unsigned* bar; unsigned x; volatile LAS unsigned* st; };
__device__ __forceinline__ XcdBarrier xcd_barrier_post(unsigned* bar, volatile LAS unsigned* st) {
    XcdBarrier b; b.bar = bar; b.x = xb_xcc_id(); b.st = st;
    if (threadIdx.x == 0) (void)xb_add(&bar[XB_XCNT(b.x)], 1u);
    return b;
}
__device__ __forceinline__ void xcd_barrier_complete(unsigned* bar, unsigned x, unsigned& nloc, unsigned& nx) {
    const unsigned G = gridDim.x * gridDim.y * gridDim.z;
    unsigned sum, cnt, mine, sp = 0u;
    for (;;) {
        sum = 0u; cnt = 0u; mine = 0u;
#pragma unroll
        for (unsigned j = 0; j < 16; ++j) { const unsigned c = xb_ld(&bar[XB_XCNT(j)]); sum += c; cnt += (c > 0u) ? 1u : 0u; mine = (j == x) ? c : mine; }
        if (sum == G) break;
        __builtin_amdgcn_s_sleep(1);
        if ((++sp & 255u) == 0u) { if (xb_ld(&bar[XB_TMO])) break; if (sp > XB_SPIN_CAP) { atomicAdd(&bar[XB_TMO], 1u); break; } }
    }
    nloc = mine > 0u ? mine : 1u; nx = cnt > 0u ? cnt : 1u;
}
__device__ __forceinline__ void xcd_barrier(const XcdBarrier& b) {
    asm volatile("s_waitcnt vmcnt(0)" ::: "memory");
    __syncthreads();
    if (threadIdx.x == 0) {
        unsigned* bar = b.bar;
        __builtin_amdgcn_s_waitcnt(0);
        unsigned nloc = b.st[0], nx = b.st[1];
        if (nloc == 0u) { xcd_barrier_complete(bar, b.x, nloc, nx); b.st[0] = nloc; b.st[1] = nx; }
        const unsigned old = xb_add(&bar[XB_XSUB(b.x)], 1u);
        const unsigned gen = old / nloc;
        if (old + 1u == (gen + 1u) * nloc) {
            __builtin_amdgcn_fence(__ATOMIC_RELEASE, "agent");
            asm volatile("s_waitcnt vmcnt(0)" ::: "memory");
            const unsigned og = xb_add(&bar[XB_TOP], 1u);
            const unsigned tg = og / nx;
            if (og + 1u == (tg + 1u) * nx) xb_add(&bar[XB_TOPGEN], 1u);
            else XB_SPIN(xb_ld(&bar[XB_TOPGEN]) == tg, bar);
            __builtin_amdgcn_fence(__ATOMIC_ACQUIRE, "agent");
            xb_add(&bar[XB_XGEN(b.x)], 1u);
            asm volatile("s_waitcnt vmcnt(0)" ::: "memory");
        } else {
            XB_SPIN(xb_ld(&bar[XB_XGEN(b.x)]) == gen, bar);
            __builtin_amdgcn_fence(__ATOMIC_ACQUIRE, "agent");
            asm volatile("s_waitcnt vmcnt(0)" ::: "memory");
        }
    }
    __syncthreads();
}

__device__ __forceinline__ unsigned ld_untracked(const void* p) { unsigned v; asm volatile("global_load_dword %0, %1, off" : "=v"(v) : "v"(p) : "memory"); return v; }
namespace pg8 {
constexpr int BM = 256, BK = 64, HALF = 128, HTB = HALF * BK * 2, STAGE_BYTES = 8 * HTB, NXCD = 8, WGM = 8;
__host__ __device__ __forceinline__ int lds_byte(int r, int c) { const int st = (r >> 4) * 2 + (c >> 5), rr = r & 15, cc = c & 31, ob = rr * 64 + cc * 2; return st * 1024 + (ob ^ (((ob >> 9) & 1) << 5)); }
__host__ __device__ __forceinline__ void stage_rc(int b, int& R, int& C) { const int st = b / 1024, sb = b % 1024, swz = sb ^ (((sb >> 9) & 1) << 5); R = (st >> 1) * 16 + swz / 64; C = (st & 1) * 32 + (swz % 64) / 2; }
__host__ __device__ __forceinline__ int perm32(int rho) { const int n = rho >> 4, i = rho & 15; return 8 * (i >> 2) + 4 * n + (i & 3); }

struct Unit { int pm, pn; };
struct Gemm { const bf16_t* A; const bf16_t* Bt; int K; };

struct StaticOrder {
    int nM, nN, nwg, G, c;
    __device__ void init(int M, int N, int G_, int c_) { nM = M / BM; nN = N / BM; nwg = nM * nN; G = G_; c = c_; }
    __device__ bool next(int i, Unit& u) const {
        const long L = (long)i * G + c; if (L >= nwg) return false;
        int wgid = (int)L; { const int q = nwg / NXCD, r = nwg % NXCD, xcd = wgid % NXCD, off = wgid / NXCD; wgid = (xcd < r ? xcd * (q + 1) : r * (q + 1) + (xcd - r) * q) + off; }
        const int nig = WGM * nN, gid = wgid / nig, fm = gid * WGM, gsz = (nM - fm) < WGM ? (nM - fm) : WGM;
        u.pm = fm + ((wgid % nig) % gsz); u.pn = (wgid % nig) / gsz; return true;
    }
    __device__ __forceinline__ unsigned arow(const Unit&, int) const { return 0u; }
    __device__ __forceinline__ unsigned arow_raw(const Unit&, int) const { return 0u; }
};

struct PanelOrder {
    int nN, nP, G, vcu;
    __device__ bool next(int i, Unit& u) const { const int p = vcu + (i / nN) * G; if (p >= nP) return false; u.pm = p; u.pn = i % nN; return true; }
    __device__ __forceinline__ unsigned arow(const Unit&, int) const { return 0u; }
    __device__ __forceinline__ unsigned arow_raw(const Unit&, int) const { return 0u; }
};
template <int N> __device__ __forceinline__ void wait_v() { asm volatile("s_waitcnt vmcnt(%0)" :: "n"(N) : "memory"); }
template <class Epi, class Sched, bool GATHER, bool FP8 = false>
__device__ __forceinline__ void gemm_phase(LAS unsigned char* lds, const Gemm g, const Sched& S, const Epi& E, int wave_in) {
    int tid_ = wave_in * 64 + lane_id(); asm volatile("" : "+v"(tid_));
    const int tid = tid_, wid = __builtin_amdgcn_readfirstlane(tid >> 6), lane = tid & 63, wr = wid >> 2, wc = wid & 3, fr = lane & 15, fq = lane >> 4;
    int K_ = g.K; asm volatile("" : "+s"(K_));
    const int K = K_, nt = K / BK;
    unsigned voffA[2], voffB[2]; int Rr[2], Cb[2];
#pragma unroll
    for (int i = 0; i < 2; ++i) { int R, C; stage_rc(tid * 16 + i * 8192, R, C); const int Rb = Epi::PERM ? ((R & ~31) + perm32(R & 31)) : R;
        Rr[i] = R; Cb[i] = C * 2; voffA[i] = (unsigned)(R * K + C) * 2u; voffB[i] = (unsigned)(Rb * K + C) * 2u; }
    const size_t kstep = (size_t)(BK * 2);
    const size_t hstep = (size_t)HALF * K * 2;
    const size_t tstep = 2 * hstep;
    const unsigned ldsw = (unsigned)wid * 1024u;
    const int aoff = lds_byte(wr * 64 + fr, fq * 8), boff = lds_byte(wc * 32 + fr, fq * 8);
#define PG8_SA(b, h) (((b) * 2 + (h)) * HTB)
#define PG8_SB(b, h) ((4 + (b) * 2 + (h)) * HTB)
#define PG8_STAGE(bufoff, gbase, voff) do { _Pragma("unroll") for (int _i = 0; _i < 2; ++_i) \
        __builtin_amdgcn_global_load_lds((const unsigned*)((const char*)(gbase) + (voff)[_i]), (LAS unsigned*)(lds + (bufoff) + ldsw + _i * 8192), 16, 0, 0); } while (0)
#define PG8_STGA(b, h, base, vs) do { if constexpr (GATHER) { PG8_STAGE(PG8_SA(b, h), (base), vs[h]); } else { PG8_STAGE(PG8_SA(b, h), (base) + (h) * hstep, voffA); } } while (0)
#define PG8_LDA(dst, b, h) do { _Pragma("unroll") for (int m = 0; m < 4; ++m) _Pragma("unroll") for (int k = 0; k < 2; ++k) dst[m][k] = *(const LAS bf16x8*)(lds + PG8_SA(b, h) + aoff + m * 2048 + k * 1024); } while (0)
#define PG8_LDB(dst, b, h) do { _Pragma("unroll") for (int n = 0; n < 2; ++n) _Pragma("unroll") for (int k = 0; k < 2; ++k) dst[n][k] = *(const LAS bf16x8*)(lds + PG8_SB(b, h) + boff + n * 2048 + k * 1024); } while (0)
#define PG8_CAT(x, y) __builtin_shufflevector(__builtin_bit_cast(i32x4, (x)), __builtin_bit_cast(i32x4, (y)), 0, 1, 2, 3, 4, 5, 6, 7)
#define PG8_MMA(ai, bj, At, Bt) do { __builtin_amdgcn_s_setprio(1); \
        if constexpr (FP8) { _Pragma("unroll") for (int m = 0; m < 4; ++m) _Pragma("unroll") for (int n = 0; n < 2; ++n) \
            { const i32x8 a8_ = PG8_CAT(Bt[n][0], Bt[n][1]), b8_ = PG8_CAT(At[m][0], At[m][1]); \
              asm volatile("v_mfma_scale_f32_16x16x128_f8f6f4 %0, %1, %2, %0, %3, %3 op_sel_hi:[0,0,0]" : "+v"(acc[ai][bj][m][n]) : "v"(a8_), "v"(b8_), "v"(one8)); } } \
        else { _Pragma("unroll") for (int m = 0; m < 4; ++m) _Pragma("unroll") for (int n = 0; n < 2; ++n) _Pragma("unroll") for (int k = 0; k < 2; ++k) \
            acc[ai][bj][m][n] = __builtin_amdgcn_mfma_f32_16x16x32_bf16(Bt[n][k], At[m][k], acc[ai][bj][m][n], 0, 0, 0); } \
        __builtin_amdgcn_s_setprio(0); } while (0)
#define PG8_PIECE(bufoff, gbase, voff, i) __builtin_amdgcn_global_load_lds((const unsigned*)((const char*)(gbase) + (voff)[i]), (LAS unsigned*)(lds + (bufoff) + ldsw + (i) * 8192), 16, 0, 0)
#define PG8_PCA(b, h, base, vs, i) do { if constexpr (GATHER) { PG8_PIECE(PG8_SA(b, h), (base), vs[h], i); } else { PG8_PIECE(PG8_SA(b, h), (base) + (h) * hstep, voffA, i); } PG8_SCHED; } while (0)
#define PG8_PCB(b, h, base, i) do { PG8_PIECE(PG8_SB(b, h), (base) + (h) * hstep, voffB, i); PG8_SCHED; } while (0)
#define PG8_MMAH(ai, bj, At, Bt, HK) do { __builtin_amdgcn_s_setprio(1); \
        if constexpr (FP8) { _Pragma("unroll") for (int m = 0; m < 4; ++m) _Pragma("unroll") for (int n = 0; n < 2; ++n) \
            { const i32x8 a8_ = PG8_CAT(Bt[n][0], Bt[n][1]), b8_ = PG8_CAT(At[m][0], At[m][1]); \
              asm volatile("v_mfma_scale_f32_16x16x128_f8f6f4 %0, %1, %2, %0, %3, %3 op_sel_hi:[0,0,0]" : "+v"(acc[ai][bj][m][n]) : "v"(a8_), "v"(b8_), "v"(one8)); HK(m * 2 + n); } } \
        else { _Pragma("unroll") for (int k = 0; k < 2; ++k) _Pragma("unroll") for (int m = 0; m < 4; ++m) { _Pragma("unroll") for (int n = 0; n < 2; ++n) \
            acc[ai][bj][m][n] = __builtin_amdgcn_mfma_f32_16x16x32_bf16(Bt[n][k], At[m][k], acc[ai][bj][m][n], 0, 0, 0); HK(k * 4 + m); } } \
        __builtin_amdgcn_s_setprio(0); } while (0)
#define PG8_WAIT_V(n) asm volatile("s_waitcnt vmcnt(" #n ")" ::: "memory")
#define PG8_WAIT_L(n) asm volatile("s_waitcnt lgkmcnt(" #n ")" ::: "memory")
#define PG8_BAR __builtin_amdgcn_s_barrier()
#define PG8_SCHED __builtin_amdgcn_sched_barrier(0)
    Unit cur, nxt; int ui = 0;
    if (!S.next(0, cur)) return;
    int one8 = 0x7f7f7f7f; asm volatile("" : "+v"(one8));
    f32x4 acc[2][2][4][2];
#pragma unroll
    for (int a = 0; a < 2; ++a)
#pragma unroll
        for (int b = 0; b < 2; ++b)
#pragma unroll
            for (int m = 0; m < 4; ++m)
#pragma unroll
                for (int n = 0; n < 2; ++n) acc[a][b][m][n] = (f32x4){0.f, 0.f, 0.f, 0.f};
    bf16x8 At[4][2], B0[2][2], B1[2][2];
    unsigned vc[2][2], vn[2][2], v2[2][2];
#pragma unroll
    for (int h = 0; h < 2; ++h)
#pragma unroll
        for (int i = 0; i < 2; ++i) { vc[h][i] = GATHER ? S.arow(cur, h * HALF + Rr[i]) * (unsigned)(K * 2) + (unsigned)Cb[i] : 0u; vn[h][i] = vc[h][i]; v2[h][i] = vc[h][i]; }
    const char* cA = GATHER ? (const char*)g.A : (const char*)g.A + (size_t)cur.pm * tstep; const char* cB = (const char*)g.Bt + (size_t)cur.pn * tstep;
    PG8_STAGE(PG8_SB(0, 0), cB, voffB); PG8_STAGE(PG8_SB(0, 1), cB + hstep, voffB); PG8_STGA(0, 0, cA, vc); PG8_STGA(0, 1, cA, vc);
    if (wr == 1) PG8_BAR;
    PG8_WAIT_V(2); PG8_BAR;
    constexpr bool PEEL = FP8;
    PG8_STAGE(PG8_SB(1, 0), cB + kstep, voffB); PG8_STGA(1, 0, cA + kstep, vc); PG8_STAGE(PG8_SB(1, 1), cB + hstep + kstep, voffB);
    PG8_STGA(1, 1, cA + kstep, vc); PG8_WAIT_V(8);
    PG8_BAR;
    constexpr int XW = Epi::NVM + Epi::NPRE + (GATHER ? 4 : 0);
    { LAS unsigned* dump = (LAS unsigned*)(lds + STAGE_BYTES + (unsigned)wave_in * 256u);
#pragma unroll
      for (int s_ = 0; s_ < Epi::NVM; ++s_) __builtin_amdgcn_global_load_lds((const unsigned*)g.Bt, dump, 4, 0, 0); }
#define PG8_ITER(FIRST) do { \
            const bool last = !(FIRST) && (t == nt - 2); \
            const char* a1 = cA + (size_t)(t + 1) * kstep; \
            const char* a2 = last ? nA : cA + (size_t)(t + 2) * kstep; const char* b2 = last ? nB : cB + (size_t)(t + 2) * kstep; \
            const char* a3 = a2 + kstep; const char* b3 = b2 + kstep; \
            if (GATHER) { \
                _Pragma("unroll") for (int h = 0; h < 2; ++h) _Pragma("unroll") for (int i = 0; i < 2; ++i) v2[h][i] = last ? vn[h][i] : vc[h][i]; \
            } \
              \
            PG8_LDB(B0, 0, 0); PG8_LDB(B1, 0, 1); PG8_SCHED; PG8_LDA(At, 0, 0); if (!(FIRST)) PG8_STGA(1, 1, a1, vc); \
            if (FIRST) wait_v<8 + XW>(); else wait_v<8>(); PG8_WAIT_L(0); PG8_BAR; PG8_MMA(0, 0, At, B0); PG8_MMA(0, 1, At, B1); PG8_BAR; PG8_SCHED; \
              \
            PG8_LDA(At, 0, 1); PG8_STAGE(PG8_SB(0, 0), b2, voffB); PG8_STAGE(PG8_SB(0, 1), b2 + hstep, voffB); PG8_STGA(0, 0, a2, v2); \
            if (FIRST) wait_v<8 + XW>(); else wait_v<8>(); PG8_WAIT_L(0); PG8_BAR; PG8_MMA(1, 0, At, B0); PG8_MMA(1, 1, At, B1); PG8_BAR; PG8_SCHED; \
              \
            PG8_LDB(B0, 1, 0); PG8_LDB(B1, 1, 1); PG8_SCHED; PG8_LDA(At, 1, 0); PG8_STGA(0, 1, a2, v2); \
            if (FIRST) wait_v<8 + XW>(); else wait_v<8>(); PG8_WAIT_L(0); PG8_BAR; PG8_MMA(0, 0, At, B0); PG8_MMA(0, 1, At, B1); PG8_BAR; PG8_SCHED; \
              \
            PG8_LDA(At, 1, 1); PG8_STAGE(PG8_SB(1, 0), b3, voffB); PG8_STAGE(PG8_SB(1, 1), b3 + hstep, voffB); PG8_STGA(1, 0, a3, v2); \
            PG8_WAIT_V(8); PG8_WAIT_L(0); PG8_BAR; PG8_MMA(1, 0, At, B0); PG8_MMA(1, 1, At, B1); PG8_BAR; PG8_SCHED; \
        } while (0)
#define PG8_H1A(j) if ((j) == 3 && !(FIRST_)) PG8_PCA(1, 1, a1, vc, 0)
#define PG8_H1B(j) if ((j) == 3 && !(FIRST_)) PG8_PCA(1, 1, a1, vc, 1)
#define PG8_H2A(j) if ((j) == 1) PG8_PCB(0, 0, b2, 0); else if ((j) == 3) PG8_PCB(0, 0, b2, 1); else if ((j) == 5) PG8_PCB(0, 1, b2, 0)
#define PG8_H2B(j) if ((j) == 1) PG8_PCB(0, 1, b2, 1); else if ((j) == 3) PG8_PCA(0, 0, a2, v2, 0); else if ((j) == 5) PG8_PCA(0, 0, a2, v2, 1)
#define PG8_H3A(j) if ((j) == 3) PG8_PCA(0, 1, a2, v2, 0)
#define PG8_H3B(j) if ((j) == 3) PG8_PCA(0, 1, a2, v2, 1)
#define PG8_H4A(j) if ((j) == 1) PG8_PCB(1, 0, b3, 0); else if ((j) == 3) PG8_PCB(1, 0, b3, 1); else if ((j) == 5) PG8_PCB(1, 1, b3, 0)
#define PG8_H4B(j) if ((j) == 1) PG8_PCB(1, 1, b3, 1); else if ((j) == 3) PG8_PCA(1, 0, a3, v2, 0); else if ((j) == 5) PG8_PCA(1, 0, a3, v2, 1)
#define PG8_ITER2(FIRST) do { \
            const bool FIRST_ = (FIRST); \
            const bool last = !(FIRST) && (t == nt - 2); \
            const char* a1 = cA + (size_t)(t + 1) * kstep; \
            const char* a2 = last ? nA : cA + (size_t)(t + 2) * kstep; const char* b2 = last ? nB : cB + (size_t)(t + 2) * kstep; \
            const char* a3 = a2 + kstep; const char* b3 = b2 + kstep; \
            if (GATHER) { \
                _Pragma("unroll") for (int h = 0; h < 2; ++h) _Pragma("unroll") for (int i = 0; i < 2; ++i) v2[h][i] = last ? vn[h][i] : vc[h][i]; \
            } \
            PG8_LDB(B0, 0, 0); PG8_LDB(B1, 0, 1); PG8_SCHED; PG8_LDA(At, 0, 0); \
            if (FIRST) wait_v<8 + XW>(); else wait_v<6>(); PG8_WAIT_L(0); PG8_BAR; PG8_MMAH(0, 0, At, B0, PG8_H1A); PG8_MMAH(0, 1, At, B1, PG8_H1B); PG8_BAR; PG8_SCHED; \
            PG8_LDA(At, 0, 1); \
            if (FIRST) wait_v<2 + XW>(); else wait_v<2>(); PG8_WAIT_L(0); PG8_BAR; PG8_MMAH(1, 0, At, B0, PG8_H2A); PG8_MMAH(1, 1, At, B1, PG8_H2B); PG8_BAR; PG8_SCHED; \
            PG8_LDB(B0, 1, 0); PG8_LDB(B1, 1, 1); PG8_SCHED; PG8_LDA(At, 1, 0); \
            if (FIRST) wait_v<6 + XW>(); else wait_v<6>(); PG8_WAIT_L(0); PG8_BAR; PG8_MMAH(0, 0, At, B0, PG8_H3A); PG8_MMAH(0, 1, At, B1, PG8_H3B); PG8_BAR; PG8_SCHED; \
            PG8_LDA(At, 1, 1); \
            wait_v<2>(); PG8_WAIT_L(0); PG8_BAR; PG8_MMAH(1, 0, At, B0, PG8_H4A); PG8_MMAH(1, 1, At, B1, PG8_H4B); PG8_BAR; PG8_SCHED; \
        } while (0)
    constexpr bool MD = FP8;
#define PG8_IT(FIRST) do { if constexpr (MD) PG8_ITER2(FIRST); else PG8_ITER(FIRST); } while (0)
    for (;;) {
        const bool has_next = S.next(ui + 1, nxt);
        if (GATHER && has_next && !PEEL) {
            int t2 = wave_in * 64 + lane_id(); asm volatile("" : "+v"(t2));
#pragma unroll
            for (int i = 0; i < 2; ++i) { int R, C; stage_rc(t2 * 16 + i * 8192, R, C);
#pragma unroll
                for (int h = 0; h < 2; ++h) vn[h][i] = S.arow(nxt, h * HALF + R) * (unsigned)(K * 2) + (unsigned)(C * 2); }
        }
        if (GATHER && PEEL) {
            int t2 = wave_in * 64 + lane_id(); asm volatile("" : "+v"(t2));
#pragma unroll
            for (int i = 0; i < 2; ++i) { int R, C; stage_rc(t2 * 16 + i * 8192, R, C);
#pragma unroll
                for (int h = 0; h < 2; ++h) vn[h][i] = S.arow_raw(has_next ? nxt : cur, h * HALF + R); }
        }
        typename Epi::Pre pre = E.preload(cur, wr, wc, fr, fq);
        const char* nA = has_next ? (GATHER ? (const char*)g.A : (const char*)g.A + (size_t)nxt.pm * tstep) : cA; const char* nB = has_next ? (const char*)g.Bt + (size_t)nxt.pn * tstep : cB;
        if constexpr (PEEL) { int t = 0; PG8_IT(true); }
        if (GATHER && PEEL) {
            int t2 = wave_in * 64 + lane_id(); asm volatile("" : "+v"(t2));
#pragma unroll
            for (int i = 0; i < 2; ++i) { int R, C; stage_rc(t2 * 16 + i * 8192, R, C);
#pragma unroll
                for (int h = 0; h < 2; ++h) vn[h][i] = (vn[h][i] >> 2) * (unsigned)(K * 2) + (unsigned)(C * 2); }
        }
        if constexpr (PEEL) {
#pragma unroll 1
            for (int t = 2; t < nt; t += 2) PG8_IT(false); }
        else {
#pragma unroll 1
            for (int t = 0; t < nt; t += 2) PG8_IT(t == 0); }
        PG8_STGA(1, 1, nA + kstep, vn);
        if (wr == 0) PG8_BAR;
        if constexpr (FP8) asm volatile("s_nop 15\n\ts_nop 15" ::: "memory");
        E(acc, cur, wr, wc, fr, fq, pre);
        if (!has_next) break;
#pragma unroll
        for (int a = 0; a < 2; ++a)
#pragma unroll
            for (int b = 0; b < 2; ++b)
#pragma unroll
                for (int m = 0; m < 4; ++m)
#pragma unroll
                    for (int n = 0; n < 2; ++n) acc[a][b][m][n] = (f32x4){0.f, 0.f, 0.f, 0.f};
        cur = nxt; cA = nA; cB = nB; ++ui;
#pragma unroll
        for (int h = 0; h < 2; ++h)
#pragma unroll
            for (int i = 0; i < 2; ++i) vc[h][i] = vn[h][i];
        if (wr == 1) PG8_BAR;
    }
    PG8_WAIT_V(0);
    PG8_BAR;
#undef PG8_SA
#undef PG8_SB
#undef PG8_STAGE
#undef PG8_STGA
#undef PG8_LDA
#undef PG8_LDB
#undef PG8_MMA
#undef PG8_CAT
#undef PG8_WAIT_V
#undef PG8_WAIT_L
#undef PG8_BAR
#undef PG8_SCHED
#undef PG8_ITER
#undef PG8_ITER2
#undef PG8_IT
#undef PG8_PIECE
#undef PG8_PCA
#undef PG8_PCB
#undef PG8_MMAH
#undef PG8_H1A
#undef PG8_H1B
#undef PG8_H2A
#undef PG8_H2B
#undef PG8_H3A
#undef PG8_H3B
#undef PG8_H4A
#undef PG8_H4B
}
}

struct Frame {
    LAS unsigned char* lds;
    LAS unsigned char* misc;
    gu32* ctl;
    int tid, lane, wave, vcu, G, wave0;
    const float *x_in, *c_in, *w_ada, *b_ada, *norm1, *w_in, *sinks, *lq1, *lk1, *lq2, *lk2, *subln, *w_out, *norm2, *w_router, *b_router, *w_gate, *b_gate, *w_up, *b_up, *w_down, *b_down, *norm_f;
    float* out;
    float *modp, *mod, *part; int* ltok; float* lg; int* inv;
    bf16_t *WIN, *WOUT, *WGU, *WDN, *H, *PROJ, *MIXED, *HIDDEN, *Y, *XB;
};

__device__ __forceinline__ void p0_transpose_tile(const float* src, int N, bf16_t* dst, int ldd, LAS float* scr, int lane) {
#pragma unroll
    for (int i = 0; i < 32; ++i) { const int kk = 2 * i + (lane >> 5); scr[kk * 33 + (lane & 31)] = src[(size_t)kk * N + (lane & 31)]; }
    LDS_WAIT(); asm volatile("" ::: "memory");
    const int c = lane & 7;
#pragma unroll
    for (int j = 0; j < 4; ++j) { const int n = (lane >> 3) + 8 * j; const LAS float* s = scr + (8 * c) * 33 + n;
        u32x4 o; o.x = pk2(s[0 * 33], s[1 * 33]); o.y = pk2(s[2 * 33], s[3 * 33]); o.z = pk2(s[4 * 33], s[5 * 33]); o.w = pk2(s[6 * 33], s[7 * 33]);
        *(GAS u32x4*)(dst + (size_t)n * ldd + 8 * c) = o; }
    LDS_WAIT(); asm volatile("" ::: "memory");
}
__device__ __forceinline__ void p0_transpose_tile8(const float* src, int N, unsigned char* dst, int ldd, LAS float* scr, int lane) {
#pragma unroll
    for (int i = 0; i < 32; ++i) { const int kk = 2 * i + (lane >> 5); scr[kk * 33 + (lane & 31)] = src[(size_t)kk * N + (lane & 31)]; }
    LDS_WAIT(); asm volatile("" ::: "memory");
    const int c = lane & 7;
#pragma unroll
    for (int j = 0; j < 4; ++j) { const int n = (lane >> 3) + 8 * j; const LAS float* s = scr + (8 * c) * 33 + n;
        u32x2 o; o.x = pk4_fp8(s[0 * 33] * W8_SCALE, s[1 * 33] * W8_SCALE, s[2 * 33] * W8_SCALE, s[3 * 33] * W8_SCALE); o.y = pk4_fp8(s[4 * 33] * W8_SCALE, s[5 * 33] * W8_SCALE, s[6 * 33] * W8_SCALE, s[7 * 33] * W8_SCALE);
        *(GAS u32x2*)(dst + (size_t)n * ldd + 8 * c) = o; }
    LDS_WAIT(); asm volatile("" ::: "memory");
}
__device__ __forceinline__ void p0_prologue(Frame& F) {
    LAS float* cond = (LAS float*)F.lds;
    for (int i = F.tid; i < NBATCH * DM; i += NTHREADS) { const float v = F.c_in[i]; cond[i] = v / (1.f + __expf(-v)); }
    __syncthreads();
    LAS float* scr = (LAS float*)(F.lds + 32768 + F.wave * 8448);
    const int gw = F.vcu * NWAVES + F.wave, NGW = F.G * NWAVES;
    constexpr int I_MOD = DEPTH * 24 * 4;
    constexpr int I_IN = DEPTH * 16 * 88, I_OUT = DEPTH * 16 * 32, I_E = DEPTH * NE * 16 * 32;
    constexpr int NITEMS = I_MOD + I_IN + I_OUT + 3 * I_E;
    for (int it = gw; it < NITEMS; it += NGW) {
        int r = it;
        if (r < I_MOD) {
            const int kq = r & 3, cg = (r >> 2) % 24, L = (r >> 2) / 24, col = cg * 256 + 4 * F.lane;
            f32x4 acc[NBATCH];
#pragma unroll
            for (int b = 0; b < NBATCH; ++b) acc[b] = (f32x4){0.f, 0.f, 0.f, 0.f};
            const float* wp = F.w_ada + ((size_t)L * DM + kq * 256) * 6144 + col;
            for (int k4 = 0; k4 < 64; ++k4) {
                f32x4 w[4];
#pragma unroll
                for (int j = 0; j < 4; ++j) w[j] = *(const GAS f32x4*)(wp + (size_t)(k4 * 4 + j) * 6144);
#pragma unroll
                for (int b = 0; b < NBATCH; ++b) { const f32x4 cv = *(const LAS f32x4*)(cond + b * DM + kq * 256 + k4 * 4);
                    acc[b] += w[0] * cv.x + w[1] * cv.y + w[2] * cv.z + w[3] * cv.w; }
            }
#pragma unroll
            for (int b = 0; b < NBATCH; ++b) *(GAS f32x4*)(F.modp + (((size_t)kq * DEPTH + L) * NBATCH + b) * 6144 + col) = acc[b];
            continue;
        }
        r -= I_MOD;
        if (r < I_IN) { const int L = r / (16 * 88), q = r % (16 * 88), kb = q / 88, nb = q % 88;
            p0_transpose_tile(F.w_in + ((size_t)L * DM + kb * 64) * INW + nb * 32, INW, F.WIN + ((size_t)L * INW + nb * 32) * DM + kb * 64, DM, scr, F.lane); continue; }
        r -= I_IN;
        if (r < I_OUT) { const int L = r / 512, q = r % 512, kb = q / 32, nb = q % 32;
            p0_transpose_tile(F.w_out + ((size_t)L * DM + kb * 64) * DM + nb * 32, DM, F.WOUT + ((size_t)L * DM + nb * 32) * DM + kb * 64, DM, scr, F.lane); continue; }
        r -= I_OUT;
        { const int which = r / I_E, q0 = r % I_E, le = q0 / 512, q = q0 % 512, kb = q / 32, nb = q % 32, n0 = nb * 32;
          unsigned char* WGU8 = (unsigned char*)F.WGU; unsigned char* WDN8 = (unsigned char*)F.WDN;
          if (which == 0) p0_transpose_tile8(F.w_gate + ((size_t)le * DM + kb * 64) * DM + n0, DM, WGU8 + ((size_t)le * 2048 + (n0 >> 7) * 256 + (n0 & 127)) * DM + kb * 64, DM, scr, F.lane);
          else if (which == 1) p0_transpose_tile8(F.w_up + ((size_t)le * DM + kb * 64) * DM + n0, DM, WGU8 + ((size_t)le * 2048 + (n0 >> 7) * 256 + 128 + (n0 & 127)) * DM + kb * 64, DM, scr, F.lane);
          else p0_transpose_tile8(F.w_down + ((size_t)le * DM + kb * 64) * DM + n0, DM, WDN8 + ((size_t)le * DM + n0) * DM + kb * 64, DM, scr, F.lane); }
    }
}
__device__ __forceinline__ void p0b_modsum(Frame& F) {
    const int gt = F.vcu * NTHREADS + F.tid, NGT = F.G * NTHREADS;
    for (int i = gt; i < DEPTH * NBATCH * 6144 / 4; i += NGT) {
        const int e = i * 4, L = e / (NBATCH * 6144), j = e % 6144;
        f32x4 s = *(const GAS f32x4*)(F.b_ada + (size_t)L * 6144 + j);
#pragma unroll
        for (int kq = 0; kq < 4; ++kq) s += *(const GAS f32x4*)(F.modp + (size_t)kq * DEPTH * NBATCH * 6144 + e);
        *(GAS f32x4*)(F.mod + e) = s;
    }
}

template <int MODE>
__device__ __forceinline__ void p1_rows(Frame& F, int L, float g2mul = 1.0f) {
    const int gw = F.vcu * NWAVES + F.wave, NGW = F.G * NWAVES, lane = F.lane;
    const float* gain = (MODE == 2) ? F.norm_f : F.norm1 + (size_t)L * DM;
    f32x4 gn[4];
#pragma unroll
    for (int j = 0; j < 4; ++j) gn[j] = *(const GAS f32x4*)(gain + 4 * lane + 256 * j);
    for (int chunk = gw; chunk < NTOK / 32; chunk += NGW) {
        const int m0 = chunk * 32, b = m0 >> 13;
        f32x4 sc[4], sh[4], g2[4];
#pragma unroll
        for (int j = 0; j < 4; ++j) {
            if (MODE != 2) { const float* mp = F.mod + ((size_t)L * NBATCH + b) * 6144; sh[j] = *(const GAS f32x4*)(mp + 0 * DM + 4 * lane + 256 * j); sc[j] = *(const GAS f32x4*)(mp + 1 * DM + 4 * lane + 256 * j); }
            if (MODE != 0) { const float* mq = F.mod + ((size_t)(L - 1) * NBATCH + b) * 6144; g2[j] = *(const GAS f32x4*)(mq + 5 * DM + 4 * lane + 256 * j) * (g2mul * (1.0f / Y8_SCALE)); }
        }
        f32x4 xa[4], xb[4]; unsigned ya[4][4], yb[4][4];
        int pst = 0; i32x4 iv = {0, 0, 0, 0};
        if (MODE != 0) {
            const int c = (int)__hip_atomic_load((unsigned*)(F.ctl + CW_CNT + ((L - 1) * NE + (lane & 31)) * 16), RLX_AGENT);
            const int p = (c + 255) & ~255;
#pragma unroll
            for (int e2 = 0; e2 < 31; ++e2) { const int v_ = __builtin_amdgcn_readlane(p, e2); pst += ((lane & 31) > e2) ? v_ : 0; }
            iv = *(const GAS i32x4*)(F.inv + ((size_t)m0 + (lane & 31)) * 4);
        }
#define P1_LOAD(X, Yv, mrow) do { const size_t m_ = (size_t)(mrow); \
            _Pragma("unroll") for (int j = 0; j < 4; ++j) { if (MODE == 0) X[j] = *(const GAS f32x4*)(F.x_in + m_ * DM + 4 * lane + 256 * j); \
                else { const u32x2 xb_ = *(const GAS u32x2*)(F.XB + m_ * DM + 4 * lane + 256 * j); X[j] = (f32x4){bf_lo(xb_.x), bf_hi(xb_.x), bf_lo(xb_.y), bf_hi(xb_.y)}; } } \
            if (MODE != 0) { const int li_ = (int)(m_ - (size_t)m0); \
                _Pragma("unroll") for (int k = 0; k < TOPK; ++k) { const int w_ = __builtin_amdgcn_readlane(k == 0 ? iv.x : k == 1 ? iv.y : k == 2 ? iv.z : iv.w, li_); \
                    const size_t row_ = (size_t)(__builtin_amdgcn_readlane(pst, w_ & 255) + (w_ >> 8)); \
                    _Pragma("unroll") for (int j = 0; j < 4; ++j) Yv[j][k] = *(const GAS unsigned*)((const unsigned char*)F.Y + row_ * DM + 4 * lane + 256 * j); } } } while (0)
#define P1_PROC(X, Yv, mrow) do { const size_t m = (size_t)(mrow); f32x4 v[4]; \
            _Pragma("unroll") for (int j = 0; j < 4; ++j) { v[j] = X[j]; \
                if (MODE != 0) { f32x4 ys = (f32x4){0.f, 0.f, 0.f, 0.f}; \
                    _Pragma("unroll") for (int k = 0; k < TOPK; ++k) { const f32x2 ylo = __builtin_amdgcn_cvt_pk_f32_fp8((int)Yv[j][k], false), yhi = __builtin_amdgcn_cvt_pk_f32_fp8((int)Yv[j][k], true); ys += (f32x4){ylo.x, ylo.y, yhi.x, yhi.y}; } \
                    v[j] += g2[j] * ys; } } \
            float ss = 0.f; \
            _Pragma("unroll") for (int j = 0; j < 4; ++j) ss += (v[j].x * v[j].x + v[j].y * v[j].y) + (v[j].z * v[j].z + v[j].w * v[j].w); \
            const float rs = 1.0f / sqrtf(wave_sum(ss) * (1.f / DM) + RMS_EPS); \
            if (MODE == 2) { _Pragma("unroll") for (int j = 0; j < 4; ++j) *(GAS f32x4*)(F.out + m * DM + 4 * lane + 256 * j) = v[j] * rs * gn[j]; } \
            else { _Pragma("unroll") for (int j = 0; j < 4; ++j) { { u32x2 xo_; xo_.x = pk2(v[j].x, v[j].y); xo_.y = pk2(v[j].z, v[j].w); *(GAS u32x2*)(F.XB + m * DM + 4 * lane + 256 * j) = xo_; } \
                    const f32x4 h = (v[j] * rs * gn[j]) * (sc[j] + 1.0f) + sh[j]; \
                    u32x2 o; o.x = pk2(h.x, h.y); o.y = pk2(h.z, h.w); \
                    *(GAS u32x2*)(F.H + m * DM + 4 * lane + 256 * j) = o; } } } while (0)
        P1_LOAD(xa, ya, m0);
        for (int i = 0; i < 32; i += 2) {
            P1_LOAD(xb, yb, m0 + i + 1);
            P1_PROC(xa, ya, m0 + i);
            if (i + 2 < 32) P1_LOAD(xa, ya, m0 + i + 2);
            P1_PROC(xb, yb, m0 + i + 1);
        }
#undef P1_LOAD
#undef P1_PROC
    }
}

constexpr int MO_RS = 9216, MO_BIASP = 10240, MO_PART = 10368;
__device__ __forceinline__ void p5_route(Frame& F, int L, int LC) {
    const int lane = F.lane, r32 = lane & 31, hi = lane >> 5;
    LAS float* Wl = (LAS float*)F.lds;
    LAS int* hist = (LAS int*)(F.misc + MO_HIST); LAS int* base = (LAS int*)(F.misc + MO_BASE);
    LAS int* sel_e = (LAS int*)(F.misc + MO_SELE); LAS float* sel_g = (LAS float*)(F.misc + MO_SELG);
    LAS float* rsl = (LAS float*)(F.misc + MO_RS); LAS float* biasp = (LAS float*)(F.misc + MO_BIASP); LAS float* part = (LAS float*)(F.misc + MO_PART);
    const float* Wr = F.w_router + (size_t)L * DM * NE;
    f32x4 gn[4];
#pragma unroll
    for (int j = 0; j < 4; ++j) gn[j] = *(const GAS f32x4*)(F.norm2 + (size_t)L * DM + 4 * lane + 256 * j);
    for (int blk = F.vcu; blk < NTOK / 256; blk += F.G) {
        const int tok0 = blk * 256 + F.wave * 32, b = tok0 >> 13;
        const float* mp = F.mod + ((size_t)L * NBATCH + b) * 6144;
        if (F.tid < NE) hist[F.tid] = 0;
        for (int it = F.tid; it < (DM / 8) * NE; it += NTHREADS) { const int kg = it >> 5, e = it & 31, k0 = kg * 8;
            const f32x4 n0 = *(const GAS f32x4*)(F.norm2 + (size_t)L * DM + k0), n1 = *(const GAS f32x4*)(F.norm2 + (size_t)L * DM + k0 + 4);
            const f32x4 s0 = *(const GAS f32x4*)(mp + 4 * DM + k0), s1 = *(const GAS f32x4*)(mp + 4 * DM + k0 + 4);
            float w[8];
#pragma unroll
            for (int i = 0; i < 8; ++i) w[i] = Wr[(size_t)(k0 + i) * NE + e] * ((i < 4 ? n0[i & 3] : n1[i & 3]) * (1.0f + (i < 4 ? s0[i & 3] : s1[i & 3])));
            u32x4 hv, mv;
#pragma unroll
            for (int i = 0; i < 4; ++i) { const unsigned hb = cvt_pk_bf16(w[2 * i], w[2 * i + 1]); hv[i] = hb; mv[i] = cvt_pk_bf16(w[2 * i] - bf_lo(hb), w[2 * i + 1] - bf_hi(hb)); }
            const int off = ((kg * 32) + e) * 16;
            *(LAS u32x4*)((LAS unsigned char*)Wl + off) = hv; *(LAS u32x4*)((LAS unsigned char*)Wl + 65536 + off) = mv; }
        { const int e = lane & 31, k0 = F.wave * 128 + hi * 64; float acc = 0.f;
#pragma unroll 8
          for (int k = 0; k < 64; ++k) acc = __builtin_fmaf(mp[3 * DM + k0 + k], Wr[(size_t)(k0 + k) * NE + e], acc);
          part[(F.wave * 2 + hi) * 32 + e] = acc; }
        f32x4 sc[4], sh[4];
#pragma unroll
        for (int j = 0; j < 4; ++j) { sh[j] = *(const GAS f32x4*)(mp + 3 * DM + 4 * lane + 256 * j); sc[j] = *(const GAS f32x4*)(mp + 4 * DM + 4 * lane + 256 * j); }
        f32x4 xa[4], xb[4];
#define P5_LOAD(X, mrow) do { _Pragma("unroll") for (int j = 0; j < 4; ++j) { const u32x2 xb_ = *(const GAS u32x2*)(F.XB + (size_t)(mrow) * DM + 4 * lane + 256 * j); X[j] = (f32x4){bf_lo(xb_.x), bf_hi(xb_.x), bf_lo(xb_.y), bf_hi(xb_.y)}; } } while (0)
#define P5_PROC(X, mrow, irow) do { const size_t m = (size_t)(mrow); float ss = 0.f; \
            _Pragma("unroll") for (int j = 0; j < 4; ++j) ss += (X[j].x * X[j].x + X[j].y * X[j].y) + (X[j].z * X[j].z + X[j].w * X[j].w); \
            const float rs = 1.0f / sqrtf(wave_sum(ss) * (1.f / DM) + RMS_EPS); \
            _Pragma("unroll") for (int j = 0; j < 4; ++j) { const f32x4 h = ((X[j] * rs * gn[j]) * (sc[j] + 1.0f) + sh[j]) * H8_SCALE; \
                *(GAS unsigned*)((unsigned char*)F.H + m * DM + 4 * lane + 256 * j) = pk4_fp8(h.x, h.y, h.z, h.w); } \
            if (lane == 0) rsl[F.wave * 32 + (irow)] = rs; } while (0)
        P5_LOAD(xa, tok0);
        for (int i = 0; i < 32; i += 2) {
            P5_LOAD(xb, tok0 + i + 1);
            P5_PROC(xa, tok0 + i, i);
            if (i + 2 < 32) P5_LOAD(xa, tok0 + i + 2);
            P5_PROC(xb, tok0 + i + 1, i + 1);
        }
#undef P5_LOAD
#undef P5_PROC
        __syncthreads();
        if (F.tid < NE) { float s = F.b_router[L * NE + F.tid];
#pragma unroll
            for (int p = 0; p < 16; ++p) s += part[p * 32 + F.tid];
            biasp[F.tid] = s; }
        __syncthreads();
        {
            f32x16 a0, a1;
#pragma unroll
            for (int r = 0; r < 16; ++r) { a0[r] = 0.f; a1[r] = 0.f; }
            const bf16_t* xr = F.XB + ((size_t)tok0 + r32) * DM + 8 * hi;
            const LAS unsigned char* wl = (const LAS unsigned char*)Wl + (hi * 32 + r32) * 16;
#pragma unroll 4
            for (int j = 0; j < 64; ++j) {
                const bf16x8 xv = *(const GAS bf16x8*)(xr + 16 * j);
                const bf16x8 wh = *(const LAS bf16x8*)(wl + j * 1024), wm = *(const LAS bf16x8*)(wl + 65536 + j * 1024);
                a0 = __builtin_amdgcn_mfma_f32_32x32x16_bf16(wh, xv, a0, 0, 0, 0); a1 = __builtin_amdgcn_mfma_f32_32x32x16_bf16(wm, xv, a1, 0, 0, 0);
            }
            const float rs = rsl[F.wave * 32 + r32];
            float v[16];
#pragma unroll
            for (int r = 0; r < 16; ++r) v[r] = (a0[r] + a1[r]) * rs + biasp[(r & 3) + 8 * (r >> 2) + 4 * hi];
            float tv[4]; int ti[4];
#pragma unroll
            for (int rd = 0; rd < 4; ++rd) {
                float bv = v[0]; int bi = 4 * hi;
#pragma unroll
                for (int r = 1; r < 16; ++r) { const int ei = (r & 3) + 8 * (r >> 2) + 4 * hi; if (v[r] > bv) { bv = v[r]; bi = ei; } }
                { const auto rv_ = __builtin_amdgcn_permlane32_swap(__float_as_uint(bv), __float_as_uint(bv), false, false); const auto ri_ = __builtin_amdgcn_permlane32_swap((unsigned)bi, (unsigned)bi, false, false);
                  const float v0_ = __uint_as_float(rv_[0]), v1_ = __uint_as_float(rv_[1]); const int i0_ = (int)ri_[0], i1_ = (int)ri_[1];
                  const bool up_ = (v1_ > v0_) || (v1_ == v0_ && i1_ < i0_); bv = up_ ? v1_ : v0_; bi = up_ ? i1_ : i0_; }
                tv[rd] = bv; ti[rd] = bi;
#pragma unroll
                for (int r = 0; r < 16; ++r) { const int ei = (r & 3) + 8 * (r >> 2) + 4 * hi; if (ei == bi) v[r] = -INFINITY; }
            }
            const float e1 = __expf(tv[1] - tv[0]), e2 = __expf(tv[2] - tv[0]), e3 = __expf(tv[3] - tv[0]); const float inv = 1.0f / (1.0f + e1 + e2 + e3);
#pragma unroll
            for (int kk = 0; kk < 2; ++kk) {
                const int me = hi ? (kk ? ti[3] : ti[2]) : (kk ? ti[1] : ti[0]);
                const float mg = (hi ? (kk ? e3 : e2) : (kk ? e1 : 1.0f)) * inv;
                const int pos = __hip_atomic_fetch_add(&hist[me], 1, __ATOMIC_RELAXED, __HIP_MEMORY_SCOPE_WORKGROUP);
                const int a = (F.wave * 32 + r32) * 4 + 2 * hi + kk;
                sel_e[a] = me | (pos << 8); sel_g[a] = mg;
            }
        }
        __syncthreads();
        if (F.tid < NE) base[F.tid] = (int)__hip_atomic_fetch_add((unsigned*)(F.ctl + CW_CNT + (LC * NE + F.tid) * 16), (unsigned)hist[F.tid], RLX_AGENT);
        __syncthreads();
        for (int a = F.tid; a < 1024; a += NTHREADS) { const int se = sel_e[a], ex = se & 255, pos = se >> 8, slot = base[ex] + pos;
            F.ltok[(size_t)ex * LCAP + slot] = (blk * 256 + (a >> 2)) * 4 + (a & 3); F.lg[(size_t)ex * LCAP + slot] = sel_g[a];
            F.inv[(size_t)blk * 1024 + a] = ex | (slot << 8); }
        __syncthreads();
    }
}

struct EpiProj {
    static constexpr bool PERM = true; static constexpr int NVM = 16;
    struct Pre {}; static constexpr int NPRE = 0;
    __device__ __forceinline__ Pre preload(const pg8::Unit&, int, int, int, int) const { return Pre{}; }
    __device__ __forceinline__ void operator()(const f32x4 (&acc)[2][2][4][2], const pg8::Unit& u, int wr, int wc, int fr, int fq, const Pre&) const { (*this)(acc, u, wr, wc, fr, fq); }
    bf16_t* O; unsigned* nrm;
    __device__ __forceinline__ void operator()(const f32x4 (&acc)[2][2][4][2], const pg8::Unit& u, int wr, int wc, int fr, int fq) const {
        const int row0 = u.pm * 256 + wr * 64 + fr, col0 = u.pn * 256 + wc * 32 + 8 * fq;
        const float sc = (u.pn == 0 || u.pn == 3 || u.pn == 5 || u.pn == 6) ? QSCALE : 1.0f;
        float nmx[2] = {0.f, 0.f};
#pragma unroll
        for (int ai = 0; ai < 2; ++ai)
#pragma unroll
            for (int m = 0; m < 4; ++m) { bf16_t* rowp = O + (size_t)(row0 + ai * 128 + m * 16) * INW + col0;
#pragma unroll
                for (int bj = 0; bj < 2; ++bj) { const f32x4 v0 = acc[ai][bj][m][0] * sc, v1 = acc[ai][bj][m][1] * sc;
                    u32x4 w; w.x = cvt_pk_bf16(v0[0], v0[1]); w.y = cvt_pk_bf16(v0[2], v0[3]); w.z = cvt_pk_bf16(v1[0], v1[1]); w.w = cvt_pk_bf16(v1[2], v1[3]);
                    *(GAS u32x4*)(rowp + bj * 128) = w;
                    if (C_TILE_SKIP && u.pn >= 5 && u.pn <= 8) {
                        float q = (v0[0] * v0[0] + v0[1] * v0[1]) + (v0[2] * v0[2] + v0[3] * v0[3]) + (v1[0] * v1[0] + v1[1] * v1[1]) + (v1[2] * v1[2] + v1[3] * v1[3]);
                        q = x32_sum(x16_sum(q)); nmx[bj] = fmaxf(nmx[bj], q); } } }
        if (C_TILE_SKIP && u.pn >= 5 && u.pn <= 8) {
#pragma unroll
            for (int bj = 0; bj < 2; ++bj) { float v = row16_max(nmx[bj]);
                if (fr == 0 && fq == 0) { const int b = u.pm >> 5, qk = u.pn >= 7, blk = (u.pn - (qk ? 7 : 5)) * 8 + bj * 4 + wc;
                    atomicMax(nrm + (b * 2 + qk) * 16 + blk, __float_as_uint(v)); } }
        }
    }
};
struct EpiOut {
    static constexpr bool PERM = false; static constexpr int NVM = 32;
    struct Pre {}; static constexpr int NPRE = 0;
    __device__ __forceinline__ Pre preload(const pg8::Unit&, int, int, int, int) const { return Pre{}; }
    __device__ __forceinline__ void operator()(const f32x4 (&acc)[2][2][4][2], const pg8::Unit& u, int wr, int wc, int fr, int fq, const Pre&) const { (*this)(acc, u, wr, wc, fr, fq); }
    bf16_t* X; const float* g1; float gmul;
    __device__ __forceinline__ void operator()(const f32x4 (&acc)[2][2][4][2], const pg8::Unit& u, int wr, int wc, int fr, int fq) const {
        const int b = u.pm >> 5, col0 = u.pn * 256 + wc * 32 + 4 * fq;
        f32x4 gv[2][2];
#pragma unroll
        for (int bj = 0; bj < 2; ++bj)
#pragma unroll
            for (int n = 0; n < 2; ++n) gv[bj][n] = *(const GAS f32x4*)(g1 + (size_t)b * 6144 + col0 + bj * 128 + n * 16) * gmul;
#pragma unroll
        for (int ai = 0; ai < 2; ++ai) {
            u32x2 xv[4][2][2];
#pragma unroll
            for (int m = 0; m < 4; ++m)
#pragma unroll
                for (int bj = 0; bj < 2; ++bj)
#pragma unroll
                    for (int n = 0; n < 2; ++n) xv[m][bj][n] = *(const GAS u32x2*)(X + (size_t)(u.pm * 256 + ai * 128 + wr * 64 + m * 16 + fr) * DM + col0 + bj * 128 + n * 16);
#pragma unroll
            for (int m = 0; m < 4; ++m)
#pragma unroll
                for (int bj = 0; bj < 2; ++bj)
#pragma unroll
                    for (int n = 0; n < 2; ++n) { const u32x2 xb = xv[m][bj][n]; const f32x4 o = (f32x4){bf_lo(xb.x), bf_hi(xb.x), bf_lo(xb.y), bf_hi(xb.y)} + gv[bj][n] * acc[ai][bj][m][n];
                        u32x2 w; w.x = cvt_pk_bf16(o[0], o[1]); w.y = cvt_pk_bf16(o[2], o[3]);
                        *(GAS u32x2*)(X + (size_t)(u.pm * 256 + ai * 128 + wr * 64 + m * 16 + fr) * DM + col0 + bj * 128 + n * 16) = w; }
            asm volatile("" ::: "memory");
        }
    }
};
struct EpiGU {
    static constexpr bool PERM = true; static constexpr int NVM = 8;
    unsigned char* Hd; const float* bg; const float* bu;
    struct Pre { float b; }; static constexpr int NPRE = 1;
    __device__ __forceinline__ Pre preload(const pg8::Unit& u, int wr, int wc, int fr, int fq) const {
        const int e = u.pn >> 3, pnl = u.pn & 7, hc = pnl * 128 + wc * 32 + 8 * fq; Pre p;
        p.b = __uint_as_float(ld_untracked(((fr & 8) ? bu : bg) + (size_t)e * DM + hc + (fr & 7)));
        return p;
    }
    __device__ __forceinline__ void operator()(const f32x4 (&acc)[2][2][4][2], const pg8::Unit& u, int wr, int wc, int fr, int fq, const Pre& pre) const {
        const int pnl = u.pn & 7, hc = pnl * 128 + wc * 32 + 8 * fq;
        constexpr float ds = 1.0f / (W8_SCALE * H8_SCALE);
        f32x4 bgv[2], buv[2];
        { const int base4 = (lane_id() & 48) * 4;
#pragma unroll
          for (int n = 0; n < 2; ++n)
#pragma unroll
            for (int i = 0; i < 4; ++i) { bgv[n][i] = __int_as_float(__builtin_amdgcn_ds_bpermute(base4 + (n * 4 + i) * 4, __float_as_int(pre.b)));
                                          buv[n][i] = __int_as_float(__builtin_amdgcn_ds_bpermute(base4 + (8 + n * 4 + i) * 4, __float_as_int(pre.b))); } }
#pragma unroll
        for (int ai = 0; ai < 2; ++ai)
#pragma unroll
            for (int m = 0; m < 4; ++m) {
                float hv[8];
#pragma unroll
                for (int n = 0; n < 2; ++n) { const f32x4 a4 = acc[ai][0][m][n] * ds + bgv[n], u4 = acc[ai][1][m][n] * ds + buv[n];
#pragma unroll
                    for (int i = 0; i < 4; ++i) { const float a = fminf(a4[i], 7.0f), uu = fminf(fmaxf(u4[i], -7.0f), 7.0f);
                        const float sg = __builtin_amdgcn_rcpf(1.0f + __builtin_amdgcn_exp2f(-1.702f * LOG2E * a));
                        hv[n * 4 + i] = (a * sg) * __builtin_fmaf(uu, HID8_SCALE, HID8_SCALE); } }
                u32x2 w; w.x = pk4_fp8_nc(hv[0], hv[1], hv[2], hv[3]); w.y = pk4_fp8_nc(hv[4], hv[5], hv[6], hv[7]);
                *(GAS u32x2*)(Hd + (size_t)(u.pm * 256 + ai * 128 + wr * 64 + m * 16 + fr) * DM + hc) = w; }
    }
};
struct EpiDown {
    static constexpr bool PERM = true; static constexpr int NVM = 8;
    unsigned char* Y; const float* bd; const LAS int* tab; const float* lg; LAS unsigned char* stg;
    struct Pre { float b; float g[2]; }; static constexpr int NPRE = 3;
    __device__ __forceinline__ Pre preload(const pg8::Unit& u, int wr, int wc, int fr, int fq) const {
        const int e = u.pn >> 2, pnl = u.pn & 3, col0 = pnl * 256 + wc * 32 + 8 * fq;
        const int pstart = tab[32 + e], cnt = tab[64 + e]; Pre p;
        p.b = __uint_as_float(ld_untracked(bd + (size_t)e * DM + col0 + (fr >> 3) * 128 + (fr & 7)));
#pragma unroll
        for (int ai = 0; ai < 2; ++ai) { const int i = u.pm * 256 + ai * 128 + wr * 64 + fq * 16 + fr - pstart; p.g[ai] = __uint_as_float(ld_untracked(lg + (size_t)e * LCAP + (i < cnt ? i : 0))); }
        return p;
    }
    __device__ __forceinline__ void operator()(const f32x4 (&acc)[2][2][4][2], const pg8::Unit& u, int wr, int wc, int fr, int fq, const Pre& pre) const {
        const int pnl = u.pn & 3, col0 = pnl * 256 + wc * 32 + 8 * fq;
        f32x4 bv[2][2]; float gt[2][4];
        { const int l_ = lane_id(), base4 = (l_ & 48) * 4, fr4 = (l_ & 15) * 4;
#pragma unroll
          for (int bj = 0; bj < 2; ++bj)
#pragma unroll
            for (int n = 0; n < 2; ++n)
#pragma unroll
                for (int i = 0; i < 4; ++i) bv[bj][n][i] = __int_as_float(__builtin_amdgcn_ds_bpermute(base4 + (bj * 8 + n * 4 + i) * 4, __float_as_int(pre.b)));
#pragma unroll
          for (int ai = 0; ai < 2; ++ai)
#pragma unroll
            for (int m = 0; m < 4; ++m) gt[ai][m] = __int_as_float(__builtin_amdgcn_ds_bpermute(m * 64 + fr4, __float_as_int(pre.g[ai]))); }
        LAS unsigned char* sg_ = stg + wr * EPI_STG_GRP;
        const int l_ = lane_id(), rrow = wc * 16 + (l_ >> 3), rch = l_ & 7;
#pragma unroll
        for (int ai = 0; ai < 2; ++ai)
#pragma unroll
            for (int bj = 0; bj < 2; ++bj) {
#pragma unroll
                for (int m = 0; m < 4; ++m) { constexpr float ds = 1.0f / (W8_SCALE * HID8_SCALE); const float g_ = gt[ai][m] * Y8_SCALE;
                    const f32x4 v0 = (acc[ai][bj][m][0] * ds + bv[bj][0]) * g_, v1 = (acc[ai][bj][m][1] * ds + bv[bj][1]) * g_;
                    u32x2 w; w.x = pk4_fp8(v0[0], v0[1], v0[2], v0[3]); w.y = pk4_fp8(v1[0], v1[1], v1[2], v1[3]);
                    *(LAS u32x2*)(sg_ + (m * 16 + fr) * EPI_STG_ROW + wc * 32 + 8 * fq) = w; }
                asm volatile("s_waitcnt lgkmcnt(0)\n\ts_barrier" ::: "memory");
#pragma unroll
                for (int k = 0; k < 2; ++k) { const int r64 = rrow + 8 * k; const u32x4 v = *(const LAS u32x4*)(sg_ + r64 * EPI_STG_ROW + rch * 16);
                    __builtin_nontemporal_store(v, (GAS u32x4*)(Y + (size_t)(u.pm * 256 + ai * 128 + wr * 64 + r64) * DM + pnl * 256 + bj * 128 + rch * 16)); }
                asm volatile("s_waitcnt lgkmcnt(0)\n\ts_barrier" ::: "memory");
            }
    }
};
struct MoeSched {
    const LAS int* tab; int NTs  , NBk, G, vcu; const int* ltok;
    __device__ __forceinline__ bool next(int i, pg8::Unit& u) const {
        const int L = i * G + vcu, per = 32 << NTs, chunk = L / per, rem = L % per, pnl = rem & ((1 << NTs) - 1), rb = chunk * 32 + (rem >> NTs);
        if (rb >= NBk) return false;
        const int pe = tab[lane_id() & 31];
        const unsigned long long bal = __ballot(pe <= rb * 256);
        const int e = __popc((unsigned)bal);
        u.pm = rb; u.pn = (e << NTs) + pnl; return true;
    }
    __device__ __forceinline__ unsigned arow(const pg8::Unit& u, int r) const {
        const int e = u.pn >> NTs, i = u.pm * 256 + r - tab[32 + e];
        return (i < tab[64 + e]) ? ((unsigned)ltok[(size_t)e * LCAP + i] >> 2) : 0u;
    }
    __device__ __forceinline__ unsigned arow_raw(const pg8::Unit& u, int r) const {
        const int e = u.pn >> NTs, i = u.pm * 256 + r - tab[32 + e];
        return ld_untracked(ltok + (size_t)e * LCAP + (i < tab[64 + e] ? i : 0));
    }
};
__device__ __forceinline__ void moe_table(Frame& F, int L) {
    LAS int* tab = (LAS int*)(F.misc + MO_TAB);
    if (F.tid < 64) {
        const int e = F.tid & 31;
        const int c = (int)__hip_atomic_load((unsigned*)(F.ctl + CW_CNT + (L * NE + e) * 16), RLX_AGENT);
        int p = (c + 255) & ~255, incl = p;
#pragma unroll
        for (int e2 = 0; e2 < 31; ++e2) { const int v_ = __builtin_amdgcn_readlane(p, e2); incl += (e > e2) ? v_ : 0; }
        if (F.tid < 32) { tab[e] = incl; tab[32 + e] = incl - p; tab[64 + e] = c; if (e == 31) tab[96] = incl >> 8; }
    }
    __syncthreads();
}

namespace att {
typedef short v4i16_t __attribute__((ext_vector_type(4)));
typedef LAS const char* lds_cptr;
__device__ __forceinline__ int crow(int r, int hi) { return (r & 3) + 8 * (r >> 2) + 4 * hi; }
__device__ __forceinline__ void glds16(const void* gsrc, unsigned lds_dst) { unsigned keep;
    asm volatile("s_mov_b32 %0, m0\n\ts_mov_b32 m0, %2\n\ts_nop 0\n\tglobal_load_lds_dwordx4 %1, off\n\ts_mov_b32 m0, %0" : "=&s"(keep) : "v"(gsrc), "s"(lds_dst) : "memory"); }
__device__ __forceinline__ void glds16s(const void* sbase, unsigned voff, unsigned lds_dst) { unsigned keep;
    asm volatile("s_mov_b32 %0, m0\n\ts_mov_b32 m0, %3\n\ts_nop 0\n\tglobal_load_lds_dwordx4 %1, %2\n\ts_mov_b32 m0, %0" : "=&s"(keep) : "v"(voff), "s"(sbase), "s"(lds_dst) : "memory"); }
__device__ __forceinline__ u32x2 vtr2(lds_cptr p) { return __builtin_bit_cast(u32x2, __builtin_amdgcn_ds_read_tr16_b64_v4i16((LAS v4i16_t*)p)); }
__device__ __forceinline__ bf16x8 vcat(u32x2 lo, u32x2 hv) { return __builtin_bit_cast(bf16x8, (u32x4){lo.x, lo.y, hv.x, hv.y}); }
__device__ __forceinline__ s16x4 vtr(lds_cptr p) { return __builtin_bit_cast(s16x4, __builtin_amdgcn_ds_read_tr16_b64_v4i16((LAS v4i16_t*)p)); }
#define ATT_WAIT_BAR(N) asm volatile("s_waitcnt vmcnt(" #N ") lgkmcnt(0)\n\ts_barrier" ::: "memory")
#define ATT_MFMA(a, b, c) __builtin_amdgcn_mfma_f32_32x32x16_bf16((a), (b), (c), 0, 0, 0)
__device__ __forceinline__ bf16x8 pack8(const f32x16& p, int s) {
    u32x4 w; w.x = cvt_pk_bf16(p[8 * s + 0], p[8 * s + 1]); w.y = cvt_pk_bf16(p[8 * s + 2], p[8 * s + 3]); w.z = cvt_pk_bf16(p[8 * s + 4], p[8 * s + 5]); w.w = cvt_pk_bf16(p[8 * s + 6], p[8 * s + 7]);
    return __builtin_bit_cast(bf16x8, w);
}
__device__ __forceinline__ u32x4 pair16(u32x2 w0, u32x2 w1) {
    const auto x = __builtin_amdgcn_permlane32_swap(w0.x, w1.x, false, false);
    const auto y = __builtin_amdgcn_permlane32_swap(w0.y, w1.y, false, false);
    return (u32x4){x[0], y[0], x[1], y[1]};
}
__device__ __forceinline__ float xmax32(float v) { const auto r = __builtin_amdgcn_permlane32_swap(__float_as_uint(v), __float_as_uint(v), false, false); return fmaxf(__uint_as_float(r[0]), __uint_as_float(r[1])); }
__device__ __forceinline__ float xsum32(float v) { const auto r = __builtin_amdgcn_permlane32_swap(__float_as_uint(v), __float_as_uint(v), false, false); return __uint_as_float(r[0]) + __uint_as_float(r[1]); }
__device__ __forceinline__ float max16(const f32x16& p) {
    float a = fmaxf(fmaxf(p[0], p[1]), fmaxf(p[2], p[3])), b = fmaxf(fmaxf(p[4], p[5]), fmaxf(p[6], p[7]));
    float c = fmaxf(fmaxf(p[8], p[9]), fmaxf(p[10], p[11])), d = fmaxf(fmaxf(p[12], p[13]), fmaxf(p[14], p[15]));
    return fmaxf(fmaxf(a, b), fmaxf(c, d));
}
__device__ __forceinline__ float sum16(const f32x16& p) {
    float a = (p[0] + p[1]) + (p[2] + p[3]), b = (p[4] + p[5]) + (p[6] + p[7]), c = (p[8] + p[9]) + (p[10] + p[11]), d = (p[12] + p[13]) + (p[14] + p[15]);
    return (a + b) + (c + d);
}

constexpr int C_KSLOT = 16384, C_VRING = 65536;
#define SBAR() __builtin_amdgcn_sched_barrier(0)
#define PIN(x) asm volatile("" : "+v"(x))
#define MX3(a, b, c) __builtin_fmaxf(__builtin_fmaxf((a), (b)), (c))
#define EX2(v) __builtin_amdgcn_exp2f(v)
#define PAF(k) __builtin_bit_cast(bf16x8, pw##k)
#define VRD(i) do { vl_[i] = vtr2(vp_ + (((i) & 3) * 4096 + ((i) >> 2) * 1024)); vh_[i] = vtr2(vp_ + (((i) & 3) * 4096 + ((i) >> 2) * 1024 + 512)); } while (0)
#define VFR(i) vcat(vl_[i], vh_[i])
#define FMAMK(d, a, K, c) asm("v_fmamk_f32 %0, %1, %3, %2" : "=v"(d) : "v"(a), "v"(c), "i"(__builtin_bit_cast(int, (float)(K))))
#define ATTC_STEP(C0, C1, P0, P1, t, GK, GV, GL) do { SBAR(); \
    const lds_cptr kc_ = kp0 + (((t) & 3) << 14); float sacc = P0[0] + P0[1]; \
    kf[2] = *(const LAS bf16x8*)(KXA(kc_, 1) + 0); C0 = ATT_MFMA(kf[0], qr[0], C0); sacc += P0[2]; sacc += P0[3]; sacc += P0[4]; sacc += P0[5]; PIN(sacc); pw0[0] = cvt_pk_bf16(P0[0], P0[1]); pw0[1] = cvt_pk_bf16(P0[2], P0[3]); PIN(pw0); SBAR(); \
    kf[3] = *(const LAS bf16x8*)(KXA(kc_, 1) + 4096); C1 = ATT_MFMA(kf[1], qr[0], C1); sacc += P0[6]; sacc += P0[7]; sacc += P0[8]; sacc += P0[9]; PIN(sacc); pw0[2] = cvt_pk_bf16(P0[4], P0[5]); pw0[3] = cvt_pk_bf16(P0[6], P0[7]); PIN(pw0); SBAR(); \
    kf[4] = *(const LAS bf16x8*)(KXA(kc_, 2) + 0); C0 = ATT_MFMA(kf[2], qr[1], C0); sacc += P0[10]; sacc += P0[11]; sacc += P0[12]; sacc += P0[13]; PIN(sacc); pw1[0] = cvt_pk_bf16(P0[8], P0[9]); pw1[1] = cvt_pk_bf16(P0[10], P0[11]); PIN(pw1); SBAR(); \
    kf[5] = *(const LAS bf16x8*)(KXA(kc_, 2) + 4096); C1 = ATT_MFMA(kf[3], qr[1], C1); sacc += P0[14]; sacc += P0[15]; sacc += P1[0]; sacc += P1[1]; PIN(sacc); pw1[2] = cvt_pk_bf16(P0[12], P0[13]); pw1[3] = cvt_pk_bf16(P0[14], P0[15]); PIN(pw1); SBAR(); \
    kf[6] = *(const LAS bf16x8*)(KXA(kc_, 3) + 0); C0 = ATT_MFMA(kf[4], qr[2], C0); sacc += P1[2]; sacc += P1[3]; sacc += P1[4]; sacc += P1[5]; PIN(sacc); pw2[0] = cvt_pk_bf16(P1[0], P1[1]); pw2[1] = cvt_pk_bf16(P1[2], P1[3]); PIN(pw2); SBAR(); \
    kf[7] = *(const LAS bf16x8*)(KXA(kc_, 3) + 4096); C1 = ATT_MFMA(kf[5], qr[2], C1); sacc += P1[6]; sacc += P1[7]; sacc += P1[8]; sacc += P1[9]; PIN(sacc); pw2[2] = cvt_pk_bf16(P1[4], P1[5]); pw2[3] = cvt_pk_bf16(P1[6], P1[7]); PIN(pw2); SBAR(); \
    C0 = ATT_MFMA(kf[6], qr[3], C0); sacc += P1[10]; sacc += P1[11]; sacc += P1[12]; sacc += P1[13]; PIN(sacc); pw3[0] = cvt_pk_bf16(P1[8], P1[9]); pw3[1] = cvt_pk_bf16(P1[10], P1[11]); PIN(pw3); SBAR(); \
    C1 = ATT_MFMA(kf[7], qr[3], C1); sacc += P1[14]; sacc += P1[15]; PIN(sacc); pw3[2] = cvt_pk_bf16(P1[12], P1[13]); pw3[3] = cvt_pk_bf16(P1[14], P1[15]); PIN(pw3); SBAR(); \
    l_reg += sacc; \
    if (GK) { C_DMA_K((t) + 3, ((((t) + 3) & 3) << 14)); } if (GV) { C_DMA_V((t) + 1, sl_next); } \
    const lds_cptr vp_ = vp0 + sl_prev; const lds_cptr kn_ = kp0 + ((((t) + 1) & 3) << 14); \
    const int tn_ = (t) + 1; float sg_ = (tn_ < tm) ? slope2 : -slope2; PIN(sg_); \
    u32x2 vl_[16], vh_[16]; \
    VRD(0); VRD(1); SBAR(); \
    VRD(2); o[0] = ATT_MFMA(VFR(0), PAF(0), o[0]); float ma_ = MX3(C0[0], C0[1], C0[2]); float mb_ = MX3(C0[3], C0[4], C0[5]); ma_ = MX3(ma_, C0[6], C0[7]); mb_ = MX3(mb_, C0[8], C0[9]); PIN(ma_); PIN(mb_); SBAR(); \
    VRD(3); o[1] = ATT_MFMA(VFR(1), PAF(0), o[1]); ma_ = MX3(ma_, C0[10], C0[11]); mb_ = MX3(mb_, C0[12], C0[13]); ma_ = MX3(ma_, C0[14], C0[15]); mb_ = MX3(mb_, C1[0], C1[1]); PIN(ma_); PIN(mb_); SBAR(); \
    VRD(4); o[2] = ATT_MFMA(VFR(2), PAF(0), o[2]); ma_ = MX3(ma_, C1[2], C1[3]); mb_ = MX3(mb_, C1[4], C1[5]); ma_ = MX3(ma_, C1[6], C1[7]); mb_ = MX3(mb_, C1[8], C1[9]); PIN(ma_); PIN(mb_); SBAR(); \
    VRD(5); o[3] = ATT_MFMA(VFR(3), PAF(0), o[3]); ma_ = MX3(ma_, C1[10], C1[11]); mb_ = MX3(mb_, C1[12], C1[13]); ma_ = MX3(ma_, C1[14], C1[15]); PIN(ma_); PIN(mb_); SBAR(); \
    { float rm_ = __builtin_fmaxf(ma_, mb_); { auto rr_ = __builtin_amdgcn_permlane32_swap(__float_as_uint(rm_), __float_as_uint(rm_), false, false); rm_ = __builtin_fmaxf(__uint_as_float(rr_[0]), __uint_as_float(rr_[1])); } \
      resc = false; \
      if (__builtin_expect(__any(rm_ > 8.0f), 0)) { const float dl_ = __builtin_fmaxf(rm_, 0.f); m += dl_; \
        _Pragma("unroll") for (int r_ = 0; r_ < 16; ++r_) { C0[r_] -= dl_; C1[r_] -= dl_; } \
        fsc = __builtin_amdgcn_exp2f(-dl_); l_reg *= fsc; resc = true; rm_ -= dl_; } \
      pz = __all(rm_ < -150.0f); } \
    const float ib_ = sg_ * ((float)(64 * tn_ + 4 * hi) - qf) - m; SBAR(); \
    VRD(6); o[0] = ATT_MFMA(VFR(4), PAF(1), o[0]); C0[0] = EX2(C0[0]); C0[1] = EX2(C0[1]); C0[2] = EX2(C0[2]); FMAMK(P0[0], sg_, 0.0f, ib_); FMAMK(P0[1], sg_, 1.0f, ib_); FMAMK(P0[2], sg_, 2.0f, ib_); PIN(C0); PIN(P0); SBAR(); \
    VRD(7); o[1] = ATT_MFMA(VFR(5), PAF(1), o[1]); C0[3] = EX2(C0[3]); C0[4] = EX2(C0[4]); C0[5] = EX2(C0[5]); FMAMK(P0[3], sg_, 3.0f, ib_); FMAMK(P0[4], sg_, 8.0f, ib_); FMAMK(P0[5], sg_, 9.0f, ib_); PIN(C0); PIN(P0); SBAR(); \
    VRD(8); o[2] = ATT_MFMA(VFR(6), PAF(1), o[2]); C0[6] = EX2(C0[6]); C0[7] = EX2(C0[7]); FMAMK(P0[6], sg_, 10.0f, ib_); FMAMK(P0[7], sg_, 11.0f, ib_); PIN(C0); PIN(P0); SBAR(); \
    VRD(9); o[3] = ATT_MFMA(VFR(7), PAF(1), o[3]); C0[8] = EX2(C0[8]); C0[9] = EX2(C0[9]); C0[10] = EX2(C0[10]); FMAMK(P0[8], sg_, 16.0f, ib_); FMAMK(P0[9], sg_, 17.0f, ib_); FMAMK(P0[10], sg_, 18.0f, ib_); PIN(C0); PIN(P0); SBAR(); \
    VRD(10); o[0] = ATT_MFMA(VFR(8), PAF(2), o[0]); C0[11] = EX2(C0[11]); C0[12] = EX2(C0[12]); C0[13] = EX2(C0[13]); FMAMK(P0[11], sg_, 19.0f, ib_); FMAMK(P0[12], sg_, 24.0f, ib_); FMAMK(P0[13], sg_, 25.0f, ib_); PIN(C0); PIN(P0); SBAR(); \
    VRD(11); o[1] = ATT_MFMA(VFR(9), PAF(2), o[1]); C0[14] = EX2(C0[14]); C0[15] = EX2(C0[15]); FMAMK(P0[14], sg_, 26.0f, ib_); FMAMK(P0[15], sg_, 27.0f, ib_); PIN(C0); PIN(P0); SBAR(); \
    if (GL) { kf[0] = *(const LAS bf16x8*)(KXA(kn_, 0) + 0); } VRD(12); o[2] = ATT_MFMA(VFR(10), PAF(2), o[2]); C1[0] = EX2(C1[0]); C1[1] = EX2(C1[1]); C1[2] = EX2(C1[2]); FMAMK(P1[0], sg_, 32.0f, ib_); FMAMK(P1[1], sg_, 33.0f, ib_); FMAMK(P1[2], sg_, 34.0f, ib_); PIN(C1); PIN(P1); SBAR(); \
    if (GL) { kf[1] = *(const LAS bf16x8*)(KXA(kn_, 0) + 4096); } VRD(13); o[3] = ATT_MFMA(VFR(11), PAF(2), o[3]); C1[3] = EX2(C1[3]); C1[4] = EX2(C1[4]); C1[5] = EX2(C1[5]); FMAMK(P1[3], sg_, 35.0f, ib_); FMAMK(P1[4], sg_, 40.0f, ib_); FMAMK(P1[5], sg_, 41.0f, ib_); PIN(C1); PIN(P1); SBAR(); \
    VRD(14); o[0] = ATT_MFMA(VFR(12), PAF(3), o[0]); C1[6] = EX2(C1[6]); C1[7] = EX2(C1[7]); FMAMK(P1[6], sg_, 42.0f, ib_); FMAMK(P1[7], sg_, 43.0f, ib_); PIN(C1); PIN(P1); SBAR(); \
    VRD(15); o[1] = ATT_MFMA(VFR(13), PAF(3), o[1]); C1[8] = EX2(C1[8]); C1[9] = EX2(C1[9]); C1[10] = EX2(C1[10]); FMAMK(P1[8], sg_, 48.0f, ib_); FMAMK(P1[9], sg_, 49.0f, ib_); FMAMK(P1[10], sg_, 50.0f, ib_); PIN(C1); PIN(P1); SBAR(); \
    o[2] = ATT_MFMA(VFR(14), PAF(3), o[2]); C1[11] = EX2(C1[11]); C1[12] = EX2(C1[12]); C1[13] = EX2(C1[13]); FMAMK(P1[11], sg_, 51.0f, ib_); FMAMK(P1[12], sg_, 56.0f, ib_); FMAMK(P1[13], sg_, 57.0f, ib_); PIN(C1); PIN(P1); SBAR(); \
    o[3] = ATT_MFMA(VFR(15), PAF(3), o[3]); C1[14] = EX2(C1[14]); C1[15] = EX2(C1[15]); FMAMK(P1[14], sg_, 58.0f, ib_); FMAMK(P1[15], sg_, 59.0f, ib_); PIN(C1); PIN(P1); SBAR(); \
    if (tn_ == tm) { const float db_ = (float)(64 * tn_ + 4 * hi) - qf; \
      _Pragma("unroll") for (int r_ = 0; r_ < 16; ++r_) { const float c_ = (float)((r_ & 3) + 8 * (r_ >> 2)); \
        P0[r_] = __builtin_fmaf(-__builtin_fabsf(db_ + c_), slope2, -m); P1[r_] = __builtin_fmaf(-__builtin_fabsf(db_ + (32.f + c_)), slope2, -m); } } \
    } while (0)

__device__ __forceinline__ bool attnC_unit(const bf16_t* P, bf16_t* MX, const float* gainv  , int b, int h, int qb, float slope2, float lam, float post, LAS unsigned char* shm, int wid, int lane, int T0, int NT, volatile LAS unsigned* badw) {
    const int r32 = lane & 31, hi = lane >> 5, rg = wid & 3, mp = wid >> 2;
    const size_t rowbase = (size_t)b * SEQ;
    const int q0 = qb * 128 + rg * 32, tm = (q0 >> 6) - T0;
    const bf16_t* qp = P + (rowbase + q0 + r32) * INW + C_QC + h * 128 + mp * 64 + hi * 8;
    bf16x8 qr[4];
#pragma unroll
    for (int d0 = 0; d0 < 4; ++d0) qr[d0] = *(const GAS bf16x8*)(qp + d0 * 16);
    const bf16_t* kbase = P + (rowbase + (size_t)T0 * 64) * INW + C_KC + h * 128;
    const bf16_t* vbase = P + (rowbase + (size_t)T0 * 64) * INW + C_VC + h * 128;
    const int c4 = wid >> 1, ks0 = 2 * (wid & 1);
    const int frow = 8 * wid + (lane >> 3);
    const unsigned voffk = (unsigned)(frow * INW + (((lane & 7) ^ ((frow >> 1) & 7)) * 8)) * 2u;
    const unsigned voffv = (unsigned)((16 * ks0 + (lane >> 2)) * INW + c4 * 32 + (lane & 3) * 8) * 2u;
    const unsigned lds0 = (unsigned)(size_t)shm;
    const unsigned d_k1 = lds0 + wid * 1024, d_k2 = lds0 + 8192 + wid * 1024, d_v0 = lds0 + C_VRING + (2 * wid) * 1024, d_v1 = d_v0 + 1024;
#define C_DMA_K(t, slot) do { const bf16_t* _b = kbase + (size_t)(t) * 64 * INW; \
        glds16s(_b, voffk, (unsigned)__builtin_amdgcn_readfirstlane(d_k1 + (slot))); glds16s(_b + 64, voffk, (unsigned)__builtin_amdgcn_readfirstlane(d_k2 + (slot))); } while (0)
#define C_DMA_V(t, slot) do { const bf16_t* _b = vbase + (size_t)(t) * 64 * INW; \
        glds16s(_b, voffv, (unsigned)__builtin_amdgcn_readfirstlane(d_v0 + (slot))); glds16s(_b + 16 * INW, voffv, (unsigned)__builtin_amdgcn_readfirstlane(d_v1 + (slot))); } while (0)
    const lds_cptr shm3 = (lds_cptr)shm;
    const lds_cptr kp0 = shm3 + mp * 8192 + r32 * 128 + ((hi ^ ((r32 >> 1) & 7)) * 16);
#define KXA(base, d0) ((lds_cptr)(size_t)((unsigned)(size_t)(base) ^ (unsigned)((d0) << 5)))
    const lds_cptr vp0 = shm3 + C_VRING + ((lane >> 4) & 1) * 32 + (lane & 3) * 8 + (4 * hi + ((lane & 15) >> 2)) * 64;
    if (C_TILE_SKIP == 1 && wid == 0 && lane == 0) *badw = 0u;
    C_DMA_K(0, 0); C_DMA_V(0, 0); C_DMA_K(1, C_KSLOT);
    float m = 0.f, l_reg = 0.f, fsc = 1.f; bool resc = false, pz = false; (void)pz;
    f32x16 o[4];
#pragma unroll
    for (int c = 0; c < 4; ++c)
#pragma unroll
        for (int r = 0; r < 16; ++r) o[c][r] = 0.f;
    const float qf = (float)(q0 + r32 - 64 * T0);
    f32x16 pA0, pA1, pB0, pB1; bf16x8 kf[8]; u32x4 pw0, pw1, pw2, pw3;
    int sl_prev = 0, sl_cur = 0, sl_next = C_KSLOT;
#define C_ROT() do { sl_prev = sl_cur; sl_cur = sl_next; sl_next = (sl_next == 2 * C_KSLOT) ? 0 : sl_next + C_KSLOT; } while (0)
#define C_RESC() do { if (resc) { _Pragma("unroll") for (int c_ = 0; c_ < 4; ++c_) _Pragma("unroll") for (int r_ = 0; r_ < 16; ++r_) o[c_][r_] *= fsc; } } while (0)
#define C_INIT(X0, X1, tn) do { const float db_ = (float)(64 * (tn) + 4 * hi) - qf; \
        _Pragma("unroll") for (int r_ = 0; r_ < 16; ++r_) { const float c_ = (float)((r_ & 3) + 8 * (r_ >> 2)); \
            X0[r_] = __builtin_fmaf(-__builtin_fabsf(db_ + c_), slope2, -m); X1[r_] = __builtin_fmaf(-__builtin_fabsf(db_ + (32.f + c_)), slope2, -m); } } while (0)
#define C_KLOAD8(kp) do { _Pragma("unroll") for (int j_ = 0; j_ < 8; ++j_) kf[j_] = *(const LAS bf16x8*)(KXA((kp), j_ >> 1) + (j_ & 1) * 4096); } while (0)
    C_DMA_K(2, 2 * C_KSLOT);
    C_INIT(pA0, pA1, 0);
    ATT_WAIT_BAR(6);
    C_KLOAD8(kp0);
#pragma unroll
    for (int i = 0; i < 8; ++i) { if (i & 1) pA1 = ATT_MFMA(kf[i], qr[i >> 1], pA1); else pA0 = ATT_MFMA(kf[i], qr[i >> 1], pA0); }
    { float rm = fmaxf(max16(pA0), max16(pA1)); rm = xmax32(rm);
      if (__any(rm > 8.0f)) { const float dl = fmaxf(rm, 0.f); m += dl;
#pragma unroll
          for (int r = 0; r < 16; ++r) { pA0[r] -= dl; pA1[r] -= dl; } }
#pragma unroll
      for (int r = 0; r < 16; ++r) { pA0[r] = EX2(pA0[r]); pA1[r] = EX2(pA1[r]); } }
    ATT_WAIT_BAR(0);
    C_DMA_K(3, 3 * C_KSLOT); C_DMA_V(1, C_KSLOT);
    C_ROT();
    { const lds_cptr k1_ = kp0 + C_KSLOT; kf[0] = *(const LAS bf16x8*)(k1_); kf[1] = *(const LAS bf16x8*)(k1_ + 4096); }
    C_INIT(pB0, pB1, 1);
    if (wid >= 4) __builtin_amdgcn_s_setprio(1);
    int t = 1;
    for (; t + 5 < NT; t += 2) {
        ATTC_STEP(pB0, pB1, pA0, pA1, t, true, true, true);     ATT_WAIT_BAR(4); C_RESC(); C_ROT();
        ATTC_STEP(pA0, pA1, pB0, pB1, t + 1, true, true, true); ATT_WAIT_BAR(4); C_RESC(); C_ROT();
    }
#define C_ENDW(tt) do { if ((tt) + 3 < NT) { ATT_WAIT_BAR(4); } else if ((tt) + 2 < NT) { ATT_WAIT_BAR(2); } else { ATT_WAIT_BAR(0); } } while (0)
    for (; t + 1 < NT; t += 2) {
        ATTC_STEP(pB0, pB1, pA0, pA1, t, (t + 3 < NT), (t + 1 < NT), (t + 1 < NT));         C_ENDW(t);     C_RESC(); C_ROT();
        ATTC_STEP(pA0, pA1, pB0, pB1, t + 1, (t + 4 < NT), (t + 2 < NT), (t + 2 < NT));     C_ENDW(t + 1); C_RESC(); C_ROT();
    }
    ATTC_STEP(pB0, pB1, pA0, pA1, NT - 1, false, false, false); C_RESC();
    __builtin_amdgcn_s_setprio(0);
    { l_reg += sum16(pB0) + sum16(pB1);
      const bf16x8 q0_ = pack8(pB0, 0), q1_ = pack8(pB0, 1), q2_ = pack8(pB1, 0), q3_ = pack8(pB1, 1);
      const lds_cptr vp = vp0 + sl_cur;
#pragma unroll
      for (int c = 0; c < 4; ++c)
#pragma unroll
          for (int s = 0; s < 4; ++s) {
              const bf16x8 vf = vcat(vtr2(vp + c * 4096 + s * 1024), vtr2(vp + c * 4096 + s * 1024 + 512));
              o[c] = ATT_MFMA(vf, s == 0 ? q0_ : s == 1 ? q1_ : s == 2 ? q2_ : q3_, o[c]);
          } }
    if (C_TILE_SKIP == 1 && NT < SEQ / 64) {
        const int NF = SEQ / 64 - NT;
        ATT_WAIT_BAR(0);
#define C_FAR(i) (((i) < T0) ? (i) - T0 : (i) - T0 + NT)
#define C_DMA_KF(trel, slot) do { const bf16_t* _b = kbase + (ptrdiff_t)(trel) * 64 * INW; \
        glds16s(_b, voffk, (unsigned)__builtin_amdgcn_readfirstlane(d_k1 + (slot))); glds16s(_b + 64, voffk, (unsigned)__builtin_amdgcn_readfirstlane(d_k2 + (slot))); } while (0)
        const int NP = NF >> 1;
        C_DMA_KF(C_FAR(0), 0); C_DMA_KF(C_FAR(1), C_KSLOT);
        if (NP > 1) { C_DMA_KF(C_FAR(2), 2 * C_KSLOT); C_DMA_KF(C_FAR(3), 3 * C_KSLOT); }
        bool badl = false;
        int s0 = 0, s2 = 4 * C_KSLOT;
        for (int p = 0; p < NP; ++p) {
            if (p + 1 < NP) { ATT_WAIT_BAR(4); } else { ATT_WAIT_BAR(0); }
            if (p + 2 < NP) { C_DMA_KF(C_FAR(2 * p + 4), s2); C_DMA_KF(C_FAR(2 * p + 5), s2 + C_KSLOT); }
            f32x16 c[2][2];
#pragma unroll
            for (int u = 0; u < 2; ++u)
#pragma unroll
                for (int r = 0; r < 16; ++r) { c[u][0][r] = 0.f; c[u][1][r] = 0.f; }
#pragma unroll
            for (int j = 0; j < 8; ++j)
#pragma unroll
                for (int u = 0; u < 2; ++u) { const bf16x8 kfj = *(const LAS bf16x8*)(KXA(kp0 + s0 + u * C_KSLOT, j >> 1) + (j & 1) * 4096);
                    c[u][j & 1] = ATT_MFMA(kfj, qr[j >> 1], c[u][j & 1]); }
#pragma unroll
            for (int u = 0; u < 2; ++u) {
                const int trel = C_FAR(2 * p + u);
                const float dmin = (trel < tm) ? (qf - (float)(64 * trel + 63)) : ((float)(64 * trel) - qf);
                badl |= !(fmaxf(max16(c[u][0]), max16(c[u][1])) - slope2 * dmin - m < -150.0f);
            }
            s0 = (s0 == 4 * C_KSLOT) ? 0 : s0 + 2 * C_KSLOT; s2 = (s2 == 4 * C_KSLOT) ? 0 : s2 + 2 * C_KSLOT;
        }
        if (__any(badl) && lane == 0) *badw = 1u;
#undef C_FAR
#undef C_DMA_KF
    }
#undef C_DMA_K
#undef C_DMA_V
#undef C_ROT
#undef C_RESC
#undef C_INIT
#undef C_KLOAD8
#undef KXA
#undef C_ENDW
    float l = xsum32(l_reg);
    const float inv = 1.0f / l;
    ATT_WAIT_BAR(0);
    LAS float* x2 = (LAS float*)shm + rg * 4096;
    if (mp == 1) {
        const float sc = inv * lam;
#pragma unroll
        for (int c = 0; c < 4; ++c)
#pragma unroll
            for (int r = 0; r < 16; ++r) x2[(c * 16 + r) * 64 + lane] = o[c][r] * sc;
    }
    ATT_WAIT_BAR(0);
    if (mp == 0) {
        float ss = 0.f;
#pragma unroll
        for (int c = 0; c < 4; ++c)
#pragma unroll
            for (int r = 0; r < 16; ++r) { const float v = o[c][r] * inv - x2[(c * 16 + r) * 64 + lane]; o[c][r] = v; ss += v * v; }
        ss = xsum32(ss);
        const float rn = post / sqrtf(ss * (1.0f / 128.0f) + RMS_EPS);
        bf16_t* op = MX + (rowbase + q0 + r32) * DM + 512 + h * 128;
#pragma unroll
        for (int c = 0; c < 4; ++c)
#pragma unroll
            for (int g = 0; g < 4; g += 2) { const f32x4 gv0 = *(const GAS f32x4*)(gainv + 32 * c + 8 * g + 4 * hi), gv1 = *(const GAS f32x4*)(gainv + 32 * c + 8 * g + 8 + 4 * hi);
                u32x2 w0, w1;
                w0.x = cvt_pk_bf16(o[c][4 * g + 0] * rn * gv0.x, o[c][4 * g + 1] * rn * gv0.y); w0.y = cvt_pk_bf16(o[c][4 * g + 2] * rn * gv0.z, o[c][4 * g + 3] * rn * gv0.w);
                w1.x = cvt_pk_bf16(o[c][4 * g + 4] * rn * gv1.x, o[c][4 * g + 5] * rn * gv1.y); w1.y = cvt_pk_bf16(o[c][4 * g + 6] * rn * gv1.z, o[c][4 * g + 7] * rn * gv1.w);
                *(GAS u32x4*)(op + 32 * c + 8 * (g + hi)) = pair16(w0, w1); }
    }
    VM_WAIT();
    const bool bad = (C_TILE_SKIP == 1) && (*badw != 0u);
    ATT_WAIT_BAR(0);
    return bad;
}
#undef SBAR
#undef PIN
#undef MX3
#undef EX2
#undef PAF
#undef VRD
#undef VFR
#undef FMAMK

template <int MODE> __device__ __forceinline__ void band_desc(int n, int q0, int& kb, int& ks, int& W) {
    if (MODE == 1) { if (n < 3) { kb = q0 - 1024 + 1024 * n; ks = 16; W = 1024; } else { kb = q0 - 256 + 256 * (n - 3); ks = 4; W = 256; } }
    else if (MODE == 2) { kb = q0 - 64 + 64 * n; ks = 1; W = 64; }
    else { kb = q0 - 128 + 64 * n; ks = 1; W = 128; }
}
constexpr int BK_S = 1056, BV_OFF = 8 * BK_S, BV_S = 4224;
template <int MODE, int NQ>
__device__ __forceinline__ void band_task(const bf16_t* P, size_t rowbase, int kcol, int vcol, int q0, const float (&slope2)[NQ], int qtok,
                                          const bf16_t* const (&qp)[NQ]  , float (&m)[NQ], float (&l)[NQ], f32x16 (&o)[NQ][2], LAS unsigned char* wl, int lane_in) {
    const int lane = lane_id(); (void)lane_in;
    const int r32 = lane & 31, hi = lane >> 5;
    const unsigned kbase_l = (unsigned)(size_t)((lds_cptr)wl + r32 * 128 + ((hi ^ ((r32 >> 1) & 7)) * 16));
    const lds_cptr vp = (lds_cptr)wl + BV_OFF + ((lane >> 4) & 1) * 32 + (lane & 3) * 8 + (4 * hi + ((lane & 15) >> 2)) * 64;
    const unsigned ldsk = (unsigned)(size_t)wl;
    const float qf = (float)qtok;
    constexpr int NTL = MODE == 1 ? 7 : (MODE == 2 ? 3 : 5);
    unsigned mask = 0u;
#pragma unroll
    for (int n = 0; n < NTL; ++n) { int kb, ks, W; band_desc<MODE>(n, q0, kb, ks, W); if (!(kb + ks * 63 < 0 || kb >= SEQ)) mask |= 1u << n; }
    if (!mask) return;
    u32x4 vr[8];
    const int lrow = lane >> 3, lch = lane & 7;
    LAS unsigned char* vw = wl + BV_OFF + (lch >> 2) * BV_S + lrow * 64 + (lch & 3) * 16;
    const bf16_t* kgb = P + rowbase * INW + kcol; const char* vgb = (const char*)(P + rowbase * INW + vcol);
#define BAND_DMAK(n_) do { int kb_, ks_, W_; band_desc<MODE>((n_), q0, kb_, ks_, W_); \
        _Pragma("unroll") for (int i = 0; i < 8; ++i) { const int row_ = lrow + 8 * i; int kt = kb_ + ks_ * row_; kt = kt < 0 ? 0 : (kt > SEQ - 1 ? SEQ - 1 : kt); \
            glds16s(kgb, (unsigned)(kt * INW + ((lch ^ ((row_ >> 1) & 7)) * 8)) * 2u, (unsigned)__builtin_amdgcn_readfirstlane(ldsk + i * 1024)); } } while (0)
#define BAND_LOADV(n_) do { int kb_, ks_, W_; band_desc<MODE>((n_), q0, kb_, ks_, W_); \
        _Pragma("unroll") for (int i = 0; i < 8; ++i) { int kt = kb_ + ks_ * (lrow + 8 * i); kt = kt < 0 ? 0 : (kt > SEQ - 1 ? SEQ - 1 : kt); \
            vr[i] = *(const GAS u32x4*)(vgb + (unsigned)((kt * INW + lch * 8) * 2)); } } while (0)
    bf16x8 qr[4];
    if (NQ == 1) {
#pragma unroll
        for (int d0 = 0; d0 < 4; ++d0) qr[d0] = *(const GAS bf16x8*)(qp[0] + d0 * 16); }
    LDS_WAIT();
    { const int n0 = __builtin_ctz(mask); BAND_DMAK(n0); BAND_LOADV(n0); }
    while (mask) {
        const int n = __builtin_ctz(mask); mask &= mask - 1u;
        const int nn = mask ? __builtin_ctz(mask) : -1;
        int kb, ks, W; band_desc<MODE>(n, q0, kb, ks, W);
        float ksf = (float)ks; asm volatile("" : "+v"(ksf));
        const float dlo = fmaxf(-qf, -(float)W), dhi = fminf((float)W, (float)(SEQ - 1) - qf);
        VM_WAIT();
#pragma unroll
        for (int i = 0; i < 8; ++i) *(LAS u32x4*)(vw + i * 512) = vr[i];
        if (nn >= 0) BAND_LOADV(nn);
        const float dbase = (float)kb - qf + ksf * (float)(4 * hi);
#pragma unroll
        for (int qi = 0; qi < NQ; ++qi) {
            if (NQ > 1) {
#pragma unroll
                for (int d0 = 0; d0 < 4; ++d0) qr[d0] = *(const GAS bf16x8*)(qp[qi] + d0 * 16); }
            f32x16 p0, p1;
#pragma unroll
            for (int r = 0; r < 16; ++r) { p0[r] = 0.f; p1[r] = 0.f; }
#pragma unroll
            for (int d0 = 0; d0 < 4; ++d0) { const lds_cptr ka_ = (lds_cptr)(size_t)(kbase_l ^ (unsigned)(d0 << 5));
                const bf16x8 a0 = *(const LAS bf16x8*)(ka_), a1 = *(const LAS bf16x8*)(ka_ + 4096);
                p0 = ATT_MFMA(a0, qr[d0], p0); p1 = ATT_MFMA(a1, qr[d0], p1);
            }
            if (qi == NQ - 1 && nn >= 0) { LDS_WAIT(); BAND_DMAK(nn); }
#pragma unroll
            for (int r = 0; r < 16; ++r) { const float c = (float)((r & 3) + 8 * (r >> 2));
                const float d0 = __builtin_fmaf(ksf, c, dbase), d1 = __builtin_fmaf(ksf, 32.f + c, dbase);
                p0[r] = (d0 >= dlo && d0 <= dhi) ? __builtin_fmaf(-__builtin_fabsf(d0), slope2[qi], p0[r]) : -INFINITY;
                p1[r] = (d1 >= dlo && d1 <= dhi) ? __builtin_fmaf(-__builtin_fabsf(d1), slope2[qi], p1[r]) : -INFINITY; }
            float mx = fmaxf(max16(p0), max16(p1));
            mx = xmax32(mx);
            if (__any(mx > m[qi] + 8.0f)) {
                const float mn = fmaxf(m[qi], mx), f = __builtin_amdgcn_exp2f(m[qi] - mn);
                l[qi] *= f; m[qi] = mn;
#pragma unroll
                for (int c = 0; c < 2; ++c)
#pragma unroll
                    for (int r = 0; r < 16; ++r) o[qi][c][r] *= f;
            }
#pragma unroll
            for (int r = 0; r < 16; ++r) { p0[r] = __builtin_amdgcn_exp2f(p0[r] - m[qi]); p1[r] = __builtin_amdgcn_exp2f(p1[r] - m[qi]); }
            l[qi] += sum16(p0) + sum16(p1);
            bf16x8 pw[4]; pw[0] = pack8(p0, 0); pw[1] = pack8(p0, 1); pw[2] = pack8(p1, 0); pw[3] = pack8(p1, 1);
#pragma unroll
            for (int c = 0; c < 2; ++c)
#pragma unroll
                for (int s = 0; s < 4; ++s) {
                    const bf16x8 vf = vcat(vtr2(vp + c * BV_S + s * 1024), vtr2(vp + c * BV_S + s * 1024 + 512));
                    o[qi][c] = ATT_MFMA(vf, pw[s], o[qi][c]);
                }
        }
    }
#undef BAND_DMAK
#undef BAND_LOADV
}
__device__ __forceinline__ void band_store(bf16_t* op  , int hi, const f32x16 (&o)[2], float inv) {
#pragma unroll
    for (int c = 0; c < 2; ++c)
#pragma unroll
        for (int g = 0; g < 4; g += 2) { u32x2 w0, w1;
            w0.x = cvt_pk_bf16(o[c][4 * g + 0] * inv, o[c][4 * g + 1] * inv); w0.y = cvt_pk_bf16(o[c][4 * g + 2] * inv, o[c][4 * g + 3] * inv);
            w1.x = cvt_pk_bf16(o[c][4 * g + 4] * inv, o[c][4 * g + 5] * inv); w1.y = cvt_pk_bf16(o[c][4 * g + 6] * inv, o[c][4 * g + 7] * inv);
            *(GAS u32x4*)(op + 32 * c + 8 * (g + hi)) = pair16(w0, w1); }
}
}

template <int DAB, int DC>
__device__ __forceinline__ void p3_attention(Frame& F, int L) {
    const int lane = F.lane, r32 = lane & 31, hi = lane >> 5, wid = F.wave;
    LAS unsigned char* wl = F.lds + wid * BAND_WL;
    for (int rep = 0; rep < DAB; ++rep) {
    for (int bt = F.vcu; bt < NBATCH * 4 * 16; bt += F.G) {
        const int b = bt >> 6, h = (bt >> 4) & 3, blk = bt & 15;
        const float sl1[1] = {__builtin_amdgcn_exp2f(-2.0f * (float)(h + 1)) * LOG2E};
        const size_t rowbase = (size_t)b * SEQ;
        for (int rr = 0; rr < 2; ++rr) {
            const int lane = lane_id(), r32 = lane & 31, hi = lane >> 5;
            const int q0 = blk * 512 + rr * 8 + wid, qtok = q0 + 16 * r32;
            const bf16_t* const qp[1] = {F.PROJ + (rowbase + qtok) * INW + C_QA + h * 64 + hi * 8};
            float m[1] = {-1e30f}, l[1] = {0.f}; f32x16 o[1][2];
#pragma unroll
            for (int c = 0; c < 2; ++c)
#pragma unroll
                for (int r = 0; r < 16; ++r) o[0][c][r] = 0.f;
            att::band_task<1, 1>(F.PROJ, rowbase, C_KA + h * 64, C_VA + h * 64, q0, sl1, qtok, qp, m, l, o, wl, lane);
            float* pp = F.part + ((rowbase + qtok) * 4 + h) * 68;
#pragma unroll
            for (int c = 0; c < 2; ++c)
#pragma unroll
                for (int g = 0; g < 4; ++g) *(GAS f32x4*)(pp + 32 * c + 8 * g + 4 * hi) = (f32x4){o[0][c][4 * g], o[0][c][4 * g + 1], o[0][c][4 * g + 2], o[0][c][4 * g + 3]};
            if (hi == 0) pp[64] = m[0];
            pp[65 + hi] = l[0];
        }
        VM_WAIT(); __syncthreads(); __builtin_amdgcn_fence(__ATOMIC_ACQUIRE, "agent"); VM_WAIT();
        for (int rr = 0; rr < 2; ++rr) {
            const int lane = lane_id(), r32 = lane & 31, hi = lane >> 5;
            const int q0 = blk * 512 + (rr * 8 + wid) * 32, qtok = q0 + r32;
            const bf16_t* const qp[1] = {F.PROJ + (rowbase + qtok) * INW + C_QA + h * 64 + hi * 8};
            const float* pp = F.part + ((rowbase + qtok) * 4 + h) * 68;
            f32x16 o[1][2];
#pragma unroll
            for (int c = 0; c < 2; ++c)
#pragma unroll
                for (int g = 0; g < 4; ++g) { const f32x4 t = *(const GAS f32x4*)(pp + 32 * c + 8 * g + 4 * hi); o[0][c][4 * g] = t[0]; o[0][c][4 * g + 1] = t[1]; o[0][c][4 * g + 2] = t[2]; o[0][c][4 * g + 3] = t[3]; }
            float m[1] = {pp[64]}, l[1] = {pp[65 + hi]};
            att::band_task<2, 1>(F.PROJ, rowbase, C_KA + h * 64, C_VA + h * 64, q0, sl1, qtok, qp, m, l, o, wl, lane);
            att::band_store(F.MIXED + (rowbase + qtok) * DM + h * 64, hi, o[0], 1.0f / att::xsum32(l[0]));
        }
        __syncthreads();
    }
    for (int bt = F.vcu; bt < NBATCH * 2 * 32; bt += F.G) {
        const int b = bt >> 6, hk = (bt >> 5) & 1, blk = bt & 31;
        const size_t rowbase = (size_t)b * SEQ;
        const int lane = lane_id(), r32 = lane & 31, hi = lane >> 5;
        const int q0 = blk * 256 + wid * 32, qtok = q0 + r32;
        float sl2[2], m[2], l[2]; f32x16 o[2][2];
        const bf16_t* const qp[2] = {F.PROJ + (rowbase + qtok) * INW + C_QB + (2 * hk) * 64 + hi * 8, F.PROJ + (rowbase + qtok) * INW + C_QB + (2 * hk + 1) * 64 + hi * 8};
#pragma unroll
        for (int g = 0; g < 2; ++g) { const int hq = 2 * hk + g;
            sl2[g] = __builtin_amdgcn_exp2f(-2.0f * (float)(hq + 1)) * LOG2E;
            m[g] = F.sinks[L * 4 + hq] * LOG2E; l[g] = 0.5f;
#pragma unroll
            for (int c = 0; c < 2; ++c)
#pragma unroll
                for (int r = 0; r < 16; ++r) o[g][c][r] = 0.f; }
        att::band_task<0, 2>(F.PROJ, rowbase, C_KB + hk * 64, C_VB + hk * 64, q0, sl2, qtok, qp, m, l, o, wl, lane);
#pragma unroll
        for (int g = 0; g < 2; ++g) att::band_store(F.MIXED + (rowbase + qtok) * DM + 256 + (2 * hk + g) * 64, hi, o[g], 1.0f / att::xsum32(l[g]));
    }
    }
    VM_WAIT(); LDS_WAIT();
    __syncthreads();
    {
        float lam_init = 0.8f - 0.6f * __expf(-0.3f * (float)L);
        const float s1 = wave_sum(F.lq1[L * 64 + lane] * F.lk1[L * 64 + lane]), s2 = wave_sum(F.lq2[L * 64 + lane] * F.lk2[L * 64 + lane]);
        const float lam = __expf(s1) - __expf(s2) + lam_init;
        for (int rep = 0; rep < DC; ++rep)
        for (int uid = F.vcu; uid < 2048; uid += F.G) {
            const int i = uid >> 8, v = uid & 255, bh = 4 * (v >> 5) + (i >> 1), qb = (i & 1) * 32 + (v & 31), b = bh >> 2, h = bh & 3;
            const float slope2 = __builtin_amdgcn_exp2f(-2.0f * (float)(h + 1)) * LOG2E;
            int T0 = 0, NT = SEQ / 64;
            if (C_TILE_SKIP) {
                const unsigned* nq = (const unsigned*)(F.ctl + CW_NRM + L * 256) + (b * 2 + 0) * 16 + h * 4; const unsigned* nk = nq + 16;
                float R2 = 0.f;
#pragma unroll
                for (int c = 0; c < 2; ++c) R2 = fmaxf(R2, sqrtf(__uint_as_float(nq[c * 2]) * __uint_as_float(nk[c * 2])) + sqrtf(__uint_as_float(nq[c * 2 + 1]) * __uint_as_float(nk[c * 2 + 1])));
                const float Dstar = (C_TILE_SKIP == 1) ? (150.0f + 8.0f + 0.4f * R2) / slope2
                                                       : (120.0f * LOG2E + 2.0f * 1.02f * R2) / slope2;
                if (Dstar < 16384.f) {
                    const int D = (int)Dstar + 1, qlo = qb * 128, qhi = qb * 128 + 127;
                    int tlo = (qlo - D - 63 + 63) / 64; if (qlo - D - 63 <= 0) tlo = 0;
                    int thi = (qhi + D) / 64; if (thi > SEQ / 64 - 1) thi = SEQ / 64 - 1;
                    if (((thi - tlo + 1) & 1) != 0) { if (tlo > 0) --tlo; else ++thi; }
                    if (thi > SEQ / 64 - 1) { thi = SEQ / 64 - 1; if (((thi - tlo + 1) & 1) != 0) --tlo; }
                    if (thi - tlo + 1 >= 4 && tlo >= 0) { T0 = tlo; NT = thi - tlo + 1; }
                }
            }
            volatile LAS unsigned* badw = (volatile LAS unsigned*)(F.misc + MO_HIST);
            const bool bad = att::attnC_unit(F.PROJ, F.MIXED, F.subln + L * 128, b, h, qb, slope2, lam, 1.0f - lam_init, F.lds, wid, lane, T0, NT, badw);
            if (bad) (void)att::attnC_unit(F.PROJ, F.MIXED, F.subln + L * 128, b, h, qb, slope2, lam, 1.0f - lam_init, F.lds, wid, lane, 0, SEQ / 64, badw);
        }
    }
}

struct Args { const float* in[23]; float* out; unsigned char* ws; };
typedef const __attribute__((address_space(4))) Args* kargs_t;
__device__ __forceinline__ void refresh(Frame& F) {
    kargs_t ap = (kargs_t)__builtin_amdgcn_kernarg_segment_ptr(); asm volatile("" : "+s"(ap));
    int w = F.wave0; asm volatile("" : "+s"(w)); int l = lane_id(); asm volatile("" : "+v"(l));
    F.tid = w * 64 + l; F.lane = l; F.wave = w;
    unsigned char* ws = ap->ws;
    F.ctl = (gu32*)(ws + WS_CTL);
    F.x_in = ap->in[0]; F.c_in = ap->in[1]; F.w_ada = ap->in[2]; F.b_ada = ap->in[3]; F.norm1 = ap->in[4]; F.w_in = ap->in[5]; F.sinks = ap->in[6];
    F.lq1 = ap->in[7]; F.lk1 = ap->in[8]; F.lq2 = ap->in[9]; F.lk2 = ap->in[10]; F.subln = ap->in[11]; F.w_out = ap->in[12]; F.norm2 = ap->in[13];
    F.w_router = ap->in[14]; F.b_router = ap->in[15]; F.w_gate = ap->in[16]; F.b_gate = ap->in[17]; F.w_up = ap->in[18]; F.b_up = ap->in[19];
    F.w_down = ap->in[20]; F.b_down = ap->in[21]; F.norm_f = ap->in[22]; F.out = ap->out;
    F.modp = (float*)(ws + WS_MODP); F.mod = (float*)(ws + WS_MOD); F.ltok = (int*)(ws + WS_LTOK); F.lg = (float*)(ws + WS_LG);
    F.WIN = (bf16_t*)(ws + WS_WIN); F.WOUT = (bf16_t*)(ws + WS_WOUT); F.WGU = (bf16_t*)(ws + WS_WGU); F.WDN = (bf16_t*)(ws + WS_WDN);
    F.H = (bf16_t*)(ws + WS_H); F.PROJ = (bf16_t*)(ws + WS_R1); F.MIXED = (bf16_t*)(ws + WS_MIXED); F.HIDDEN = (bf16_t*)(ws + WS_R1); F.Y = (bf16_t*)(ws + WS_Y); F.XB = (bf16_t*)(ws + WS_XB); F.part = (float*)(ws + WS_PART); F.inv = (int*)(ws + WS_INV);
}
__global__ void __launch_bounds__(NTHREADS, 2) fwd_kernel(Args args) {
    extern __shared__ __attribute__((aligned(16))) unsigned char lds[];
    Frame F;
    F.lds = (LAS unsigned char*)lds; F.misc = F.lds + MISC_OFF;
    F.wave0 = __builtin_amdgcn_readfirstlane((int)threadIdx.x >> 6);
    F.G = gridDim.x; { const int bx = blockIdx.x; F.vcu = (F.G % 8 == 0) ? (bx % 8) * (F.G / 8) + bx / 8 : bx; }
    refresh(F);
    for (int u = F.tid; u < 256; u += NTHREADS) ((LAS unsigned*)F.misc)[u] = 0u;
    __syncthreads();
    XcdBarrier bar = xcd_barrier_post((unsigned*)(F.ctl + CW_BAR), (volatile LAS unsigned*)(F.misc + MO_BAR));
    (void)bar;
#define GRID_BAR() do { kargs_t ap_ = (kargs_t)__builtin_amdgcn_kernarg_segment_ptr(); asm volatile("" : "+s"(ap_)); XcdBarrier b_; \
        b_.bar = (unsigned*)(ap_->ws + WS_CTL) + CW_BAR; b_.x = xb_xcc_id(); b_.st = (volatile LAS unsigned*)(F.misc + MO_BAR); xcd_barrier(b_); } while (0)

#ifndef PH_MASK
#define PH_MASK 0xffff
#endif
#define PH(k) ((PH_MASK >> (k)) & 1)
#ifndef DUP_MASK
#define DUP_MASK 0
#endif
#define DUP(k) (1 + ((DUP_MASK >> (k)) & 1))
    if (PH(0)) { for (int rep = 0; rep < DUP(0); ++rep) { p0_prologue(F); __syncthreads(); } GRID_BAR();
    refresh(F); p0b_modsum(F); GRID_BAR(); }
    for (int L = 0; L < DEPTH; ++L) {
        refresh(F);
        if (PH(1)) { if (L == 0) p1_rows<0>(F, L); else p1_rows<1>(F, L); if (DUP(6) > 1) { __syncthreads(); if (L == 0) p1_rows<0>(F, L); else p1_rows<1>(F, L, 0.0f); } }
        const bool own_panels = false;
        if (own_panels) { VM_WAIT(); __syncthreads(); __builtin_amdgcn_fence(__ATOMIC_ACQUIRE, "agent"); VM_WAIT(); } else { GRID_BAR(); }
        refresh(F);
        if (PH(2)) for (int rep = 0; rep < DUP(1); ++rep) { pg8::Gemm g{F.H, F.WIN + (size_t)L * INW * DM, DM}; EpiProj E{F.PROJ, (unsigned*)(F.ctl + CW_NRM + L * 256)};
          if (own_panels) { pg8::PanelOrder S{INW / 256, NTOK / 256, F.G, F.vcu}; pg8::gemm_phase<EpiProj, pg8::PanelOrder, false>(F.lds, g, S, E, F.wave); }
          else { pg8::StaticOrder S; S.init(NTOK, INW, F.G, (int)blockIdx.x); pg8::gemm_phase<EpiProj, pg8::StaticOrder, false>(F.lds, g, S, E, F.wave); } }
        GRID_BAR();
        refresh(F);
        if (PH(3)) p3_attention<DUP(2), DUP(3)>(F, L);
        GRID_BAR();
        refresh(F);
        const bool own_panels4 = (F.G == NTOK / 256);
        if (PH(4)) for (int rep = 0; rep < DUP(7); ++rep) { pg8::Gemm g{F.MIXED, F.WOUT + (size_t)L * DM * DM, DM}; EpiOut E{F.XB, F.mod + (size_t)L * NBATCH * 6144 + 2 * DM, rep ? 0.0f : 1.0f};
          if (own_panels4) { pg8::PanelOrder S{DM / 256, NTOK / 256, F.G, F.vcu}; pg8::gemm_phase<EpiOut, pg8::PanelOrder, false>(F.lds, g, S, E, F.wave); }
          else { pg8::StaticOrder S; S.init(NTOK, DM, F.G, (int)blockIdx.x); pg8::gemm_phase<EpiOut, pg8::StaticOrder, false>(F.lds, g, S, E, F.wave); } }
        if (own_panels4) { VM_WAIT(); __syncthreads(); __builtin_amdgcn_fence(__ATOMIC_ACQUIRE, "agent"); VM_WAIT(); } else { GRID_BAR(); }
        refresh(F);
        if (PH(5)) { p5_route(F, L, L); if (DUP(8) > 1) { __syncthreads(); p5_route(F, L, L + 4); } }
        GRID_BAR();
        refresh(F);
        moe_table(F, L);
        if (PH(7)) for (int rep = 0; rep < DUP(4); ++rep) { const LAS int* tab = (const LAS int*)(F.misc + MO_TAB);
          pg8::Gemm g{F.H, (const bf16_t*)((const unsigned char*)F.WGU + (size_t)L * NE * 2048 * DM), DM / 2}; MoeSched S{tab, 3, tab[96], F.G, F.vcu, F.ltok};
          EpiGU E{(unsigned char*)F.HIDDEN, F.b_gate + (size_t)L * NE * DM, F.b_up + (size_t)L * NE * DM};
          pg8::gemm_phase<EpiGU, MoeSched, true, true>(F.lds, g, S, E, F.wave); }
        GRID_BAR();
        refresh(F);
        if (PH(8)) for (int rep = 0; rep < DUP(5); ++rep) { const LAS int* tab = (const LAS int*)(F.misc + MO_TAB);
          pg8::Gemm g{F.HIDDEN, (const bf16_t*)((const unsigned char*)F.WDN + (size_t)L * NE * DM * DM), DM / 2}; MoeSched S{tab, 2, tab[96], F.G, F.vcu, F.ltok};
          EpiDown E{(unsigned char*)F.Y, F.b_down + (size_t)L * NE * DM, tab, F.lg, F.misc + EPI_STG};
          pg8::gemm_phase<EpiDown, MoeSched, false, true>(F.lds, g, S, E, F.wave); }
        GRID_BAR();
    }
    refresh(F);
    if (PH(9)) p1_rows<2>(F, DEPTH);
}

extern "C" void kernel_launch(void* const* d_in, const int* in_sizes, int n_in, void* d_out, int out_size, void* d_ws, size_t ws_size, hipStream_t stream) {
    static int grid = 0;
    if (grid == 0) {
        if (n_in != 23 || in_sizes[0] != NTOK * DM || out_size != NTOK * DM || ws_size < WS_END) {
            fprintf(stderr, "kernel_launch: unexpected shapes/workspace: n_in %d in0 %d out %d ws %zu (need %zu); nothing launched\n", n_in, n_in > 0 ? in_sizes[0] : -1, out_size, ws_size, (size_t)WS_END); grid = -1; return; }
        int dev = 0, cus = 0, per_cu = 0;
        if (hipGetDevice(&dev) != hipSuccess || hipDeviceGetAttribute(&cus, hipDeviceAttributeMultiprocessorCount, dev) != hipSuccess) { grid = -1; return; }
        if (hipFuncSetAttribute((const void*)fwd_kernel, hipFuncAttributeMaxDynamicSharedMemorySize, LDS_BYTES) != hipSuccess) { fprintf(stderr, "kernel_launch: hipFuncSetAttribute failed\n"); grid = -1; return; }
        if (hipOccupancyMaxActiveBlocksPerMultiprocessor(&per_cu, (const void*)fwd_kernel, NTHREADS, LDS_BYTES) != hipSuccess || per_cu < 1)
            fprintf(stderr, "kernel_launch: note: occupancy query reports %d workgroups per CU\n", per_cu);
        (void)hipGetLastError();
        grid = cus;
    }
    if (grid < 0) return;
    if (hipMemsetAsync((char*)d_ws + WS_CTL, 0, CTL_ZERO_BYTES, stream) != hipSuccess) return;
    Args a{};
    for (int i = 0; i < 23; ++i) a.in[i] = (const float*)d_in[i];
    a.out = (float*)d_out; a.ws = (unsigned char*)d_ws;
    hipLaunchKernelGGL(fwd_kernel, dim3(grid), dim3(NTHREADS), LDS_BYTES, stream, a);
}
```

```cpp
#include <hip/hip_runtime.h>
#include <cstdio>
#include <cstdint>

#define LAS __attribute__((address_space(3)))
#define GAS __attribute__((address_space(1)))
typedef unsigned short bf16_t;
typedef short bf16x8 __attribute__((ext_vector_type(8)));
typedef short s16x4 __attribute__((ext_vector_type(4)));
typedef float f32x4 __attribute__((ext_vector_type(4)));
typedef float f32x2 __attribute__((ext_vector_type(2)));
typedef float f32x16 __attribute__((ext_vector_type(16)));
typedef unsigned u32x4 __attribute__((ext_vector_type(4)));
typedef unsigned u32x2 __attribute__((ext_vector_type(2)));
typedef GAS unsigned gu32;

constexpr int NBATCH = 8, SEQ = 8192, DM = 1024, NTOK = NBATCH * SEQ, DEPTH = 4;
constexpr int INW = 2816;
constexpr int C_QA = 0, C_KA = 256, C_VA = 512, C_QB = 768, C_KB = 1024, C_VB = 1152, C_QC = 1280, C_KC = 1792, C_VC = 2304;
constexpr int NE = 32, TOPK = 4, LCAP = NTOK;
constexpr float RMS_EPS = 1e-6f;
constexpr float LOG2E = 1.4426950408889634f;
constexpr float QSCALE = 0.125f * LOG2E;
constexpr int NWAVES = 8, NTHREADS = 512;
#ifndef C_TILE_SKIP
#define C_TILE_SKIP 1
#endif
constexpr int CW_NRM = 16384;

constexpr size_t MiB = 1u << 20;
constexpr size_t WS_CTL = 0, CTL_ZERO_BYTES = 1 * MiB;
constexpr size_t WS_MODP = 1 * MiB;
constexpr size_t WS_MOD = 4 * MiB;
constexpr size_t WS_LTOK = 5 * MiB;
constexpr size_t WS_LG = 13 * MiB;
constexpr size_t WS_WIN = 21 * MiB;
constexpr size_t WS_WOUT = 43 * MiB;
constexpr size_t WS_WGU = 51 * MiB;
constexpr size_t WS_WDN = 563 * MiB;
constexpr size_t WS_H = 819 * MiB;
constexpr size_t WS_R1 = 947 * MiB;
constexpr size_t WS_MIXED = WS_R1 + 352 * MiB;
constexpr size_t WS_Y = 1475 * MiB;
constexpr size_t WS_INV = WS_MODP;
constexpr size_t WS_XB = WS_Y + 264 * MiB;
constexpr size_t WS_PART = WS_XB + 128 * MiB;
constexpr size_t WS_END = 1987 * MiB;
static_assert(WS_PART + (size_t)NTOK * 4 * 68 * 4 <= WS_END, "d_ws map");
constexpr int CW_TMO = 0, CW_CODE = 1, CW_BAR = 4096, CW_CNT = 8192;

constexpr int RING_BYTES = 131072;
constexpr int BAND_WL = 16896;
constexpr int MISC_OFF = 8 * BAND_WL;
constexpr int EPI_STG = 1024, EPI_STG_ROW = 144, EPI_STG_GRP = 64 * EPI_STG_ROW;
constexpr int LDS_BYTES = MISC_OFF + EPI_STG + 2 * EPI_STG_GRP;
constexpr int MO_BAR = 0, MO_HIST = 64, MO_BASE = 192, MO_TAB = 320, MO_SELE = 1024, MO_SELG = 5120;

#define RLX_AGENT __ATOMIC_RELAXED, __HIP_MEMORY_SCOPE_AGENT
#define LDS_WAIT() asm volatile("s_waitcnt lgkmcnt(0)" ::: "memory")
#define VM_WAIT() asm volatile("s_waitcnt vmcnt(0)" ::: "memory")
__device__ __forceinline__ unsigned cvt_pk_bf16(float lo, float hi) { unsigned r; asm volatile("v_cvt_pk_bf16_f32 %0, %1, %2" : "=v"(r) : "v"(lo), "v"(hi)); return r; }
__device__ __forceinline__ unsigned f2bf(float f) { unsigned u = __builtin_bit_cast(unsigned, f); return (u + 0x7fffu + ((u >> 16) & 1u)) >> 16; }
__device__ __forceinline__ unsigned pk2(float lo, float hi) { return f2bf(lo) | (f2bf(hi) << 16); }
typedef int i32x8 __attribute__((ext_vector_type(8)));
typedef int i32x4 __attribute__((ext_vector_type(4)));
__device__ __forceinline__ unsigned pk4_fp8_nc(float a, float b, float c, float d) {
    unsigned w = 0u; w = (unsigned)__builtin_amdgcn_cvt_pk_fp8_f32(a, b, (int)w, false); w = (unsigned)__builtin_amdgcn_cvt_pk_fp8_f32(c, d, (int)w, true); return w;
}
__device__ __forceinline__ unsigned pk4_fp8(float a, float b, float c, float d) {
    a = fminf(fmaxf(a, -448.f), 448.f); b = fminf(fmaxf(b, -448.f), 448.f); c = fminf(fmaxf(c, -448.f), 448.f); d = fminf(fmaxf(d, -448.f), 448.f);
    unsigned w = 0u; w = (unsigned)__builtin_amdgcn_cvt_pk_fp8_f32(a, b, (int)w, false); w = (unsigned)__builtin_amdgcn_cvt_pk_fp8_f32(c, d, (int)w, true); return w;
}
constexpr float W8_SCALE = 64.f, H8_SCALE = 8.f, HID8_SCALE = 4.f, Y8_SCALE = 64.f;
__device__ __forceinline__ float bf_lo(unsigned u) { return __builtin_bit_cast(float, u << 16); }
__device__ __forceinline__ float bf_hi(unsigned u) { return __builtin_bit_cast(float, u & 0xffff0000u); }
__device__ __forceinline__ int lane_id() { unsigned ones = ~0u; asm volatile("" : "+s"(ones)); return (int)__builtin_amdgcn_mbcnt_hi(ones, __builtin_amdgcn_mbcnt_lo(ones, 0u)); }
template <int CTRL> __device__ __forceinline__ float dpp_mov(float v) { return __builtin_bit_cast(float, __builtin_amdgcn_update_dpp(0, __builtin_bit_cast(int, v), CTRL, 0xf, 0xf, true)); }
__device__ __forceinline__ float row16_sum(float v) { v += dpp_mov<0xB1>(v); v += dpp_mov<0x4E>(v); v += dpp_mov<0x141>(v); v += dpp_mov<0x140>(v); return v; }
__device__ __forceinline__ float row16_max(float v) { v = fmaxf(v, dpp_mov<0xB1>(v)); v = fmaxf(v, dpp_mov<0x4E>(v)); v = fmaxf(v, dpp_mov<0x141>(v)); v = fmaxf(v, dpp_mov<0x140>(v)); return v; }
__device__ __forceinline__ float x16_sum(float v) { const auto r = __builtin_amdgcn_permlane16_swap(__float_as_uint(v), __float_as_uint(v), false, false); return __uint_as_float(r[0]) + __uint_as_float(r[1]); }
__device__ __forceinline__ float x32_sum(float v) { const auto r = __builtin_amdgcn_permlane32_swap(__float_as_uint(v), __float_as_uint(v), false, false); return __uint_as_float(r[0]) + __uint_as_float(r[1]); }
__device__ __forceinline__ float wave_sum(float v) { return x32_sum(x16_sum(row16_sum(v))); }

#define XB_TMO      128
#define XB_XCNT(j)  (256  + 64 * (j))
#define XB_XSUB(j)  (1280 + 64 * (j))
#define XB_XGEN(j)  (2304 + 64 * (j))
#define XB_TOP      3328
#define XB_TOPGEN   3392
#define XCD_BAR_WORDS 3456
#define XB_SPIN_CAP (1u << 20)

__device__ __forceinline__ unsigned xb_ld(unsigned* p)              { return __hip_atomic_load(p, __ATOMIC_RELAXED, __HIP_MEMORY_SCOPE_AGENT); }
__device__ __forceinline__ unsigned xb_add(unsigned* p, unsigned v) { return __hip_atomic_fetch_add(p, v, __ATOMIC_RELAXED, __HIP_MEMORY_SCOPE_AGENT); }
__device__ __forceinline__ unsigned xb_xcc_id() { return (unsigned)__builtin_amdgcn_s_getreg((3 << 11) | 20) & 0xFu; }
#define XB_SPIN(cond, bar) do { unsigned _sp = 0; while (cond) { __builtin_amdgcn_s_sleep(1); \
    if ((++_sp & 255u) == 0u) { if (xb_ld(&(bar)[XB_TMO])) break; if (_sp > XB_SPIN_CAP) { atomicAdd(&(bar)[XB_TMO], 1u); break; } } } } while (0)

struct XcdBarrier { unsigned* bar; unsigned x; volatile LAS unsigned* st; };
__device__ __forceinline__ XcdBarrier xcd_barrier_post(unsigned* bar, volatile LAS unsigned* st) {
    XcdBarrier b; b.bar = bar; b.x = xb_xcc_id(); b.st = st;
    if (threadIdx.x == 0) (void)xb_add(&bar[XB_XCNT(b.x)], 1u);
    return b;
}
__device__ __forceinline__ void xcd_barrier_complete(unsigned* bar, unsigned x, unsigned& nloc, unsigned& nx) {
    const unsigned G = gridDim.x * gridDim.y * gridDim.z;
    unsigned sum, cnt, mine, sp = 0u;
    for (;;) {
        sum = 0u; cnt = 0u; mine = 0u;
#pragma unroll
        for (unsigned j = 0; j < 16; ++j) { const unsigned c = xb_ld(&bar[XB_XCNT(j)]); sum += c; cnt += (c > 0u) ? 1u : 0u; mine = (j == x) ? c : mine; }
        if (sum == G) break;
        __builtin_amdgcn_s_sleep(1);
        if ((++sp & 255u) == 0u) { if (xb_ld(&bar[XB_TMO])) break; if (sp > XB_SPIN_CAP) { atomicAdd(&bar[XB_TMO], 1u); break; } }
    }
    nloc = mine > 0u ? mine : 1u; nx = cnt > 0u ? cnt : 1u;
}
__device__ __forceinline__ void xcd_barrier(const XcdBarrier& b) {
    asm volatile("s_waitcnt vmcnt(0)" ::: "memory");
    __syncthreads();
    if (threadIdx.x == 0) {
        unsigned* bar = b.bar;
        __builtin_amdgcn_s_waitcnt(0);
        unsigned nloc = b.st[0], nx = b.st[1];
        if (nloc == 0u) { xcd_barrier_complete(bar, b.x, nloc, nx); b.st[0] = nloc; b.st[1] = nx; }
        const unsigned old = xb_add(&bar[XB_XSUB(b.x)], 1u);
        const unsigned gen = old / nloc;
        if (old + 1u == (gen + 1u) * nloc) {
            __builtin_amdgcn_fence(__ATOMIC_RELEASE, "agent");
            asm volatile("s_waitcnt vmcnt(0)" ::: "memory");
            const unsigned og = xb_add(&bar[XB_TOP], 1u);
            const unsigned tg = og / nx;
            if (og + 1u == (tg + 1u) * nx) xb_add(&bar[XB_TOPGEN], 1u);
            else XB_SPIN(xb_ld(&bar[XB_TOPGEN]) == tg, bar);
            __builtin_amdgcn_fence(__ATOMIC_ACQUIRE, "agent");
            xb_add(&bar[XB_XGEN(b.x)], 1u);
            asm volatile("s_waitcnt vmcnt(0)" ::: "memory");
        } else {
            XB_SPIN(xb_ld(&bar[XB_XGEN(b.x)]) == gen, bar);
            __builtin_amdgcn_fence(__ATOMIC_ACQUIRE, "agent");
            asm volatile("s_waitcnt vmcnt(0)" ::: "memory");
        }
    }
    __syncthreads();
}

__device__ __forceinline__ unsigned ld_untracked(const void* p) { unsigned v; asm volatile("global_load_dword %0, %1, off" : "=v"(v) : "v"(p) : "memory"); return v; }
namespace pg8 {
constexpr int BM = 256, BK = 64, HALF = 128, HTB = HALF * BK * 2, STAGE_BYTES = 8 * HTB, NXCD = 8, WGM = 8;
__host__ __device__ __forceinline__ int lds_byte(int r, int c) { const int st = (r >> 4) * 2 + (c >> 5), rr = r & 15, cc = c & 31, ob = rr * 64 + cc * 2; return st * 1024 + (ob ^ (((ob >> 9) & 1) << 5)); }
__host__ __device__ __forceinline__ void stage_rc(int b, int& R, int& C) { const int st = b / 1024, sb = b % 1024, swz = sb ^ (((sb >> 9) & 1) << 5); R = (st >> 1) * 16 + swz / 64; C = (st & 1) * 32 + (swz % 64) / 2; }
__host__ __device__ __forceinline__ int perm32(int rho) { const int n = rho >> 4, i = rho & 15; return 8 * (i >> 2) + 4 * n + (i & 3); }

struct Unit { int pm, pn; };
struct Gemm { const bf16_t* A; const bf16_t* Bt; int K; };

struct StaticOrder {
    int nM, nN, nwg, G, c;
    __device__ void init(int M, int N, int G_, int c_) { nM = M / BM; nN = N / BM; nwg = nM * nN; G = G_; c = c_; }
    __device__ bool next(int i, Unit& u) const {
        const long L = (long)i * G + c; if (L >= nwg) return false;
        int wgid = (int)L; { const int q = nwg / NXCD, r = nwg % NXCD, xcd = wgid % NXCD, off = wgid / NXCD; wgid = (xcd < r ? xcd * (q + 1) : r * (q + 1) + (xcd - r) * q) + off; }
        const int nig = WGM * nN, gid = wgid / nig, fm = gid * WGM, gsz = (nM - fm) < WGM ? (nM - fm) : WGM;
        u.pm = fm + ((wgid % nig) % gsz); u.pn = (wgid % nig) / gsz; return true;
    }
    __device__ __forceinline__ unsigned arow(const Unit&, int) const { return 0u; }
    __device__ __forceinline__ unsigned arow_raw(const Unit&, int) const { return 0u; }
};

struct PanelOrder {
    int nN, nP, G, vcu;
    __device__ bool next(int i, Unit& u) const { const int p = vcu + (i / nN) * G; if (p >= nP) return false; u.pm = p; u.pn = i % nN; return true; }
    __device__ __forceinline__ unsigned arow(const Unit&, int) const { return 0u; }
    __device__ __forceinline__ unsigned arow_raw(const Unit&, int) const { return 0u; }
};
template <int N> __device__ __forceinline__ void wait_v() { asm volatile("s_waitcnt vmcnt(%0)" :: "n"(N) : "memory"); }
template <class Epi, class Sched, bool GATHER, bool FP8 = false>
__device__ __forceinline__ void gemm_phase(LAS unsigned char* lds, const Gemm g, const Sched& S, const Epi& E, int wave_in) {
    int tid_ = wave_in * 64 + lane_id(); asm volatile("" : "+v"(tid_));
    const int tid = tid_, wid = __builtin_amdgcn_readfirstlane(tid >> 6), lane = tid & 63, wr = wid >> 2, wc = wid & 3, fr = lane & 15, fq = lane >> 4;
    int K_ = g.K; asm volatile("" : "+s"(K_));
    const int K = K_, nt = K / BK;
    unsigned voffA[2], voffB[2]; int Rr[2], Cb[2];
#pragma unroll
    for (int i = 0; i < 2; ++i) { int R, C; stage_rc(tid * 16 + i * 8192, R, C); const int Rb = Epi::PERM ? ((R & ~31) + perm32(R & 31)) : R;
        Rr[i] = R; Cb[i] = C * 2; voffA[i] = (unsigned)(R * K + C) * 2u; voffB[i] = (unsigned)(Rb * K + C) * 2u; }
    const size_t kstep = (size_t)(BK * 2);
    const size_t hstep = (size_t)HALF * K * 2;
    const size_t tstep = 2 * hstep;
    const unsigned ldsw = (unsigned)wid * 1024u;
    const int aoff = lds_byte(wr * 64 + fr, fq * 8), boff = lds_byte(wc * 32 + fr, fq * 8);
#define PG8_SA(b, h) (((b) * 2 + (h)) * HTB)
#define PG8_SB(b, h) ((4 + (b) * 2 + (h)) * HTB)
#define PG8_STAGE(bufoff, gbase, voff) do { _Pragma("unroll") for (int _i = 0; _i < 2; ++_i) \
        __builtin_amdgcn_global_load_lds((const unsigned*)((const char*)(gbase) + (voff)[_i]), (LAS unsigned*)(lds + (bufoff) + ldsw + _i * 8192), 16, 0, 0); } while (0)
#define PG8_STGA(b, h, base, vs) do { if constexpr (GATHER) { PG8_STAGE(PG8_SA(b, h), (base), vs[h]); } else { PG8_STAGE(PG8_SA(b, h), (base) + (h) * hstep, voffA); } } while (0)
#define PG8_LDA(dst, b, h) do { _Pragma("unroll") for (int m = 0; m < 4; ++m) _Pragma("unroll") for (int k = 0; k < 2; ++k) dst[m][k] = *(const LAS bf16x8*)(lds + PG8_SA(b, h) + aoff + m * 2048 + k * 1024); } while (0)
#define PG8_LDB(dst, b, h) do { _Pragma("unroll") for (int n = 0; n < 2; ++n) _Pragma("unroll") for (int k = 0; k < 2; ++k) dst[n][k] = *(const LAS bf16x8*)(lds + PG8_SB(b, h) + boff + n * 2048 + k * 1024); } while (0)
#define PG8_CAT(x, y) __builtin_shufflevector(__builtin_bit_cast(i32x4, (x)), __builtin_bit_cast(i32x4, (y)), 0, 1, 2, 3, 4, 5, 6, 7)
#define PG8_MMA(ai, bj, At, Bt) do { __builtin_amdgcn_s_setprio(1); \
        if constexpr (FP8) { _Pragma("unroll") for (int m = 0; m < 4; ++m) _Pragma("unroll") for (int n = 0; n < 2; ++n) \
            { const i32x8 a8_ = PG8_CAT(Bt[n][0], Bt[n][1]), b8_ = PG8_CAT(At[m][0], At[m][1]); \
              asm volatile("v_mfma_scale_f32_16x16x128_f8f6f4 %0, %1, %2, %0, %3, %3 op_sel_hi:[0,0,0]" : "+v"(acc[ai][bj][m][n]) : "v"(a8_), "v"(b8_), "v"(one8)); } } \
        else { _Pragma("unroll") for (int m = 0; m < 4; ++m) _Pragma("unroll") for (int n = 0; n < 2; ++n) _Pragma("unroll") for (int k = 0; k < 2; ++k) \
            acc[ai][bj][m][n] = __builtin_amdgcn_mfma_f32_16x16x32_bf16(Bt[n][k], At[m][k], acc[ai][bj][m][n], 0, 0, 0); } \
        __builtin_amdgcn_s_setprio(0); } while (0)
#define PG8_PIECE(bufoff, gbase, voff, i) __builtin_amdgcn_global_load_lds((const unsigned*)((const char*)(gbase) + (voff)[i]), (LAS unsigned*)(lds + (bufoff) + ldsw + (i) * 8192), 16, 0, 0)
#define PG8_PCA(b, h, base, vs, i) do { if constexpr (GATHER) { PG8_PIECE(PG8_SA(b, h), (base), vs[h], i); } else { PG8_PIECE(PG8_SA(b, h), (base) + (h) * hstep, voffA, i); } PG8_SCHED; } while (0)
#define PG8_PCB(b, h, base, i) do { PG8_PIECE(PG8_SB(b, h), (base) + (h) * hstep, voffB, i); PG8_SCHED; } while (0)
#define PG8_MMAH(ai, bj, At, Bt, HK) do { __builtin_amdgcn_s_setprio(1); \
        if constexpr (FP8) { _Pragma("unroll") for (int m = 0; m < 4; ++m) _Pragma("unroll") for (int n = 0; n < 2; ++n) \
            { const i32x8 a8_ = PG8_CAT(Bt[n][0], Bt[n][1]), b8_ = PG8_CAT(At[m][0], At[m][1]); \
              asm volatile("v_mfma_scale_f32_16x16x128_f8f6f4 %0, %1, %2, %0, %3, %3 op_sel_hi:[0,0,0]" : "+v"(acc[ai][bj][m][n]) : "v"(a8_), "v"(b8_), "v"(one8)); HK(m * 2 + n); } } \
        else { _Pragma("unroll") for (int k = 0; k < 2; ++k) _Pragma("unroll") for (int m = 0; m < 4; ++m) { _Pragma("unroll") for (int n = 0; n < 2; ++n) \
            acc[ai][bj][m][n] = __builtin_amdgcn_mfma_f32_16x16x32_bf16(Bt[n][k], At[m][k], acc[ai][bj][m][n], 0, 0, 0); HK(k * 4 + m); } } \
        __builtin_amdgcn_s_setprio(0); } while (0)
#define PG8_WAIT_V(n) asm volatile("s_waitcnt vmcnt(" #n ")" ::: "memory")
#define PG8_WAIT_L(n) asm volatile("s_waitcnt lgkmcnt(" #n ")" ::: "memory")
#define PG8_BAR __builtin_amdgcn_s_barrier()
#define PG8_SCHED __builtin_amdgcn_sched_barrier(0)
    Unit cur, nxt; int ui = 0;
    if (!S.next(0, cur)) return;
    int one8 = 0x7f7f7f7f; asm volatile("" : "+v"(one8));
    f32x4 acc[2][2][4][2];
#pragma unroll
    for (int a = 0; a < 2; ++a)
#pragma unroll
        for (int b = 0; b < 2; ++b)
#pragma unroll
            for (int m = 0; m < 4; ++m)
#pragma unroll
                for (int n = 0; n < 2; ++n) acc[a][b][m][n] = (f32x4){0.f, 0.f, 0.f, 0.f};
    bf16x8 At[4][2], B0[2][2], B1[2][2];
    unsigned vc[2][2], vn[2][2], v2[2][2];
#pragma unroll
    for (int h = 0; h < 2; ++h)
#pragma unroll
        for (int i = 0; i < 2; ++i) { vc[h][i] = GATHER ? S.arow(cur, h * HALF + Rr[i]) * (unsigned)(K * 2) + (unsigned)Cb[i] : 0u; vn[h][i] = vc[h][i]; v2[h][i] = vc[h][i]; }
    const char* cA = GATHER ? (const char*)g.A : (const char*)g.A + (size_t)cur.pm * tstep; const char* cB = (const char*)g.Bt + (size_t)cur.pn * tstep;
    PG8_STAGE(PG8_SB(0, 0), cB, voffB); PG8_STAGE(PG8_SB(0, 1), cB + hstep, voffB); PG8_STGA(0, 0, cA, vc); PG8_STGA(0, 1, cA, vc);
    if (wr == 1) PG8_BAR;
    PG8_WAIT_V(2); PG8_BAR;
    constexpr bool PEEL = FP8;
    PG8_STAGE(PG8_SB(1, 0), cB + kstep, voffB); PG8_STGA(1, 0, cA + kstep, vc); PG8_STAGE(PG8_SB(1, 1), cB + hstep + kstep, voffB);
    PG8_STGA(1, 1, cA + kstep, vc); PG8_WAIT_V(8);
    PG8_BAR;
    constexpr int XW = Epi::NVM + Epi::NPRE + (GATHER ? 4 : 0);
    { LAS unsigned* dump = (LAS unsigned*)(lds + STAGE_BYTES + (unsigned)wave_in * 256u);
#pragma unroll
      for (int s_ = 0; s_ < Epi::NVM; ++s_) __builtin_amdgcn_global_load_lds((const unsigned*)g.Bt, dump, 4, 0, 0); }
#define PG8_ITER(FIRST) do { \
            const bool last = !(FIRST) && (t == nt - 2); \
            const char* a1 = cA + (size_t)(t + 1) * kstep; \
            const char* a2 = last ? nA : cA + (size_t)(t + 2) * kstep; const char* b2 = last ? nB : cB + (size_t)(t + 2) * kstep; \
            const char* a3 = a2 + kstep; const char* b3 = b2 + kstep; \
            if (GATHER) { \
                _Pragma("unroll") for (int h = 0; h < 2; ++h) _Pragma("unroll") for (int i = 0; i < 2; ++i) v2[h][i] = last ? vn[h][i] : vc[h][i]; \
            } \
              \
            PG8_LDB(B0, 0, 0); PG8_LDB(B1, 0, 1); PG8_SCHED; PG8_LDA(At, 0, 0); if (!(FIRST)) PG8_STGA(1, 1, a1, vc); \
            if (FIRST) wait_v<8 + XW>(); else wait_v<8>(); PG8_WAIT_L(0); PG8_BAR; PG8_MMA(0, 0, At, B0); PG8_MMA(0, 1, At, B1); PG8_BAR; PG8_SCHED; \
              \
            PG8_LDA(At, 0, 1); PG8_STAGE(PG8_SB(0, 0), b2, voffB); PG8_STAGE(PG8_SB(0, 1), b2 + hstep, voffB); PG8_STGA(0, 0, a2, v2); \
            if (FIRST) wait_v<8 + XW>(); else wait_v<8>(); PG8_WAIT_L(0); PG8_BAR; PG8_MMA(1, 0, At, B0); PG8_MMA(1, 1, At, B1); PG8_BAR; PG8_SCHED; \
              \
            PG8_LDB(B0, 1, 0); PG8_LDB(B1, 1, 1); PG8_SCHED; PG8_LDA(At, 1, 0); PG8_STGA(0, 1, a2, v2); \
            if (FIRST) wait_v<8 + XW>(); else wait_v<8>(); PG8_WAIT_L(0); PG8_BAR; PG8_MMA(0, 0, At, B0); PG8_MMA(0, 1, At, B1); PG8_BAR; PG8_SCHED; \
              \
            PG8_LDA(At, 1, 1); PG8_STAGE(PG8_SB(1, 0), b3, voffB); PG8_STAGE(PG8_SB(1, 1), b3 + hstep, voffB); PG8_STGA(1, 0, a3, v2); \
            PG8_WAIT_V(8); PG8_WAIT_L(0); PG8_BAR; PG8_MMA(1, 0, At, B0); PG8_MMA(1, 1, At, B1); PG8_BAR; PG8_SCHED; \
        } while (0)
#define PG8_H1A(j) if ((j) == 3 && !(FIRST_)) PG8_PCA(1, 1, a1, vc, 0)
#define PG8_H1B(j) if ((j) == 3 && !(FIRST_)) PG8_PCA(1, 1, a1, vc, 1)
#define PG8_H2A(j) if ((j) == 1) PG8_PCB(0, 0, b2, 0); else if ((j) == 3) PG8_PCB(0, 0, b2, 1); else if ((j) == 5) PG8_PCB(0, 1, b2, 0)
#define PG8_H2B(j) if ((j) == 1) PG8_PCB(0, 1, b2, 1); else if ((j) == 3) PG8_PCA(0, 0, a2, v2, 0); else if ((j) == 5) PG8_PCA(0, 0, a2, v2, 1)
#define PG8_H3A(j) if ((j) == 3) PG8_PCA(0, 1, a2, v2, 0)
#define PG8_H3B(j) if ((j) == 3) PG8_PCA(0, 1, a2, v2, 1)
#define PG8_H4A(j) if ((j) == 1) PG8_PCB(1, 0, b3, 0); else if ((j) == 3) PG8_PCB(1, 0, b3, 1); else if ((j) == 5) PG8_PCB(1, 1, b3, 0)
#define PG8_H4B(j) if ((j) == 1) PG8_PCB(1, 1, b3, 1); else if ((j) == 3) PG8_PCA(1, 0, a3, v2, 0); else if ((j) == 5) PG8_PCA(1, 0, a3, v2, 1)
#define PG8_ITER2(FIRST) do { \
            const bool FIRST_ = (FIRST); \
            const bool last = !(FIRST) && (t == nt - 2); \
            const char* a1 = cA + (size_t)(t + 1) * kstep; \
            const char* a2 = last ? nA : cA + (size_t)(t + 2) * kstep; const char* b2 = last ? nB : cB + (size_t)(t + 2) * kstep; \
            const char* a3 = a2 + kstep; const char* b3 = b2 + kstep; \
            if (GATHER) { \
                _Pragma("unroll") for (int h = 0; h < 2; ++h) _Pragma("unroll") for (int i = 0; i < 2; ++i) v2[h][i] = last ? vn[h][i] : vc[h][i]; \
            } \
            PG8_LDB(B0, 0, 0); PG8_LDB(B1, 0, 1); PG8_SCHED; PG8_LDA(At, 0, 0); \
            if (FIRST) wait_v<8 + XW>(); else wait_v<6>(); PG8_WAIT_L(0); PG8_BAR; PG8_MMAH(0, 0, At, B0, PG8_H1A); PG8_MMAH(0, 1, At, B1, PG8_H1B); PG8_BAR; PG8_SCHED; \
            PG8_LDA(At, 0, 1); \
            if (FIRST) wait_v<2 + XW>(); else wait_v<2>(); PG8_WAIT_L(0); PG8_BAR; PG8_MMAH(1, 0, At, B0, PG8_H2A); PG8_MMAH(1, 1, At, B1, PG8_H2B); PG8_BAR; PG8_SCHED; \
            PG8_LDB(B0, 1, 0); PG8_LDB(B1, 1, 1); PG8_SCHED; PG8_LDA(At, 1, 0); \
            if (FIRST) wait_v<6 + XW>(); else wait_v<6>(); PG8_WAIT_L(0); PG8_BAR; PG8_MMAH(0, 0, At, B0, PG8_H3A); PG8_MMAH(0, 1, At, B1, PG8_H3B); PG8_BAR; PG8_SCHED; \
            PG8_LDA(At, 1, 1); \
            wait_v<2>(); PG8_WAIT_L(0); PG8_BAR; PG8_MMAH(1, 0, At, B0, PG8_H4A); PG8_MMAH(1, 1, At, B1, PG8_H4B); PG8_BAR; PG8_SCHED; \
        } while (0)
    constexpr bool MD = FP8;
#define PG8_IT(FIRST) do { if constexpr (MD) PG8_ITER2(FIRST); else PG8_ITER(FIRST); } while (0)
    for (;;) {
        const bool has_next = S.next(ui + 1, nxt);
        if (GATHER && has_next && !PEEL) {
            int t2 = wave_in * 64 + lane_id(); asm volatile("" : "+v"(t2));
#pragma unroll
            for (int i = 0; i < 2; ++i) { int R, C; stage_rc(t2 * 16 + i * 8192, R, C);
#pragma unroll
                for (int h = 0; h < 2; ++h) vn[h][i] = S.arow(nxt, h * HALF + R) * (unsigned)(K * 2) + (unsigned)(C * 2); }
        }
        if (GATHER && PEEL) {
            int t2 = wave_in * 64 + lane_id(); asm volatile("" : "+v"(t2));
#pragma unroll
            for (int i = 0; i < 2; ++i) { int R, C; stage_rc(t2 * 16 + i * 8192, R, C);
#pragma unroll
                for (int h = 0; h < 2; ++h) vn[h][i] = S.arow_raw(has_next ? nxt : cur, h * HALF + R); }
        }
        typename Epi::Pre pre = E.preload(cur, wr, wc, fr, fq);
        const char* nA = has_next ? (GATHER ? (const char*)g.A : (const char*)g.A + (size_t)nxt.pm * tstep) : cA; const char* nB = has_next ? (const char*)g.Bt + (size_t)nxt.pn * tstep : cB;
        if constexpr (PEEL) { int t = 0; PG8_IT(true); }
        if (GATHER && PEEL) {
            int t2 = wave_in * 64 + lane_id(); asm volatile("" : "+v"(t2));
#pragma unroll
            for (int i = 0; i < 2; ++i) { int R, C; stage_rc(t2 * 16 + i * 8192, R, C);
#pragma unroll
                for (int h = 0; h < 2; ++h) vn[h][i] = (vn[h][i] >> 2) * (unsigned)(K * 2) + (unsigned)(C * 2); }
        }
        if constexpr (PEEL) {
#pragma unroll 1
            for (int t = 2; t < nt; t += 2) PG8_IT(false); }
        else {
#pragma unroll 1
            for (int t = 0; t < nt; t += 2) PG8_IT(t == 0); }
        PG8_STGA(1, 1, nA + kstep, vn);
        if (wr == 0) PG8_BAR;
        if constexpr (FP8) asm volatile("s_nop 15\n\ts_nop 15" ::: "memory");
        E(acc, cur, wr, wc, fr, fq, pre);
        if (!has_next) break;
#pragma unroll
        for (int a = 0; a < 2; ++a)
#pragma unroll
            for (int b = 0; b < 2; ++b)
#pragma unroll
                for (int m = 0; m < 4; ++m)
#pragma unroll
                    for (int n = 0; n < 2; ++n) acc[a][b][m][n] = (f32x4){0.f, 0.f, 0.f, 0.f};
        cur = nxt; cA = nA; cB = nB; ++ui;
#pragma unroll
        for (int h = 0; h < 2; ++h)
#pragma unroll
            for (int i = 0; i < 2; ++i) vc[h][i] = vn[h][i];
        if (wr == 1) PG8_BAR;
    }
    PG8_WAIT_V(0);
    PG8_BAR;
#undef PG8_SA
#undef PG8_SB
#undef PG8_STAGE
#undef PG8_STGA
#undef PG8_LDA
#undef PG8_LDB
#undef PG8_MMA
#undef PG8_CAT
#undef PG8_WAIT_V
#undef PG8_WAIT_L
#undef PG8_BAR
#undef PG8_SCHED
#undef PG8_ITER
#undef PG8_ITER2
#undef PG8_IT
#undef PG8_PIECE
#undef PG8_PCA
#undef PG8_PCB
#undef PG8_MMAH
#undef PG8_H1A
#undef PG8_H1B
#undef PG8_H2A
#undef PG8_H2B
#undef PG8_H3A
#undef PG8_H3B
#undef PG8_H4A
#undef PG8_H4B
}
}

struct Frame {
    LAS unsigned char* lds;
    LAS unsigned char* misc;
    gu32* ctl;
    int tid, lane, wave, vcu, G, wave0;
    const float *x_in, *c_in, *w_ada, *b_ada, *norm1, *w_in, *sinks, *lq1, *lk1, *lq2, *lk2, *subln, *w_out, *norm2, *w_router, *b_router, *w_gate, *b_gate, *w_up, *b_up, *w_down, *b_down, *norm_f;
    float* out;
    float *modp, *mod, *part; int* ltok; float* lg; int* inv;
    bf16_t *WIN, *WOUT, *WGU, *WDN, *H, *PROJ, *MIXED, *HIDDEN, *Y, *XB;
};

__device__ __forceinline__ void p0_transpose_tile(const float* src, int N, bf16_t* dst, int ldd, LAS float* scr, int lane) {
#pragma unroll
    for (int i = 0; i < 32; ++i) { const int kk = 2 * i + (lane >> 5); scr[kk * 33 + (lane & 31)] = src[(size_t)kk * N + (lane & 31)]; }
    LDS_WAIT(); asm volatile("" ::: "memory");
    const int c = lane & 7;
#pragma unroll
    for (int j = 0; j < 4; ++j) { const int n = (lane >> 3) + 8 * j; const LAS float* s = scr + (8 * c) * 33 + n;
        u32x4 o; o.x = pk2(s[0 * 33], s[1 * 33]); o.y = pk2(s[2 * 33], s[3 * 33]); o.z = pk2(s[4 * 33], s[5 * 33]); o.w = pk2(s[6 * 33], s[7 * 33]);
        *(GAS u32x4*)(dst + (size_t)n * ldd + 8 * c) = o; }
    LDS_WAIT(); asm volatile("" ::: "memory");
}
__device__ __forceinline__ void p0_transpose_tile8(const float* src, int N, unsigned char* dst, int ldd, LAS float* scr, int lane) {
#pragma unroll
    for (int i = 0; i < 32; ++i) { const int kk = 2 * i + (lane >> 5); scr[kk * 33 + (lane & 31)] = src[(size_t)kk * N + (lane & 31)]; }
    LDS_WAIT(); asm volatile("" ::: "memory");
    const int c = lane & 7;
#pragma unroll
    for (int j = 0; j < 4; ++j) { const int n = (lane >> 3) + 8 * j; const LAS float* s = scr + (8 * c) * 33 + n;
        u32x2 o; o.x = pk4_fp8(s[0 * 33] * W8_SCALE, s[1 * 33] * W8_SCALE, s[2 * 33] * W8_SCALE, s[3 * 33] * W8_SCALE); o.y = pk4_fp8(s[4 * 33] * W8_SCALE, s[5 * 33] * W8_SCALE, s[6 * 33] * W8_SCALE, s[7 * 33] * W8_SCALE);
        *(GAS u32x2*)(dst + (size_t)n * ldd + 8 * c) = o; }
    LDS_WAIT(); asm volatile("" ::: "memory");
}
__device__ __forceinline__ void p0_prologue(Frame& F) {
    LAS float* cond = (LAS float*)F.lds;
    for (int i = F.tid; i < NBATCH * DM; i += NTHREADS) { const float v = F.c_in[i]; cond[i] = v / (1.f + __expf(-v)); }
    __syncthreads();
    LAS float* scr = (LAS float*)(F.lds + 32768 + F.wave * 8448);
    const int gw = F.vcu * NWAVES + F.wave, NGW = F.G * NWAVES;
    constexpr int I_MOD = DEPTH * 24 * 4;
    constexpr int I_IN = DEPTH * 16 * 88, I_OUT = DEPTH * 16 * 32, I_E = DEPTH * NE * 16 * 32;
    constexpr int NITEMS = I_MOD + I_IN + I_OUT + 3 * I_E;
    for (int it = gw; it < NITEMS; it += NGW) {
        int r = it;
        if (r < I_MOD) {
            const int kq = r & 3, cg = (r >> 2) % 24, L = (r >> 2) / 24, col = cg * 256 + 4 * F.lane;
            f32x4 acc[NBATCH];
#pragma unroll
            for (int b = 0; b < NBATCH; ++b) acc[b] = (f32x4){0.f, 0.f, 0.f, 0.f};
            const float* wp = F.w_ada + ((size_t)L * DM + kq * 256) * 6144 + col;
            for (int k4 = 0; k4 < 64; ++k4) {
                f32x4 w[4];
#pragma unroll
                for (int j = 0; j < 4; ++j) w[j] = *(const GAS f32x4*)(wp + (size_t)(k4 * 4 + j) * 6144);
#pragma unroll
                for (int b = 0; b < NBATCH; ++b) { const f32x4 cv = *(const LAS f32x4*)(cond + b * DM + kq * 256 + k4 * 4);
                    acc[b] += w[0] * cv.x + w[1] * cv.y + w[2] * cv.z + w[3] * cv.w; }
            }
#pragma unroll
            for (int b = 0; b < NBATCH; ++b) *(GAS f32x4*)(F.modp + (((size_t)kq * DEPTH + L) * NBATCH + b) * 6144 + col) = acc[b];
            continue;
        }
        r -= I_MOD;
        if (r < I_IN) { const int L = r / (16 * 88), q = r % (16 * 88), kb = q / 88, nb = q % 88;
            p0_transpose_tile(F.w_in + ((size_t)L * DM + kb * 64) * INW + nb * 32, INW, F.WIN + ((size_t)L * INW + nb * 32) * DM + kb * 64, DM, scr, F.lane); continue; }
        r -= I_IN;
        if (r < I_OUT) { const int L = r / 512, q = r % 512, kb = q / 32, nb = q % 32;
            p0_transpose_tile(F.w_out + ((size_t)L * DM + kb * 64) * DM + nb * 32, DM, F.WOUT + ((size_t)L * DM + nb * 32) * DM + kb * 64, DM, scr, F.lane); continue; }
        r -= I_OUT;
        { const int which = r / I_E, q0 = r % I_E, le = q0 / 512, q = q0 % 512, kb = q / 32, nb = q % 32, n0 = nb * 32;
          unsigned char* WGU8 = (unsigned char*)F.WGU; unsigned char* WDN8 = (unsigned char*)F.WDN;
          if (which == 0) p0_transpose_tile8(F.w_gate + ((size_t)le * DM + kb * 64) * DM + n0, DM, WGU8 + ((size_t)le * 2048 + (n0 >> 7) * 256 + (n0 & 127)) * DM + kb * 64, DM, scr, F.lane);
          else if (which == 1) p0_transpose_tile8(F.w_up + ((size_t)le * DM + kb * 64) * DM + n0, DM, WGU8 + ((size_t)le * 2048 + (n0 >> 7) * 256 + 128 + (n0 & 127)) * DM + kb * 64, DM, scr, F.lane);
          else p0_transpose_tile8(F.w_down + ((size_t)le * DM + kb * 64) * DM + n0, DM, WDN8 + ((size_t)le * DM + n0) * DM + kb * 64, DM, scr, F.lane); }
    }
}
__device__ __forceinline__ void p0b_modsum(Frame& F) {
    const int gt = F.vcu * NTHREADS + F.tid, NGT = F.G * NTHREADS;
    for (int i = gt; i < DEPTH * NBATCH * 6144 / 4; i += NGT) {
        const int e = i * 4, L = e / (NBATCH * 6144), j = e % 6144;
        f32x4 s = *(const GAS f32x4*)(F.b_ada + (size_t)L * 6144 + j);
#pragma unroll
        for (int kq = 0; kq < 4; ++kq) s += *(const GAS f32x4*)(F.modp + (size_t)kq * DEPTH * NBATCH * 6144 + e);
        *(GAS f32x4*)(F.mod + e) = s;
    }
}

template <int MODE>
__device__ __forceinline__ void p1_rows(Frame& F, int L, float g2mul = 1.0f) {
    const int gw = F.vcu * NWAVES + F.wave, NGW = F.G * NWAVES, lane = F.lane;
    const float* gain = (MODE == 2) ? F.norm_f : F.norm1 + (size_t)L * DM;
    f32x4 gn[4];
#pragma unroll
    for (int j = 0; j < 4; ++j) gn[j] = *(const GAS f32x4*)(gain + 4 * lane + 256 * j);
    for (int chunk = gw; chunk < NTOK / 32; chunk += NGW) {
        const int m0 = chunk * 32, b = m0 >> 13;
        f32x4 sc[4], sh[4], g2[4];
#pragma unroll
        for (int j = 0; j < 4; ++j) {
            if (MODE != 2) { const float* mp = F.mod + ((size_t)L * NBATCH + b) * 6144; sh[j] = *(const GAS f32x4*)(mp + 0 * DM + 4 * lane + 256 * j); sc[j] = *(const GAS f32x4*)(mp + 1 * DM + 4 * lane + 256 * j); }
            if (MODE != 0) { const float* mq = F.mod + ((size_t)(L - 1) * NBATCH + b) * 6144; g2[j] = *(const GAS f32x4*)(mq + 5 * DM + 4 * lane + 256 * j) * (g2mul * (1.0f / Y8_SCALE)); }
        }
        f32x4 xa[4], xb[4]; unsigned ya[4][4], yb[4][4];
        int pst = 0; i32x4 iv = {0, 0, 0, 0};
        if (MODE != 0) {
            const int c = (int)__hip_atomic_load((unsigned*)(F.ctl + CW_CNT + ((L - 1) * NE + (lane & 31)) * 16), RLX_AGENT);
            const int p = (c + 255) & ~255;
#pragma unroll
            for (int e2 = 0; e2 < 31; ++e2) { const int v_ = __builtin_amdgcn_readlane(p, e2); pst += ((lane & 31) > e2) ? v_ : 0; }
            iv = *(const GAS i32x4*)(F.inv + ((size_t)m0 + (lane & 31)) * 4);
        }
#define P1_LOAD(X, Yv, mrow) do { const size_t m_ = (size_t)(mrow); \
            _Pragma("unroll") for (int j = 0; j < 4; ++j) { if (MODE == 0) X[j] = *(const GAS f32x4*)(F.x_in + m_ * DM + 4 * lane + 256 * j); \
                else { const u32x2 xb_ = *(const GAS u32x2*)(F.XB + m_ * DM + 4 * lane + 256 * j); X[j] = (f32x4){bf_lo(xb_.x), bf_hi(xb_.x), bf_lo(xb_.y), bf_hi(xb_.y)}; } } \
            if (MODE != 0) { const int li_ = (int)(m_ - (size_t)m0); \
                _Pragma("unroll") for (int k = 0; k < TOPK; ++k) { const int w_ = __builtin_amdgcn_readlane(k == 0 ? iv.x : k == 1 ? iv.y : k == 2 ? iv.z : iv.w, li_); \
                    const size_t row_ = (size_t)(__builtin_amdgcn_readlane(pst, w_ & 255) + (w_ >> 8)); \
                    _Pragma("unroll") for (int j = 0; j < 4; ++j) Yv[j][k] = *(const GAS unsigned*)((const unsigned char*)F.Y + row_ * DM + 4 * lane + 256 * j); } } } while (0)
#define P1_PROC(X, Yv, mrow) do { const size_t m = (size_t)(mrow); f32x4 v[4]; \
            _Pragma("unroll") for (int j = 0; j < 4; ++j) { v[j] = X[j]; \
                if (MODE != 0) { f32x4 ys = (f32x4){0.f, 0.f, 0.f, 0.f}; \
                    _Pragma("unroll") for (int k = 0; k < TOPK; ++k) { const f32x2 ylo = __builtin_amdgcn_cvt_pk_f32_fp8((int)Yv[j][k], false), yhi = __builtin_amdgcn_cvt_pk_f32_fp8((int)Yv[j][k], true); ys += (f32x4){ylo.x, ylo.y, yhi.x, yhi.y}; } \
                    v[j] += g2[j] * ys; } } \
            float ss = 0.f; \
            _Pragma("unroll") for (int j = 0; j < 4; ++j) ss += (v[j].x * v[j].x + v[j].y * v[j].y) + (v[j].z * v[j].z + v[j].w * v[j].w); \
            const float rs = 1.0f / sqrtf(wave_sum(ss) * (1.f / DM) + RMS_EPS); \
            if (MODE == 2) { _Pragma("unroll") for (int j = 0; j < 4; ++j) *(GAS f32x4*)(F.out + m * DM + 4 * lane + 256 * j) = v[j] * rs * gn[j]; } \
            else { _Pragma("unroll") for (int j = 0; j < 4; ++j) { { u32x2 xo_; xo_.x = pk2(v[j].x, v[j].y); xo_.y = pk2(v[j].z, v[j].w); *(GAS u32x2*)(F.XB + m * DM + 4 * lane + 256 * j) = xo_; } \
                    const f32x4 h = (v[j] * rs * gn[j]) * (sc[j] + 1.0f) + sh[j]; \
                    u32x2 o; o.x = pk2(h.x, h.y); o.y = pk2(h.z, h.w); \
                    *(GAS u32x2*)(F.H + m * DM + 4 * lane + 256 * j) = o; } } } while (0)
        P1_LOAD(xa, ya, m0);
        for (int i = 0; i < 32; i += 2) {
            P1_LOAD(xb, yb, m0 + i + 1);
            P1_PROC(xa, ya, m0 + i);
            if (i + 2 < 32) P1_LOAD(xa, ya, m0 + i + 2);
            P1_PROC(xb, yb, m0 + i + 1);
        }
#undef P1_LOAD
#undef P1_PROC
    }
}

constexpr int MO_RS = 9216, MO_BIASP = 10240, MO_PART = 10368;
__device__ __forceinline__ void p5_route(Frame& F, int L, int LC) {
    const int lane = F.lane, r32 = lane & 31, hi = lane >> 5;
    LAS float* Wl = (LAS float*)F.lds;
    LAS int* hist = (LAS int*)(F.misc + MO_HIST); LAS int* base = (LAS int*)(F.misc + MO_BASE);
    LAS int* sel_e = (LAS int*)(F.misc + MO_SELE); LAS float* sel_g = (LAS float*)(F.misc + MO_SELG);
    LAS float* rsl = (LAS float*)(F.misc + MO_RS); LAS float* biasp = (LAS float*)(F.misc + MO_BIASP); LAS float* part = (LAS float*)(F.misc + MO_PART);
    const float* Wr = F.w_router + (size_t)L * DM * NE;
    f32x4 gn[4];
#pragma unroll
    for (int j = 0; j < 4; ++j) gn[j] = *(const GAS f32x4*)(F.norm2 + (size_t)L * DM + 4 * lane + 256 * j);
    for (int blk = F.vcu; blk < NTOK / 256; blk += F.G) {
        const int tok0 = blk * 256 + F.wave * 32, b = tok0 >> 13;
        const float* mp = F.mod + ((size_t)L * NBATCH + b) * 6144;
        if (F.tid < NE) hist[F.tid] = 0;
        for (int it = F.tid; it < (DM / 8) * NE; it += NTHREADS) { const int kg = it >> 5, e = it & 31, k0 = kg * 8;
            const f32x4 n0 = *(const GAS f32x4*)(F.norm2 + (size_t)L * DM + k0), n1 = *(const GAS f32x4*)(F.norm2 + (size_t)L * DM + k0 + 4);
            const f32x4 s0 = *(const GAS f32x4*)(mp + 4 * DM + k0), s1 = *(const GAS f32x4*)(mp + 4 * DM + k0 + 4);
            float w[8];
#pragma unroll
            for (int i = 0; i < 8; ++i) w[i] = Wr[(size_t)(k0 + i) * NE + e] * ((i < 4 ? n0[i & 3] : n1[i & 3]) * (1.0f + (i < 4 ? s0[i & 3] : s1[i & 3])));
            u32x4 hv, mv;
#pragma unroll
            for (int i = 0; i < 4; ++i) { const unsigned hb = cvt_pk_bf16(w[2 * i], w[2 * i + 1]); hv[i] = hb; mv[i] = cvt_pk_bf16(w[2 * i] - bf_lo(hb), w[2 * i + 1] - bf_hi(hb)); }
            const int off = ((kg * 32) + e) * 16;
            *(LAS u32x4*)((LAS unsigned char*)Wl + off) = hv; *(LAS u32x4*)((LAS unsigned char*)Wl + 65536 + off) = mv; }
        { const int e = lane & 31, k0 = F.wave * 128 + hi * 64; float acc = 0.f;
#pragma unroll 8
          for (int k = 0; k < 64; ++k) acc = __builtin_fmaf(mp[3 * DM + k0 + k], Wr[(size_t)(k0 + k) * NE + e], acc);
          part[(F.wave * 2 + hi) * 32 + e] = acc; }
        f32x4 sc[4], sh[4];
#pragma unroll
        for (int j = 0; j < 4; ++j) { sh[j] = *(const GAS f32x4*)(mp + 3 * DM + 4 * lane + 256 * j); sc[j] = *(const GAS f32x4*)(mp + 4 * DM + 4 * lane + 256 * j); }
        f32x4 xa[4], xb[4];
#define P5_LOAD(X, mrow) do { _Pragma("unroll") for (int j = 0; j < 4; ++j) { const u32x2 xb_ = *(const GAS u32x2*)(F.XB + (size_t)(mrow) * DM + 4 * lane + 256 * j); X[j] = (f32x4){bf_lo(xb_.x), bf_hi(xb_.x), bf_lo(xb_.y), bf_hi(xb_.y)}; } } while (0)
#define P5_PROC(X, mrow, irow) do { const size_t m = (size_t)(mrow); float ss = 0.f; \
            _Pragma("unroll") for (int j = 0; j < 4; ++j) ss += (X[j].x * X[j].x + X[j].y * X[j].y) + (X[j].z * X[j].z + X[j].w * X[j].w); \
            const float rs = 1.0f / sqrtf(wave_sum(ss) * (1.f / DM) + RMS_EPS); \
            _Pragma("unroll") for (int j = 0; j < 4; ++j) { const f32x4 h = ((X[j] * rs * gn[j]) * (sc[j] + 1.0f) + sh[j]) * H8_SCALE; \
                *(GAS unsigned*)((unsigned char*)F.H + m * DM + 4 * lane + 256 * j) = pk4_fp8(h.x, h.y, h.z, h.w); } \
            if (lane == 0) rsl[F.wave * 32 + (irow)] = rs; } while (0)
        P5_LOAD(xa, tok0);
        for (int i = 0; i < 32; i += 2) {
            P5_LOAD(xb, tok0 + i + 1);
            P5_PROC(xa, tok0 + i, i);
            if (i + 2 < 32) P5_LOAD(xa, tok0 + i + 2);
            P5_PROC(xb, tok0 + i + 1, i + 1);
        }
#undef P5_LOAD
#undef P5_PROC
        __syncthreads();
        if (F.tid < NE) { float s = F.b_router[L * NE + F.tid];
#pragma unroll
            for (int p = 0; p < 16; ++p) s += part[p * 32 + F.tid];
            biasp[F.tid] = s; }
        __syncthreads();
        {
            f32x16 a0, a1;
#pragma unroll
            for (int r = 0; r < 16; ++r) { a0[r] = 0.f; a1[r] = 0.f; }
            const bf16_t* xr = F.XB + ((size_t)tok0 + r32) * DM + 8 * hi;
            const LAS unsigned char* wl = (const LAS unsigned char*)Wl + (hi * 32 + r32) * 16;
#pragma unroll 4
            for (int j = 0; j < 64; ++j) {
                const bf16x8 xv = *(const GAS bf16x8*)(xr + 16 * j);
                const bf16x8 wh = *(const LAS bf16x8*)(wl + j * 1024), wm = *(const LAS bf16x8*)(wl + 65536 + j * 1024);
                a0 = __builtin_amdgcn_mfma_f32_32x32x16_bf16(wh, xv, a0, 0, 0, 0); a1 = __builtin_amdgcn_mfma_f32_32x32x16_bf16(wm, xv, a1, 0, 0, 0);
            }
            const float rs = rsl[F.wave * 32 + r32];
            float v[16];
#pragma unroll
            for (int r = 0; r < 16; ++r) v[r] = (a0[r] + a1[r]) * rs + biasp[(r & 3) + 8 * (r >> 2) + 4 * hi];
            float tv[4]; int ti[4];
#pragma unroll
            for (int rd = 0; rd < 4; ++rd) {
                float bv = v[0]; int bi = 4 * hi;
#pragma unroll
                for (int r = 1; r < 16; ++r) { const int ei = (r & 3) + 8 * (r >> 2) + 4 * hi; if (v[r] > bv) { bv = v[r]; bi = ei; } }
                { const auto rv_ = __builtin_amdgcn_permlane32_swap(__float_as_uint(bv), __float_as_uint(bv), false, false); const auto ri_ = __builtin_amdgcn_permlane32_swap((unsigned)bi, (unsigned)bi, false, false);
                  const float v0_ = __uint_as_float(rv_[0]), v1_ = __uint_as_float(rv_[1]); const int i0_ = (int)ri_[0], i1_ = (int)ri_[1];
                  const bool up_ = (v1_ > v0_) || (v1_ == v0_ && i1_ < i0_); bv = up_ ? v1_ : v0_; bi = up_ ? i1_ : i0_; }
                tv[rd] = bv; ti[rd] = bi;
#pragma unroll
                for (int r = 0; r < 16; ++r) { const int ei = (r & 3) + 8 * (r >> 2) + 4 * hi; if (ei == bi) v[r] = -INFINITY; }
            }
            const float e1 = __expf(tv[1] - tv[0]), e2 = __expf(tv[2] - tv[0]), e3 = __expf(tv[3] - tv[0]); const float inv = 1.0f / (1.0f + e1 + e2 + e3);
#pragma unroll
            for (int kk = 0; kk < 2; ++kk) {
                const int me = hi ? (kk ? ti[3] : ti[2]) : (kk ? ti[1] : ti[0]);
                const float mg = (hi ? (kk ? e3 : e2) : (kk ? e1 : 1.0f)) * inv;
                const int pos = __hip_atomic_fetch_add(&hist[me], 1, __ATOMIC_RELAXED, __HIP_MEMORY_SCOPE_WORKGROUP);
                const int a = (F.wave * 32 + r32) * 4 + 2 * hi + kk;
                sel_e[a] = me | (pos << 8); sel_g[a] = mg;
            }
        }
        __syncthreads();
        if (F.tid < NE) base[F.tid] = (int)__hip_atomic_fetch_add((unsigned*)(F.ctl + CW_CNT + (LC * NE + F.tid) * 16), (unsigned)hist[F.tid], RLX_AGENT);
        __syncthreads();
        for (int a = F.tid; a < 1024; a += NTHREADS) { const int se = sel_e[a], ex = se & 255, pos = se >> 8, slot = base[ex] + pos;
            F.ltok[(size_t)ex * LCAP + slot] = (blk * 256 + (a >> 2)) * 4 + (a & 3); F.lg[(size_t)ex * LCAP + slot] = sel_g[a];
            F.inv[(size_t)blk * 1024 + a] = ex | (slot << 8); }
        __syncthreads();
    }
}

struct EpiProj {
    static constexpr bool PERM = true; static constexpr int NVM = 16;
    struct Pre {}; static constexpr int NPRE = 0;
    __device__ __forceinline__ Pre preload(const pg8::Unit&, int, int, int, int) const { return Pre{}; }
    __device__ __forceinline__ void operator()(const f32x4 (&acc)[2][2][4][2], const pg8::Unit& u, int wr, int wc, int fr, int fq, const Pre&) const { (*this)(acc, u, wr, wc, fr, fq); }
    bf16_t* O; unsigned* nrm;
    __device__ __forceinline__ void operator()(const f32x4 (&acc)[2][2][4][2], const pg8::Unit& u, int wr, int wc, int fr, int fq) const {
        const int row0 = u.pm * 256 + wr * 64 + fr, col0 = u.pn * 256 + wc * 32 + 8 * fq;
        const float sc = (u.pn == 0 || u.pn == 3 || u.pn == 5 || u.pn == 6) ? QSCALE : 1.0f;
        float nmx[2] = {0.f, 0.f};
#pragma unroll
        for (int ai = 0; ai < 2; ++ai)
#pragma unroll
            for (int m = 0; m < 4; ++m) { bf16_t* rowp = O + (size_t)(row0 + ai * 128 + m * 16) * INW + col0;
#pragma unroll
                for (int bj = 0; bj < 2; ++bj) { const f32x4 v0 = acc[ai][bj][m][0] * sc, v1 = acc[ai][bj][m][1] * sc;
                    u32x4 w; w.x = cvt_pk_bf16(v0[0], v0[1]); w.y = cvt_pk_bf16(v0[2], v0[3]); w.z = cvt_pk_bf16(v1[0], v1[1]); w.w = cvt_pk_bf16(v1[2], v1[3]);
                    *(GAS u32x4*)(rowp + bj * 128) = w;
                    if (C_TILE_SKIP && u.pn >= 5 && u.pn <= 8) {
                        float q = (v0[0] * v0[0] + v0[1] * v0[1]) + (v0[2] * v0[2] + v0[3] * v0[3]) + (v1[0] * v1[0] + v1[1] * v1[1]) + (v1[2] * v1[2] + v1[3] * v1[3]);
                        q = x32_sum(x16_sum(q)); nmx[bj] = fmaxf(nmx[bj], q); } } }
        if (C_TILE_SKIP && u.pn >= 5 && u.pn <= 8) {
#pragma unroll
            for (int bj = 0; bj < 2; ++bj) { float v = row16_max(nmx[bj]);
                if (fr == 0 && fq == 0) { const int b = u.pm >> 5, qk = u.pn >= 7, blk = (u.pn - (qk ? 7 : 5)) * 8 + bj * 4 + wc;
                    atomicMax(nrm + (b * 2 + qk) * 16 + blk, __float_as_uint(v)); } }
        }
    }
};
struct EpiOut {
    static constexpr bool PERM = false; static constexpr int NVM = 32;
    struct Pre {}; static constexpr int NPRE = 0;
    __device__ __forceinline__ Pre preload(const pg8::Unit&, int, int, int, int) const { return Pre{}; }
    __device__ __forceinline__ void operator()(const f32x4 (&acc)[2][2][4][2], const pg8::Unit& u, int wr, int wc, int fr, int fq, const Pre&) const { (*this)(acc, u, wr, wc, fr, fq); }
    bf16_t* X; const float* g1; float gmul;
    __device__ __forceinline__ void operator()(const f32x4 (&acc)[2][2][4][2], const pg8::Unit& u, int wr, int wc, int fr, int fq) const {
        const int b = u.pm >> 5, col0 = u.pn * 256 + wc * 32 + 4 * fq;
        f32x4 gv[2][2];
#pragma unroll
        for (int bj = 0; bj < 2; ++bj)
#pragma unroll
            for (int n = 0; n < 2; ++n) gv[bj][n] = *(const GAS f32x4*)(g1 + (size_t)b * 6144 + col0 + bj * 128 + n * 16) * gmul;
#pragma unroll
        for (int ai = 0; ai < 2; ++ai) {
            u32x2 xv[4][2][2];
#pragma unroll
            for (int m = 0; m < 4; ++m)
#pragma unroll
                for (int bj = 0; bj < 2; ++bj)
#pragma unroll
                    for (int n = 0; n < 2; ++n) xv[m][bj][n] = *(const GAS u32x2*)(X + (size_t)(u.pm * 256 + ai * 128 + wr * 64 + m * 16 + fr) * DM + col0 + bj * 128 + n * 16);
#pragma unroll
            for (int m = 0; m < 4; ++m)
#pragma unroll
                for (int bj = 0; bj < 2; ++bj)
#pragma unroll
                    for (int n = 0; n < 2; ++n) { const u32x2 xb = xv[m][bj][n]; const f32x4 o = (f32x4){bf_lo(xb.x), bf_hi(xb.x), bf_lo(xb.y), bf_hi(xb.y)} + gv[bj][n] * acc[ai][bj][m][n];
                        u32x2 w; w.x = cvt_pk_bf16(o[0], o[1]); w.y = cvt_pk_bf16(o[2], o[3]);
                        *(GAS u32x2*)(X + (size_t)(u.pm * 256 + ai * 128 + wr * 64 + m * 16 + fr) * DM + col0 + bj * 128 + n * 16) = w; }
            asm volatile("" ::: "memory");
        }
    }
};
struct EpiGU {
    static constexpr bool PERM = true; static constexpr int NVM = 8;
    unsigned char* Hd; const float* bg; const float* bu;
    struct Pre { float b; }; static constexpr int NPRE = 1;
    __device__ __forceinline__ Pre preload(const pg8::Unit& u, int wr, int wc, int fr, int fq) const {
        const int e = u.pn >> 3, pnl = u.pn & 7, hc = pnl * 128 + wc * 32 + 8 * fq; Pre p;
        p.b = __uint_as_float(ld_untracked(((fr & 8) ? bu : bg) + (size_t)e * DM + hc + (fr & 7)));
        return p;
    }
    __device__ __forceinline__ void operator()(const f32x4 (&acc)[2][2][4][2], const pg8::Unit& u, int wr, int wc, int fr, int fq, const Pre& pre) const {
        const int pnl = u.pn & 7, hc = pnl * 128 + wc * 32 + 8 * fq;
        constexpr float ds = 1.0f / (W8_SCALE * H8_SCALE);
        f32x4 bgv[2], buv[2];
        { const int base4 = (lane_id() & 48) * 4;
#pragma unroll
          for (int n = 0; n < 2; ++n)
#pragma unroll
            for (int i = 0; i < 4; ++i) { bgv[n][i] = __int_as_float(__builtin_amdgcn_ds_bpermute(base4 + (n * 4 + i) * 4, __float_as_int(pre.b)));
                                          buv[n][i] = __int_as_float(__builtin_amdgcn_ds_bpermute(base4 + (8 + n * 4 + i) * 4, __float_as_int(pre.b))); } }
        constexpr float KS = -1.702f * LOG2E, US = HID8_SCALE / KS;
        f32x4 kbg[2], ubu[2];
#pragma unroll
        for (int n = 0; n < 2; ++n) { kbg[n] = bgv[n] * KS; ubu[n] = buv[n] * US + US; }
#pragma unroll
        for (int ai = 0; ai < 2; ++ai)
#pragma unroll
            for (int m = 0; m < 4; ++m) {
                float hv[8];
#pragma unroll
                for (int n = 0; n < 2; ++n) {
                    const f32x4 ap4 = acc[ai][0][m][n] * (KS * ds) + kbg[n], up4 = acc[ai][1][m][n] * (US * ds) + ubu[n];
#pragma unroll
                    for (int i = 0; i < 4; ++i) { const float ap = fmaxf(ap4[i], 7.0f * KS), up = __builtin_amdgcn_fmed3f(up4[i], 8.0f * US, -6.0f * US);
                        const float sg = __builtin_amdgcn_rcpf(1.0f + __builtin_amdgcn_exp2f(ap));
                        hv[n * 4 + i] = (ap * sg) * up; } }
                u32x2 w; w.x = pk4_fp8_nc(hv[0], hv[1], hv[2], hv[3]); w.y = pk4_fp8_nc(hv[4], hv[5], hv[6], hv[7]);
                *(GAS u32x2*)(Hd + (size_t)(u.pm * 256 + ai * 128 + wr * 64 + m * 16 + fr) * DM + hc) = w; }
    }
};
struct EpiDown {
    static constexpr bool PERM = true; static constexpr int NVM = 8;
    unsigned char* Y; const float* bd; const LAS int* tab; const float* lg; LAS unsigned char* stg;
    struct Pre { float b; float g[2]; }; static constexpr int NPRE = 3;
    __device__ __forceinline__ Pre preload(const pg8::Unit& u, int wr, int wc, int fr, int fq) const {
        const int e = u.pn >> 2, pnl = u.pn & 3, col0 = pnl * 256 + wc * 32 + 8 * fq;
        const int pstart = tab[32 + e], cnt = tab[64 + e]; Pre p;
        p.b = __uint_as_float(ld_untracked(bd + (size_t)e * DM + col0 + (fr >> 3) * 128 + (fr & 7)));
#pragma unroll
        for (int ai = 0; ai < 2; ++ai) { const int i = u.pm * 256 + ai * 128 + wr * 64 + fq * 16 + fr - pstart; p.g[ai] = __uint_as_float(ld_untracked(lg + (size_t)e * LCAP + (i < cnt ? i : 0))); }
        return p;
    }
    __device__ __forceinline__ void operator()(const f32x4 (&acc)[2][2][4][2], const pg8::Unit& u, int wr, int wc, int fr, int fq, const Pre& pre) const {
        const int pnl = u.pn & 3, col0 = pnl * 256 + wc * 32 + 8 * fq;
        f32x4 bv[2][2]; float gt[2][4];
        { const int l_ = lane_id(), base4 = (l_ & 48) * 4, fr4 = (l_ & 15) * 4;
#pragma unroll
          for (int bj = 0; bj < 2; ++bj)
#pragma unroll
            for (int n = 0; n < 2; ++n)
#pragma unroll
                for (int i = 0; i < 4; ++i) bv[bj][n][i] = __int_as_float(__builtin_amdgcn_ds_bpermute(base4 + (bj * 8 + n * 4 + i) * 4, __float_as_int(pre.b)));
#pragma unroll
          for (int ai = 0; ai < 2; ++ai)
#pragma unroll
            for (int m = 0; m < 4; ++m) gt[ai][m] = __int_as_float(__builtin_amdgcn_ds_bpermute(m * 64 + fr4, __float_as_int(pre.g[ai]))); }
        LAS unsigned char* sg_ = stg + wr * EPI_STG_GRP;
        const int l_ = lane_id(), rrow = wc * 16 + (l_ >> 3), rch = l_ & 7;
#pragma unroll
        for (int ai = 0; ai < 2; ++ai)
#pragma unroll
            for (int bj = 0; bj < 2; ++bj) {
#pragma unroll
                for (int m = 0; m < 4; ++m) { constexpr float ds = 1.0f / (W8_SCALE * HID8_SCALE); const float g_ = gt[ai][m] * Y8_SCALE;
                    const f32x4 v0 = (acc[ai][bj][m][0] * ds + bv[bj][0]) * g_, v1 = (acc[ai][bj][m][1] * ds + bv[bj][1]) * g_;
                    u32x2 w; w.x = pk4_fp8(v0[0], v0[1], v0[2], v0[3]); w.y = pk4_fp8(v1[0], v1[1], v1[2], v1[3]);
                    *(LAS u32x2*)(sg_ + (m * 16 + fr) * EPI_STG_ROW + wc * 32 + 8 * fq) = w; }
                asm volatile("s_waitcnt lgkmcnt(0)\n\ts_barrier" ::: "memory");
#pragma unroll
                for (int k = 0; k < 2; ++k) { const int r64 = rrow + 8 * k; const u32x4 v = *(const LAS u32x4*)(sg_ + r64 * EPI_STG_ROW + rch * 16);
                    __builtin_nontemporal_store(v, (GAS u32x4*)(Y + (size_t)(u.pm * 256 + ai * 128 + wr * 64 + r64) * DM + pnl * 256 + bj * 128 + rch * 16)); }
                asm volatile("s_waitcnt lgkmcnt(0)\n\ts_barrier" ::: "memory");
            }
    }
};
struct MoeSched {
    const LAS int* tab; int NTs  , NBk, G, vcu; const int* ltok;
    __device__ __forceinline__ bool next(int i, pg8::Unit& u) const {
        const int L = i * G + vcu, per = 32 << NTs, chunk = L / per, rem = L % per, pnl = rem & ((1 << NTs) - 1), rb = chunk * 32 + (rem >> NTs);
        if (rb >= NBk) return false;
        const int pe = tab[lane_id() & 31];
        const unsigned long long bal = __ballot(pe <= rb * 256);
        const int e = __popc((unsigned)bal);
        u.pm = rb; u.pn = (e << NTs) + pnl; return true;
    }
    __device__ __forceinline__ unsigned arow(const pg8::Unit& u, int r) const {
        const int e = u.pn >> NTs, i = u.pm * 256 + r - tab[32 + e];
        return (i < tab[64 + e]) ? ((unsigned)ltok[(size_t)e * LCAP + i] >> 2) : 0u;
    }
    __device__ __forceinline__ unsigned arow_raw(const pg8::Unit& u, int r) const {
        const int e = u.pn >> NTs, i = u.pm * 256 + r - tab[32 + e];
        return ld_untracked(ltok + (size_t)e * LCAP + (i < tab[64 + e] ? i : 0));
    }
};
__device__ __forceinline__ void moe_table(Frame& F, int L) {
    LAS int* tab = (LAS int*)(F.misc + MO_TAB);
    if (F.tid < 64) {
        const int e = F.tid & 31;
        const int c = (int)__hip_atomic_load((unsigned*)(F.ctl + CW_CNT + (L * NE + e) * 16), RLX_AGENT);
        int p = (c + 255) & ~255, incl = p;
#pragma unroll
        for (int e2 = 0; e2 < 31; ++e2) { const int v_ = __builtin_amdgcn_readlane(p, e2); incl += (e > e2) ? v_ : 0; }
        if (F.tid < 32) { tab[e] = incl; tab[32 + e] = incl - p; tab[64 + e] = c; if (e == 31) tab[96] = incl >> 8; }
    }
    __syncthreads();
}

namespace att {
typedef short v4i16_t __attribute__((ext_vector_type(4)));
typedef LAS const char* lds_cptr;
__device__ __forceinline__ int crow(int r, int hi) { return (r & 3) + 8 * (r >> 2) + 4 * hi; }
__device__ __forceinline__ void glds16(const void* gsrc, unsigned lds_dst) { unsigned keep;
    asm volatile("s_mov_b32 %0, m0\n\ts_mov_b32 m0, %2\n\ts_nop 0\n\tglobal_load_lds_dwordx4 %1, off\n\ts_mov_b32 m0, %0" : "=&s"(keep) : "v"(gsrc), "s"(lds_dst) : "memory"); }
__device__ __forceinline__ void glds16s(const void* sbase, unsigned voff, unsigned lds_dst) { unsigned keep;
    asm volatile("s_mov_b32 %0, m0\n\ts_mov_b32 m0, %3\n\ts_nop 0\n\tglobal_load_lds_dwordx4 %1, %2\n\ts_mov_b32 m0, %0" : "=&s"(keep) : "v"(voff), "s"(sbase), "s"(lds_dst) : "memory"); }
__device__ __forceinline__ u32x2 vtr2(lds_cptr p) { return __builtin_bit_cast(u32x2, __builtin_amdgcn_ds_read_tr16_b64_v4i16((LAS v4i16_t*)p)); }
__device__ __forceinline__ bf16x8 vcat(u32x2 lo, u32x2 hv) { return __builtin_bit_cast(bf16x8, (u32x4){lo.x, lo.y, hv.x, hv.y}); }
__device__ __forceinline__ s16x4 vtr(lds_cptr p) { return __builtin_bit_cast(s16x4, __builtin_amdgcn_ds_read_tr16_b64_v4i16((LAS v4i16_t*)p)); }
#define ATT_WAIT_BAR(N) asm volatile("s_waitcnt vmcnt(" #N ") lgkmcnt(0)\n\ts_barrier" ::: "memory")
#define ATT_MFMA(a, b, c) __builtin_amdgcn_mfma_f32_32x32x16_bf16((a), (b), (c), 0, 0, 0)
__device__ __forceinline__ bf16x8 pack8(const f32x16& p, int s) {
    u32x4 w; w.x = cvt_pk_bf16(p[8 * s + 0], p[8 * s + 1]); w.y = cvt_pk_bf16(p[8 * s + 2], p[8 * s + 3]); w.z = cvt_pk_bf16(p[8 * s + 4], p[8 * s + 5]); w.w = cvt_pk_bf16(p[8 * s + 6], p[8 * s + 7]);
    return __builtin_bit_cast(bf16x8, w);
}
__device__ __forceinline__ u32x4 pair16(u32x2 w0, u32x2 w1) {
    const auto x = __builtin_amdgcn_permlane32_swap(w0.x, w1.x, false, false);
    const auto y = __builtin_amdgcn_permlane32_swap(w0.y, w1.y, false, false);
    return (u32x4){x[0], y[0], x[1], y[1]};
}
__device__ __forceinline__ float xmax32(float v) { const auto r = __builtin_amdgcn_permlane32_swap(__float_as_uint(v), __float_as_uint(v), false, false); return fmaxf(__uint_as_float(r[0]), __uint_as_float(r[1])); }
__device__ __forceinline__ float xsum32(float v) { const auto r = __builtin_amdgcn_permlane32_swap(__float_as_uint(v), __float_as_uint(v), false, false); return __uint_as_float(r[0]) + __uint_as_float(r[1]); }
__device__ __forceinline__ float max16(const f32x16& p) {
    float a = fmaxf(fmaxf(p[0], p[1]), fmaxf(p[2], p[3])), b = fmaxf(fmaxf(p[4], p[5]), fmaxf(p[6], p[7]));
    float c = fmaxf(fmaxf(p[8], p[9]), fmaxf(p[10], p[11])), d = fmaxf(fmaxf(p[12], p[13]), fmaxf(p[14], p[15]));
    return fmaxf(fmaxf(a, b), fmaxf(c, d));
}
__device__ __forceinline__ float sum16(const f32x16& p) {
    float a = (p[0] + p[1]) + (p[2] + p[3]), b = (p[4] + p[5]) + (p[6] + p[7]), c = (p[8] + p[9]) + (p[10] + p[11]), d = (p[12] + p[13]) + (p[14] + p[15]);
    return (a + b) + (c + d);
}

constexpr int C_KSLOT = 16384, C_VRING = 65536;
#define SBAR() __builtin_amdgcn_sched_barrier(0)
#define PIN(x) asm volatile("" : "+v"(x))
#define MX3(a, b, c) __builtin_fmaxf(__builtin_fmaxf((a), (b)), (c))
#define EX2(v) __builtin_amdgcn_exp2f(v)
#define PAF(k) __builtin_bit_cast(bf16x8, pw##k)
#define VRD(i) do { vl_[i] = vtr2(vp_ + (((i) & 3) * 4096 + ((i) >> 2) * 1024)); vh_[i] = vtr2(vp_ + (((i) & 3) * 4096 + ((i) >> 2) * 1024 + 512)); } while (0)
#define VFR(i) vcat(vl_[i], vh_[i])
#define FMAMK(d, a, K, c) asm("v_fmamk_f32 %0, %1, %3, %2" : "=v"(d) : "v"(a), "v"(c), "i"(__builtin_bit_cast(int, (float)(K))))
#define ATTC_STEP(C0, C1, P0, P1, t, GK, GV, GL) do { SBAR(); \
    const lds_cptr kc_ = kp0 + (((t) & 3) << 14); float sacc = P0[0] + P0[1]; \
    kf[2] = *(const LAS bf16x8*)(KXA(kc_, 1) + 0); C0 = ATT_MFMA(kf[0], qr[0], C0); sacc += P0[2]; sacc += P0[3]; sacc += P0[4]; sacc += P0[5]; PIN(sacc); pw0[0] = cvt_pk_bf16(P0[0], P0[1]); pw0[1] = cvt_pk_bf16(P0[2], P0[3]); PIN(pw0); SBAR(); \
    kf[3] = *(const LAS bf16x8*)(KXA(kc_, 1) + 4096); C1 = ATT_MFMA(kf[1], qr[0], C1); sacc += P0[6]; sacc += P0[7]; sacc += P0[8]; sacc += P0[9]; PIN(sacc); pw0[2] = cvt_pk_bf16(P0[4], P0[5]); pw0[3] = cvt_pk_bf16(P0[6], P0[7]); PIN(pw0); SBAR(); \
    kf[4] = *(const LAS bf16x8*)(KXA(kc_, 2) + 0); C0 = ATT_MFMA(kf[2], qr[1], C0); sacc += P0[10]; sacc += P0[11]; sacc += P0[12]; sacc += P0[13]; PIN(sacc); pw1[0] = cvt_pk_bf16(P0[8], P0[9]); pw1[1] = cvt_pk_bf16(P0[10], P0[11]); PIN(pw1); SBAR(); \
    kf[5] = *(const LAS bf16x8*)(KXA(kc_, 2) + 4096); C1 = ATT_MFMA(kf[3], qr[1], C1); sacc += P0[14]; sacc += P0[15]; sacc += P1[0]; sacc += P1[1]; PIN(sacc); pw1[2] = cvt_pk_bf16(P0[12], P0[13]); pw1[3] = cvt_pk_bf16(P0[14], P0[15]); PIN(pw1); SBAR(); \
    kf[6] = *(const LAS bf16x8*)(KXA(kc_, 3) + 0); C0 = ATT_MFMA(kf[4], qr[2], C0); sacc += P1[2]; sacc += P1[3]; sacc += P1[4]; sacc += P1[5]; PIN(sacc); pw2[0] = cvt_pk_bf16(P1[0], P1[1]); pw2[1] = cvt_pk_bf16(P1[2], P1[3]); PIN(pw2); SBAR(); \
    kf[7] = *(const LAS bf16x8*)(KXA(kc_, 3) + 4096); C1 = ATT_MFMA(kf[5], qr[2], C1); sacc += P1[6]; sacc += P1[7]; sacc += P1[8]; sacc += P1[9]; PIN(sacc); pw2[2] = cvt_pk_bf16(P1[4], P1[5]); pw2[3] = cvt_pk_bf16(P1[6], P1[7]); PIN(pw2); SBAR(); \
    C0 = ATT_MFMA(kf[6], qr[3], C0); sacc += P1[10]; sacc += P1[11]; sacc += P1[12]; sacc += P1[13]; PIN(sacc); pw3[0] = cvt_pk_bf16(P1[8], P1[9]); pw3[1] = cvt_pk_bf16(P1[10], P1[11]); PIN(pw3); SBAR(); \
    C1 = ATT_MFMA(kf[7], qr[3], C1); sacc += P1[14]; sacc += P1[15]; PIN(sacc); pw3[2] = cvt_pk_bf16(P1[12], P1[13]); pw3[3] = cvt_pk_bf16(P1[14], P1[15]); PIN(pw3); SBAR(); \
    l_reg += sacc; \
    if (GK) { C_DMA_K((t) + 3, ((((t) + 3) & 3) << 14)); } if (GV) { C_DMA_V((t) + 1, sl_next); } \
    const lds_cptr vp_ = vp0 + sl_prev; const lds_cptr kn_ = kp0 + ((((t) + 1) & 3) << 14); \
    const int tn_ = (t) + 1; float sg_ = (tn_ < tm) ? slope2 : -slope2; PIN(sg_); \
    u32x2 vl_[16], vh_[16]; \
    VRD(0); VRD(1); SBAR(); \
    VRD(2); o[0] = ATT_MFMA(VFR(0), PAF(0), o[0]); float ma_ = MX3(C0[0], C0[1], C0[2]); float mb_ = MX3(C0[3], C0[4], C0[5]); ma_ = MX3(ma_, C0[6], C0[7]); mb_ = MX3(mb_, C0[8], C0[9]); PIN(ma_); PIN(mb_); SBAR(); \
    VRD(3); o[1] = ATT_MFMA(VFR(1), PAF(0), o[1]); ma_ = MX3(ma_, C0[10], C0[11]); mb_ = MX3(mb_, C0[12], C0[13]); ma_ = MX3(ma_, C0[14], C0[15]); mb_ = MX3(mb_, C1[0], C1[1]); PIN(ma_); PIN(mb_); SBAR(); \
    VRD(4); o[2] = ATT_MFMA(VFR(2), PAF(0), o[2]); ma_ = MX3(ma_, C1[2], C1[3]); mb_ = MX3(mb_, C1[4], C1[5]); ma_ = MX3(ma_, C1[6], C1[7]); mb_ = MX3(mb_, C1[8], C1[9]); PIN(ma_); PIN(mb_); SBAR(); \
    VRD(5); o[3] = ATT_MFMA(VFR(3), PAF(0), o[3]); ma_ = MX3(ma_, C1[10], C1[11]); mb_ = MX3(mb_, C1[12], C1[13]); ma_ = MX3(ma_, C1[14], C1[15]); PIN(ma_); PIN(mb_); SBAR(); \
    { float rm_ = __builtin_fmaxf(ma_, mb_); { auto rr_ = __builtin_amdgcn_permlane32_swap(__float_as_uint(rm_), __float_as_uint(rm_), false, false); rm_ = __builtin_fmaxf(__uint_as_float(rr_[0]), __uint_as_float(rr_[1])); } \
      resc = false; \
      if (__builtin_expect(__any(rm_ > 8.0f), 0)) { const float dl_ = __builtin_fmaxf(rm_, 0.f); m += dl_; \
        _Pragma("unroll") for (int r_ = 0; r_ < 16; ++r_) { C0[r_] -= dl_; C1[r_] -= dl_; } \
        fsc = __builtin_amdgcn_exp2f(-dl_); l_reg *= fsc; resc = true; rm_ -= dl_; } \
      pz = __all(rm_ < -150.0f); } \
    const float ib_ = sg_ * ((float)(64 * tn_ + 4 * hi) - qf) - m; SBAR(); \
    VRD(6); o[0] = ATT_MFMA(VFR(4), PAF(1), o[0]); C0[0] = EX2(C0[0]); C0[1] = EX2(C0[1]); C0[2] = EX2(C0[2]); FMAMK(P0[0], sg_, 0.0f, ib_); FMAMK(P0[1], sg_, 1.0f, ib_); FMAMK(P0[2], sg_, 2.0f, ib_); PIN(C0); PIN(P0); SBAR(); \
    VRD(7); o[1] = ATT_MFMA(VFR(5), PAF(1), o[1]); C0[3] = EX2(C0[3]); C0[4] = EX2(C0[4]); C0[5] = EX2(C0[5]); FMAMK(P0[3], sg_, 3.0f, ib_); FMAMK(P0[4], sg_, 8.0f, ib_); FMAMK(P0[5], sg_, 9.0f, ib_); PIN(C0); PIN(P0); SBAR(); \
    VRD(8); o[2] = ATT_MFMA(VFR(6), PAF(1), o[2]); C0[6] = EX2(C0[6]); C0[7] = EX2(C0[7]); FMAMK(P0[6], sg_, 10.0f, ib_); FMAMK(P0[7], sg_, 11.0f, ib_); PIN(C0); PIN(P0); SBAR(); \
    VRD(9); o[3] = ATT_MFMA(VFR(7), PAF(1), o[3]); C0[8] = EX2(C0[8]); C0[9] = EX2(C0[9]); C0[10] = EX2(C0[10]); FMAMK(P0[8], sg_, 16.0f, ib_); FMAMK(P0[9], sg_, 17.0f, ib_); FMAMK(P0[10], sg_, 18.0f, ib_); PIN(C0); PIN(P0); SBAR(); \
    VRD(10); o[0] = ATT_MFMA(VFR(8), PAF(2), o[0]); C0[11] = EX2(C0[11]); C0[12] = EX2(C0[12]); C0[13] = EX2(C0[13]); FMAMK(P0[11], sg_, 19.0f, ib_); FMAMK(P0[12], sg_, 24.0f, ib_); FMAMK(P0[13], sg_, 25.0f, ib_); PIN(C0); PIN(P0); SBAR(); \
    VRD(11); o[1] = ATT_MFMA(VFR(9), PAF(2), o[1]); C0[14] = EX2(C0[14]); C0[15] = EX2(C0[15]); FMAMK(P0[14], sg_, 26.0f, ib_); FMAMK(P0[15], sg_, 27.0f, ib_); PIN(C0); PIN(P0); SBAR(); \
    if (GL) { kf[0] = *(const LAS bf16x8*)(KXA(kn_, 0) + 0); } VRD(12); o[2] = ATT_MFMA(VFR(10), PAF(2), o[2]); C1[0] = EX2(C1[0]); C1[1] = EX2(C1[1]); C1[2] = EX2(C1[2]); FMAMK(P1[0], sg_, 32.0f, ib_); FMAMK(P1[1], sg_, 33.0f, ib_); FMAMK(P1[2], sg_, 34.0f, ib_); PIN(C1); PIN(P1); SBAR(); \
    if (GL) { kf[1] = *(const LAS bf16x8*)(KXA(kn_, 0) + 4096); } VRD(13); o[3] = ATT_MFMA(VFR(11), PAF(2), o[3]); C1[3] = EX2(C1[3]); C1[4] = EX2(C1[4]); C1[5] = EX2(C1[5]); FMAMK(P1[3], sg_, 35.0f, ib_); FMAMK(P1[4], sg_, 40.0f, ib_); FMAMK(P1[5], sg_, 41.0f, ib_); PIN(C1); PIN(P1); SBAR(); \
    VRD(14); o[0] = ATT_MFMA(VFR(12), PAF(3), o[0]); C1[6] = EX2(C1[6]); C1[7] = EX2(C1[7]); FMAMK(P1[6], sg_, 42.0f, ib_); FMAMK(P1[7], sg_, 43.0f, ib_); PIN(C1); PIN(P1); SBAR(); \
    VRD(15); o[1] = ATT_MFMA(VFR(13), PAF(3), o[1]); C1[8] = EX2(C1[8]); C1[9] = EX2(C1[9]); C1[10] = EX2(C1[10]); FMAMK(P1[8], sg_, 48.0f, ib_); FMAMK(P1[9], sg_, 49.0f, ib_); FMAMK(P1[10], sg_, 50.0f, ib_); PIN(C1); PIN(P1); SBAR(); \
    o[2] = ATT_MFMA(VFR(14), PAF(3), o[2]); C1[11] = EX2(C1[11]); C1[12] = EX2(C1[12]); C1[13] = EX2(C1[13]); FMAMK(P1[11], sg_, 51.0f, ib_); FMAMK(P1[12], sg_, 56.0f, ib_); FMAMK(P1[13], sg_, 57.0f, ib_); PIN(C1); PIN(P1); SBAR(); \
    o[3] = ATT_MFMA(VFR(15), PAF(3), o[3]); C1[14] = EX2(C1[14]); C1[15] = EX2(C1[15]); FMAMK(P1[14], sg_, 58.0f, ib_); FMAMK(P1[15], sg_, 59.0f, ib_); PIN(C1); PIN(P1); SBAR(); \
    if (tn_ == tm) { const float db_ = (float)(64 * tn_ + 4 * hi) - qf; \
      _Pragma("unroll") for (int r_ = 0; r_ < 16; ++r_) { const float c_ = (float)((r_ & 3) + 8 * (r_ >> 2)); \
        P0[r_] = __builtin_fmaf(-__builtin_fabsf(db_ + c_), slope2, -m); P1[r_] = __builtin_fmaf(-__builtin_fabsf(db_ + (32.f + c_)), slope2, -m); } } \
    } while (0)

__device__ __forceinline__ bool attnC_unit(const bf16_t* P, bf16_t* MX, const float* gainv  , int b, int h, int qb, float slope2, float lam, float post, LAS unsigned char* shm, int wid, int lane, int T0, int NT, volatile LAS unsigned* badw) {
    const int r32 = lane & 31, hi = lane >> 5, rg = wid & 3, mp = wid >> 2;
    const size_t rowbase = (size_t)b * SEQ;
    const int q0 = qb * 128 + rg * 32, tm = (q0 >> 6) - T0;
    const bf16_t* qp = P + (rowbase + q0 + r32) * INW + C_QC + h * 128 + mp * 64 + hi * 8;
    bf16x8 qr[4];
#pragma unroll
    for (int d0 = 0; d0 < 4; ++d0) qr[d0] = *(const GAS bf16x8*)(qp + d0 * 16);
    const bf16_t* kbase = P + (rowbase + (size_t)T0 * 64) * INW + C_KC + h * 128;
    const bf16_t* vbase = P + (rowbase + (size_t)T0 * 64) * INW + C_VC + h * 128;
    const int c4 = wid >> 1, ks0 = 2 * (wid & 1);
    const int frow = 8 * wid + (lane >> 3);
    const unsigned voffk = (unsigned)(frow * INW + (((lane & 7) ^ ((frow >> 1) & 7)) * 8)) * 2u;
    const unsigned voffv = (unsigned)((16 * ks0 + (lane >> 2)) * INW + c4 * 32 + (lane & 3) * 8) * 2u;
    const unsigned lds0 = (unsigned)(size_t)shm;
    const unsigned d_k1 = lds0 + wid * 1024, d_k2 = lds0 + 8192 + wid * 1024, d_v0 = lds0 + C_VRING + (2 * wid) * 1024, d_v1 = d_v0 + 1024;
#define C_DMA_K(t, slot) do { const bf16_t* _b = kbase + (size_t)(t) * 64 * INW; \
        glds16s(_b, voffk, (unsigned)__builtin_amdgcn_readfirstlane(d_k1 + (slot))); glds16s(_b + 64, voffk, (unsigned)__builtin_amdgcn_readfirstlane(d_k2 + (slot))); } while (0)
#define C_DMA_V(t, slot) do { const bf16_t* _b = vbase + (size_t)(t) * 64 * INW; \
        glds16s(_b, voffv, (unsigned)__builtin_amdgcn_readfirstlane(d_v0 + (slot))); glds16s(_b + 16 * INW, voffv, (unsigned)__builtin_amdgcn_readfirstlane(d_v1 + (slot))); } while (0)
    const lds_cptr shm3 = (lds_cptr)shm;
    const lds_cptr kp0 = shm3 + mp * 8192 + r32 * 128 + ((hi ^ ((r32 >> 1) & 7)) * 16);
#define KXA(base, d0) ((lds_cptr)(size_t)((unsigned)(size_t)(base) ^ (unsigned)((d0) << 5)))
    const lds_cptr vp0 = shm3 + C_VRING + ((lane >> 4) & 1) * 32 + (lane & 3) * 8 + (4 * hi + ((lane & 15) >> 2)) * 64;
    if (C_TILE_SKIP == 1 && wid == 0 && lane == 0) *badw = 0u;
    C_DMA_K(0, 0); C_DMA_V(0, 0); C_DMA_K(1, C_KSLOT);
    float m = 0.f, l_reg = 0.f, fsc = 1.f; bool resc = false, pz = false; (void)pz;
    f32x16 o[4];
#pragma unroll
    for (int c = 0; c < 4; ++c)
#pragma unroll
        for (int r = 0; r < 16; ++r) o[c][r] = 0.f;
    const float qf = (float)(q0 + r32 - 64 * T0);
    f32x16 pA0, pA1, pB0, pB1; bf16x8 kf[8]; u32x4 pw0, pw1, pw2, pw3;
    int sl_prev = 0, sl_cur = 0, sl_next = C_KSLOT;
#define C_ROT() do { sl_prev = sl_cur; sl_cur = sl_next; sl_next = (sl_next == 2 * C_KSLOT) ? 0 : sl_next + C_KSLOT; } while (0)
#define C_RESC() do { if (resc) { _Pragma("unroll") for (int c_ = 0; c_ < 4; ++c_) _Pragma("unroll") for (int r_ = 0; r_ < 16; ++r_) o[c_][r_] *= fsc; } } while (0)
#define C_INIT(X0, X1, tn) do { const float db_ = (float)(64 * (tn) + 4 * hi) - qf; \
        _Pragma("unroll") for (int r_ = 0; r_ < 16; ++r_) { const float c_ = (float)((r_ & 3) + 8 * (r_ >> 2)); \
            X0[r_] = __builtin_fmaf(-__builtin_fabsf(db_ + c_), slope2, -m); X1[r_] = __builtin_fmaf(-__builtin_fabsf(db_ + (32.f + c_)), slope2, -m); } } while (0)
#define C_KLOAD8(kp) do { _Pragma("unroll") for (int j_ = 0; j_ < 8; ++j_) kf[j_] = *(const LAS bf16x8*)(KXA((kp), j_ >> 1) + (j_ & 1) * 4096); } while (0)
    C_DMA_K(2, 2 * C_KSLOT);
    C_INIT(pA0, pA1, 0);
    ATT_WAIT_BAR(6);
    C_KLOAD8(kp0);
#pragma unroll
    for (int i = 0; i < 8; ++i) { if (i & 1) pA1 = ATT_MFMA(kf[i], qr[i >> 1], pA1); else pA0 = ATT_MFMA(kf[i], qr[i >> 1], pA0); }
    { float rm = fmaxf(max16(pA0), max16(pA1)); rm = xmax32(rm);
      if (__any(rm > 8.0f)) { const float dl = fmaxf(rm, 0.f); m += dl;
#pragma unroll
          for (int r = 0; r < 16; ++r) { pA0[r] -= dl; pA1[r] -= dl; } }
#pragma unroll
      for (int r = 0; r < 16; ++r) { pA0[r] = EX2(pA0[r]); pA1[r] = EX2(pA1[r]); } }
    ATT_WAIT_BAR(0);
    C_DMA_K(3, 3 * C_KSLOT); C_DMA_V(1, C_KSLOT);
    C_ROT();
    { const lds_cptr k1_ = kp0 + C_KSLOT; kf[0] = *(const LAS bf16x8*)(k1_); kf[1] = *(const LAS bf16x8*)(k1_ + 4096); }
    C_INIT(pB0, pB1, 1);
    if (wid >= 4) __builtin_amdgcn_s_setprio(1);
    int t = 1;
    for (; t + 5 < NT; t += 2) {
        ATTC_STEP(pB0, pB1, pA0, pA1, t, true, true, true);     ATT_WAIT_BAR(4); C_RESC(); C_ROT();
        ATTC_STEP(pA0, pA1, pB0, pB1, t + 1, true, true, true); ATT_WAIT_BAR(4); C_RESC(); C_ROT();
    }
#define C_ENDW(tt) do { if ((tt) + 3 < NT) { ATT_WAIT_BAR(4); } else if ((tt) + 2 < NT) { ATT_WAIT_BAR(2); } else { ATT_WAIT_BAR(0); } } while (0)
    for (; t + 1 < NT; t += 2) {
        ATTC_STEP(pB0, pB1, pA0, pA1, t, (t + 3 < NT), (t + 1 < NT), (t + 1 < NT));         C_ENDW(t);     C_RESC(); C_ROT();
        ATTC_STEP(pA0, pA1, pB0, pB1, t + 1, (t + 4 < NT), (t + 2 < NT), (t + 2 < NT));     C_ENDW(t + 1); C_RESC(); C_ROT();
    }
    ATTC_STEP(pB0, pB1, pA0, pA1, NT - 1, false, false, false); C_RESC();
    __builtin_amdgcn_s_setprio(0);
    { l_reg += sum16(pB0) + sum16(pB1);
      const bf16x8 q0_ = pack8(pB0, 0), q1_ = pack8(pB0, 1), q2_ = pack8(pB1, 0), q3_ = pack8(pB1, 1);
      const lds_cptr vp = vp0 + sl_cur;
#pragma unroll
      for (int c = 0; c < 4; ++c)
#pragma unroll
          for (int s = 0; s < 4; ++s) {
              const bf16x8 vf = vcat(vtr2(vp + c * 4096 + s * 1024), vtr2(vp + c * 4096 + s * 1024 + 512));
              o[c] = ATT_MFMA(vf, s == 0 ? q0_ : s == 1 ? q1_ : s == 2 ? q2_ : q3_, o[c]);
          } }
    if (C_TILE_SKIP == 1 && NT < SEQ / 64) {
        const int NF = SEQ / 64 - NT;
        ATT_WAIT_BAR(0);
#define C_FAR(i) (((i) < T0) ? (i) - T0 : (i) - T0 + NT)
#define C_DMA_KF(trel, slot) do { const bf16_t* _b = kbase + (ptrdiff_t)(trel) * 64 * INW; \
        glds16s(_b, voffk, (unsigned)__builtin_amdgcn_readfirstlane(d_k1 + (slot))); glds16s(_b + 64, voffk, (unsigned)__builtin_amdgcn_readfirstlane(d_k2 + (slot))); } while (0)
        const int NP = NF >> 1;
        C_DMA_KF(C_FAR(0), 0); C_DMA_KF(C_FAR(1), C_KSLOT);
        if (NP > 1) { C_DMA_KF(C_FAR(2), 2 * C_KSLOT); C_DMA_KF(C_FAR(3), 3 * C_KSLOT); }
        bool badl = false;
        int s0 = 0, s2 = 4 * C_KSLOT;
        for (int p = 0; p < NP; ++p) {
            if (p + 1 < NP) { ATT_WAIT_BAR(4); } else { ATT_WAIT_BAR(0); }
            if (p + 2 < NP) { C_DMA_KF(C_FAR(2 * p + 4), s2); C_DMA_KF(C_FAR(2 * p + 5), s2 + C_KSLOT); }
            f32x16 c[2][2];
#pragma unroll
            for (int u = 0; u < 2; ++u)
#pragma unroll
                for (int r = 0; r < 16; ++r) { c[u][0][r] = 0.f; c[u][1][r] = 0.f; }
#pragma unroll
            for (int j = 0; j < 8; ++j)
#pragma unroll
                for (int u = 0; u < 2; ++u) { const bf16x8 kfj = *(const LAS bf16x8*)(KXA(kp0 + s0 + u * C_KSLOT, j >> 1) + (j & 1) * 4096);
                    c[u][j & 1] = ATT_MFMA(kfj, qr[j >> 1], c[u][j & 1]); }
#pragma unroll
            for (int u = 0; u < 2; ++u) {
                const int trel = C_FAR(2 * p + u);
                const float dmin = (trel < tm) ? (qf - (float)(64 * trel + 63)) : ((float)(64 * trel) - qf);
                badl |= !(fmaxf(max16(c[u][0]), max16(c[u][1])) - slope2 * dmin - m < -150.0f);
            }
            s0 = (s0 == 4 * C_KSLOT) ? 0 : s0 + 2 * C_KSLOT; s2 = (s2 == 4 * C_KSLOT) ? 0 : s2 + 2 * C_KSLOT;
        }
        if (__any(badl) && lane == 0) *badw = 1u;
#undef C_FAR
#undef C_DMA_KF
    }
#undef C_DMA_K
#undef C_DMA_V
#undef C_ROT
#undef C_RESC
#undef C_INIT
#undef C_KLOAD8
#undef KXA
#undef C_ENDW
    float l = xsum32(l_reg);
    const float inv = 1.0f / l;
    ATT_WAIT_BAR(0);
    LAS float* x2 = (LAS float*)shm + rg * 4096;
    if (mp == 1) {
        const float sc = inv * lam;
#pragma unroll
        for (int c = 0; c < 4; ++c)
#pragma unroll
            for (int r = 0; r < 16; ++r) x2[(c * 16 + r) * 64 + lane] = o[c][r] * sc;
    }
    ATT_WAIT_BAR(0);
    if (mp == 0) {
        float ss = 0.f;
#pragma unroll
        for (int c = 0; c < 4; ++c)
#pragma unroll
            for (int r = 0; r < 16; ++r) { const float v = o[c][r] * inv - x2[(c * 16 + r) * 64 + lane]; o[c][r] = v; ss += v * v; }
        ss = xsum32(ss);
        const float rn = post / sqrtf(ss * (1.0f / 128.0f) + RMS_EPS);
        bf16_t* op = MX + (rowbase + q0 + r32) * DM + 512 + h * 128;
#pragma unroll
        for (int c = 0; c < 4; ++c)
#pragma unroll
            for (int g = 0; g < 4; g += 2) { const f32x4 gv0 = *(const GAS f32x4*)(gainv + 32 * c + 8 * g + 4 * hi), gv1 = *(const GAS f32x4*)(gainv + 32 * c + 8 * g + 8 + 4 * hi);
                u32x2 w0, w1;
                w0.x = cvt_pk_bf16(o[c][4 * g + 0] * rn * gv0.x, o[c][4 * g + 1] * rn * gv0.y); w0.y = cvt_pk_bf16(o[c][4 * g + 2] * rn * gv0.z, o[c][4 * g + 3] * rn * gv0.w);
                w1.x = cvt_pk_bf16(o[c][4 * g + 4] * rn * gv1.x, o[c][4 * g + 5] * rn * gv1.y); w1.y = cvt_pk_bf16(o[c][4 * g + 6] * rn * gv1.z, o[c][4 * g + 7] * rn * gv1.w);
                *(GAS u32x4*)(op + 32 * c + 8 * (g + hi)) = pair16(w0, w1); }
    }
    const bool bad = (C_TILE_SKIP == 1) && (*badw != 0u);
    asm volatile("s_waitcnt lgkmcnt(0)\n\ts_barrier" ::: "memory");
    return bad;
}
#undef SBAR
#undef PIN
#undef MX3
#undef EX2
#undef PAF
#undef VRD
#undef VFR
#undef FMAMK

template <int MODE> __device__ __forceinline__ void band_desc(int n, int q0, int& kb, int& ks, int& W) {
    if (MODE == 1) { if (n < 3) { kb = q0 - 1024 + 1024 * n; ks = 16; W = 1024; } else { kb = q0 - 256 + 256 * (n - 3); ks = 4; W = 256; } }
    else if (MODE == 2) { kb = q0 - 64 + 64 * n; ks = 1; W = 64; }
    else { kb = q0 - 128 + 64 * n; ks = 1; W = 128; }
}
constexpr int BK_S = 1056, BV_OFF = 8 * BK_S, BV_S = 4224;
template <int MODE, int NQ>
__device__ __forceinline__ void band_task(const bf16_t* P, size_t rowbase, int kcol, int vcol, int q0, const float (&slope2)[NQ], int qtok,
                                          const bf16_t* const (&qp)[NQ]  , float (&m)[NQ], float (&l)[NQ], f32x16 (&o)[NQ][2], LAS unsigned char* wl, int lane_in) {
    const int lane = lane_id(); (void)lane_in;
    const int r32 = lane & 31, hi = lane >> 5;
    const unsigned kbase_l = (unsigned)(size_t)((lds_cptr)wl + r32 * 128 + ((hi ^ ((r32 >> 1) & 7)) * 16));
    const lds_cptr vp = (lds_cptr)wl + BV_OFF + ((lane >> 4) & 1) * 32 + (lane & 3) * 8 + (4 * hi + ((lane & 15) >> 2)) * 64;
    const unsigned ldsk = (unsigned)(size_t)wl;
    const float qf = (float)qtok;
    constexpr int NTL = MODE == 1 ? 7 : (MODE == 2 ? 3 : 5);
    unsigned mask = 0u;
#pragma unroll
    for (int n = 0; n < NTL; ++n) { int kb, ks, W; band_desc<MODE>(n, q0, kb, ks, W); if (!(kb + ks * 63 < 0 || kb >= SEQ)) mask |= 1u << n; }
    if (!mask) return;
    u32x4 vr[8];
    const int lrow = lane >> 3, lch = lane & 7;
    LAS unsigned char* vw = wl + BV_OFF + (lch >> 2) * BV_S + lrow * 64 + (lch & 3) * 16;
    const bf16_t* kgb = P + rowbase * INW + kcol; const char* vgb = (const char*)(P + rowbase * INW + vcol);
#define BAND_DMAK(n_) do { int kb_, ks_, W_; band_desc<MODE>((n_), q0, kb_, ks_, W_); \
        _Pragma("unroll") for (int i = 0; i < 8; ++i) { const int row_ = lrow + 8 * i; int kt = kb_ + ks_ * row_; kt = kt < 0 ? 0 : (kt > SEQ - 1 ? SEQ - 1 : kt); \
            glds16s(kgb, (unsigned)(kt * INW + ((lch ^ ((row_ >> 1) & 7)) * 8)) * 2u, (unsigned)__builtin_amdgcn_readfirstlane(ldsk + i * 1024)); } } while (0)
#define BAND_LOADV(n_) do { int kb_, ks_, W_; band_desc<MODE>((n_), q0, kb_, ks_, W_); \
        _Pragma("unroll") for (int i = 0; i < 8; ++i) { int kt = kb_ + ks_ * (lrow + 8 * i); kt = kt < 0 ? 0 : (kt > SEQ - 1 ? SEQ - 1 : kt); \
            vr[i] = *(const GAS u32x4*)(vgb + (unsigned)((kt * INW + lch * 8) * 2)); } } while (0)
    bf16x8 qr[4];
    if (NQ == 1) {
#pragma unroll
        for (int d0 = 0; d0 < 4; ++d0) qr[d0] = *(const GAS bf16x8*)(qp[0] + d0 * 16); }
    LDS_WAIT();
    { const int n0 = __builtin_ctz(mask); BAND_DMAK(n0); BAND_LOADV(n0); }
    while (mask) {
        const int n = __builtin_ctz(mask); mask &= mask - 1u;
        const int nn = mask ? __builtin_ctz(mask) : -1;
        int kb, ks, W; band_desc<MODE>(n, q0, kb, ks, W);
        float ksf = (float)ks; asm volatile("" : "+v"(ksf));
        const float dlo = fmaxf(-qf, -(float)W), dhi = fminf((float)W, (float)(SEQ - 1) - qf);
        VM_WAIT();
#pragma unroll
        for (int i = 0; i < 8; ++i) *(LAS u32x4*)(vw + i * 512) = vr[i];
        if (nn >= 0) BAND_LOADV(nn);
        const float dbase = (float)kb - qf + ksf * (float)(4 * hi);
#pragma unroll
        for (int qi = 0; qi < NQ; ++qi) {
            if (NQ > 1) {
#pragma unroll
                for (int d0 = 0; d0 < 4; ++d0) qr[d0] = *(const GAS bf16x8*)(qp[qi] + d0 * 16); }
            f32x16 p0, p1;
#pragma unroll
            for (int r = 0; r < 16; ++r) { p0[r] = 0.f; p1[r] = 0.f; }
#pragma unroll
            for (int d0 = 0; d0 < 4; ++d0) { const lds_cptr ka_ = (lds_cptr)(size_t)(kbase_l ^ (unsigned)(d0 << 5));
                const bf16x8 a0 = *(const LAS bf16x8*)(ka_), a1 = *(const LAS bf16x8*)(ka_ + 4096);
                p0 = ATT_MFMA(a0, qr[d0], p0); p1 = ATT_MFMA(a1, qr[d0], p1);
            }
            if (qi == NQ - 1 && nn >= 0) { LDS_WAIT(); BAND_DMAK(nn); }
#pragma unroll
            for (int r = 0; r < 16; ++r) { const float c = (float)((r & 3) + 8 * (r >> 2));
                const float d0 = __builtin_fmaf(ksf, c, dbase), d1 = __builtin_fmaf(ksf, 32.f + c, dbase);
                p0[r] = (d0 >= dlo && d0 <= dhi) ? __builtin_fmaf(-__builtin_fabsf(d0), slope2[qi], p0[r]) : -INFINITY;
                p1[r] = (d1 >= dlo && d1 <= dhi) ? __builtin_fmaf(-__builtin_fabsf(d1), slope2[qi], p1[r]) : -INFINITY; }
            float mx = fmaxf(max16(p0), max16(p1));
            mx = xmax32(mx);
            if (__any(mx > m[qi] + 8.0f)) {
                const float mn = fmaxf(m[qi], mx), f = __builtin_amdgcn_exp2f(m[qi] - mn);
                l[qi] *= f; m[qi] = mn;
#pragma unroll
                for (int c = 0; c < 2; ++c)
#pragma unroll
                    for (int r = 0; r < 16; ++r) o[qi][c][r] *= f;
            }
#pragma unroll
            for (int r = 0; r < 16; ++r) { p0[r] = __builtin_amdgcn_exp2f(p0[r] - m[qi]); p1[r] = __builtin_amdgcn_exp2f(p1[r] - m[qi]); }
            l[qi] += sum16(p0) + sum16(p1);
            bf16x8 pw[4]; pw[0] = pack8(p0, 0); pw[1] = pack8(p0, 1); pw[2] = pack8(p1, 0); pw[3] = pack8(p1, 1);
#pragma unroll
            for (int c = 0; c < 2; ++c)
#pragma unroll
                for (int s = 0; s < 4; ++s) {
                    const bf16x8 vf = vcat(vtr2(vp + c * BV_S + s * 1024), vtr2(vp + c * BV_S + s * 1024 + 512));
                    o[qi][c] = ATT_MFMA(vf, pw[s], o[qi][c]);
                }
        }
    }
#undef BAND_DMAK
#undef BAND_LOADV
}
__device__ __forceinline__ void band_store(bf16_t* op  , int hi, const f32x16 (&o)[2], float inv) {
#pragma unroll
    for (int c = 0; c < 2; ++c)
#pragma unroll
        for (int g = 0; g < 4; g += 2) { u32x2 w0, w1;
            w0.x = cvt_pk_bf16(o[c][4 * g + 0] * inv, o[c][4 * g + 1] * inv); w0.y = cvt_pk_bf16(o[c][4 * g + 2] * inv, o[c][4 * g + 3] * inv);
            w1.x = cvt_pk_bf16(o[c][4 * g + 4] * inv, o[c][4 * g + 5] * inv); w1.y = cvt_pk_bf16(o[c][4 * g + 6] * inv, o[c][4 * g + 7] * inv);
            *(GAS u32x4*)(op + 32 * c + 8 * (g + hi)) = pair16(w0, w1); }
}
}

template <int DAB, int DC>
__device__ __forceinline__ void p3_attention(Frame& F, int L) {
    const int lane = F.lane, r32 = lane & 31, hi = lane >> 5, wid = F.wave;
    LAS unsigned char* wl = F.lds + wid * BAND_WL;
    for (int rep = 0; rep < DAB; ++rep) {
    for (int bt = F.vcu; bt < NBATCH * 4 * 16; bt += F.G) {
        const int b = bt >> 6, h = (bt >> 4) & 3, blk = bt & 15;
        const float sl1[1] = {__builtin_amdgcn_exp2f(-2.0f * (float)(h + 1)) * LOG2E};
        const size_t rowbase = (size_t)b * SEQ;
        for (int rr = 0; rr < 2; ++rr) {
            const int lane = lane_id(), r32 = lane & 31, hi = lane >> 5;
            const int q0 = blk * 512 + rr * 8 + wid, qtok = q0 + 16 * r32;
            const bf16_t* const qp[1] = {F.PROJ + (rowbase + qtok) * INW + C_QA + h * 64 + hi * 8};
            float m[1] = {-1e30f}, l[1] = {0.f}; f32x16 o[1][2];
#pragma unroll
            for (int c = 0; c < 2; ++c)
#pragma unroll
                for (int r = 0; r < 16; ++r) o[0][c][r] = 0.f;
            att::band_task<1, 1>(F.PROJ, rowbase, C_KA + h * 64, C_VA + h * 64, q0, sl1, qtok, qp, m, l, o, wl, lane);
            float* pp = F.part + ((rowbase + qtok) * 4 + h) * 68;
#pragma unroll
            for (int c = 0; c < 2; ++c)
#pragma unroll
                for (int g = 0; g < 4; ++g) *(GAS f32x4*)(pp + 32 * c + 8 * g + 4 * hi) = (f32x4){o[0][c][4 * g], o[0][c][4 * g + 1], o[0][c][4 * g + 2], o[0][c][4 * g + 3]};
            if (hi == 0) pp[64] = m[0];
            pp[65 + hi] = l[0];
        }
        VM_WAIT(); __syncthreads(); __builtin_amdgcn_fence(__ATOMIC_ACQUIRE, "agent"); VM_WAIT();
        for (int rr = 0; rr < 2; ++rr) {
            const int lane = lane_id(), r32 = lane & 31, hi = lane >> 5;
            const int q0 = blk * 512 + (rr * 8 + wid) * 32, qtok = q0 + r32;
            const bf16_t* const qp[1] = {F.PROJ + (rowbase + qtok) * INW + C_QA + h * 64 + hi * 8};
            const float* pp = F.part + ((rowbase + qtok) * 4 + h) * 68;
            f32x16 o[1][2];
#pragma unroll
            for (int c = 0; c < 2; ++c)
#pragma unroll
                for (int g = 0; g < 4; ++g) { const f32x4 t = *(const GAS f32x4*)(pp + 32 * c + 8 * g + 4 * hi); o[0][c][4 * g] = t[0]; o[0][c][4 * g + 1] = t[1]; o[0][c][4 * g + 2] = t[2]; o[0][c][4 * g + 3] = t[3]; }
            float m[1] = {pp[64]}, l[1] = {pp[65 + hi]};
            att::band_task<2, 1>(F.PROJ, rowbase, C_KA + h * 64, C_VA + h * 64, q0, sl1, qtok, qp, m, l, o, wl, lane);
            att::band_store(F.MIXED + (rowbase + qtok) * DM + h * 64, hi, o[0], 1.0f / att::xsum32(l[0]));
        }
        __syncthreads();
    }
    for (int bt = F.vcu; bt < NBATCH * 2 * 32; bt += F.G) {
        const int b = bt >> 6, hk = (bt >> 5) & 1, blk = bt & 31;
        const size_t rowbase = (size_t)b * SEQ;
        const int lane = lane_id(), r32 = lane & 31, hi = lane >> 5;
        const int q0 = blk * 256 + wid * 32, qtok = q0 + r32;
        float sl2[2], m[2], l[2]; f32x16 o[2][2];
        const bf16_t* const qp[2] = {F.PROJ + (rowbase + qtok) * INW + C_QB + (2 * hk) * 64 + hi * 8, F.PROJ + (rowbase + qtok) * INW + C_QB + (2 * hk + 1) * 64 + hi * 8};
#pragma unroll
        for (int g = 0; g < 2; ++g) { const int hq = 2 * hk + g;
            sl2[g] = __builtin_amdgcn_exp2f(-2.0f * (float)(hq + 1)) * LOG2E;
            m[g] = F.sinks[L * 4 + hq] * LOG2E; l[g] = 0.5f;
#pragma unroll
            for (int c = 0; c < 2; ++c)
#pragma unroll
                for (int r = 0; r < 16; ++r) o[g][c][r] = 0.f; }
        att::band_task<0, 2>(F.PROJ, rowbase, C_KB + hk * 64, C_VB + hk * 64, q0, sl2, qtok, qp, m, l, o, wl, lane);
#pragma unroll
        for (int g = 0; g < 2; ++g) att::band_store(F.MIXED + (rowbase + qtok) * DM + 256 + (2 * hk + g) * 64, hi, o[g], 1.0f / att::xsum32(l[g]));
    }
    }
    VM_WAIT(); LDS_WAIT();
    __syncthreads();
    {
        float lam_init = 0.8f - 0.6f * __expf(-0.3f * (float)L);
        const float s1 = wave_sum(F.lq1[L * 64 + lane] * F.lk1[L * 64 + lane]), s2 = wave_sum(F.lq2[L * 64 + lane] * F.lk2[L * 64 + lane]);
        const float lam = __expf(s1) - __expf(s2) + lam_init;
        for (int rep = 0; rep < DC; ++rep)
        for (int uid = F.vcu; uid < 2048; uid += F.G) {
            const int i = uid >> 8, v = uid & 255, bh = 4 * (v >> 5) + (i >> 1), qb = (i & 1) * 32 + (v & 31), b = bh >> 2, h = bh & 3;
            const float slope2 = __builtin_amdgcn_exp2f(-2.0f * (float)(h + 1)) * LOG2E;
            int T0 = 0, NT = SEQ / 64;
            if (C_TILE_SKIP) {
                const unsigned* nq = (const unsigned*)(F.ctl + CW_NRM + L * 256) + (b * 2 + 0) * 16 + h * 4; const unsigned* nk = nq + 16;
                float R2 = 0.f;
#pragma unroll
                for (int c = 0; c < 2; ++c) R2 = fmaxf(R2, sqrtf(__uint_as_float(nq[c * 2]) * __uint_as_float(nk[c * 2])) + sqrtf(__uint_as_float(nq[c * 2 + 1]) * __uint_as_float(nk[c * 2 + 1])));
                const float Dstar = (C_TILE_SKIP == 1) ? (150.0f + 8.0f + 0.4f * R2) / slope2
                                                       : (120.0f * LOG2E + 2.0f * 1.02f * R2) / slope2;
                if (Dstar < 16384.f) {
                    const int D = (int)Dstar + 1, qlo = qb * 128, qhi = qb * 128 + 127;
                    int tlo = (qlo - D - 63 + 63) / 64; if (qlo - D - 63 <= 0) tlo = 0;
                    int thi = (qhi + D) / 64; if (thi > SEQ / 64 - 1) thi = SEQ / 64 - 1;
                    if (((thi - tlo + 1) & 1) != 0) { if (tlo > 0) --tlo; else ++thi; }
                    if (thi > SEQ / 64 - 1) { thi = SEQ / 64 - 1; if (((thi - tlo + 1) & 1) != 0) --tlo; }
                    if (thi - tlo + 1 >= 4 && tlo >= 0) { T0 = tlo; NT = thi - tlo + 1; }
                }
            }
            volatile LAS unsigned* badw = (volatile LAS unsigned*)(F.misc + MO_HIST);
            const bool bad = att::attnC_unit(F.PROJ, F.MIXED, F.subln + L * 128, b, h, qb, slope2, lam, 1.0f - lam_init, F.lds, wid, lane, T0, NT, badw);
            if (bad) (void)att::attnC_unit(F.PROJ, F.MIXED, F.subln + L * 128, b, h, qb, slope2, lam, 1.0f - lam_init, F.lds, wid, lane, 0, SEQ / 64, badw);
        }
    }
}

struct Args { const float* in[23]; float* out; unsigned char* ws; };
typedef const __attribute__((address_space(4))) Args* kargs_t;
__device__ __forceinline__ void refresh(Frame& F) {
    kargs_t ap = (kargs_t)__builtin_amdgcn_kernarg_segment_ptr(); asm volatile("" : "+s"(ap));
    int w = F.wave0; asm volatile("" : "+s"(w)); int l = lane_id(); asm volatile("" : "+v"(l));
    F.tid = w * 64 + l; F.lane = l; F.wave = w;
    unsigned char* ws = ap->ws;
    F.ctl = (gu32*)(ws + WS_CTL);
    F.x_in = ap->in[0]; F.c_in = ap->in[1]; F.w_ada = ap->in[2]; F.b_ada = ap->in[3]; F.norm1 = ap->in[4]; F.w_in = ap->in[5]; F.sinks = ap->in[6];
    F.lq1 = ap->in[7]; F.lk1 = ap->in[8]; F.lq2 = ap->in[9]; F.lk2 = ap->in[10]; F.subln = ap->in[11]; F.w_out = ap->in[12]; F.norm2 = ap->in[13];
    F.w_router = ap->in[14]; F.b_router = ap->in[15]; F.w_gate = ap->in[16]; F.b_gate = ap->in[17]; F.w_up = ap->in[18]; F.b_up = ap->in[19];
    F.w_down = ap->in[20]; F.b_down = ap->in[21]; F.norm_f = ap->in[22]; F.out = ap->out;
    F.modp = (float*)(ws + WS_MODP); F.mod = (float*)(ws + WS_MOD); F.ltok = (int*)(ws + WS_LTOK); F.lg = (float*)(ws + WS_LG);
    F.WIN = (bf16_t*)(ws + WS_WIN); F.WOUT = (bf16_t*)(ws + WS_WOUT); F.WGU = (bf16_t*)(ws + WS_WGU); F.WDN = (bf16_t*)(ws + WS_WDN);
    F.H = (bf16_t*)(ws + WS_H); F.PROJ = (bf16_t*)(ws + WS_R1); F.MIXED = (bf16_t*)(ws + WS_MIXED); F.HIDDEN = (bf16_t*)(ws + WS_R1); F.Y = (bf16_t*)(ws + WS_Y); F.XB = (bf16_t*)(ws + WS_XB); F.part = (float*)(ws + WS_PART); F.inv = (int*)(ws + WS_INV);
}
__global__ void __launch_bounds__(NTHREADS, 2) fwd_kernel(Args args) {
    extern __shared__ __attribute__((aligned(16))) unsigned char lds[];
    Frame F;
    F.lds = (LAS unsigned char*)lds; F.misc = F.lds + MISC_OFF;
    F.wave0 = __builtin_amdgcn_readfirstlane((int)threadIdx.x >> 6);
    F.G = gridDim.x; { const int bx = blockIdx.x; F.vcu = (F.G % 8 == 0) ? (bx % 8) * (F.G / 8) + bx / 8 : bx; }
    refresh(F);
    for (int u = F.tid; u < 256; u += NTHREADS) ((LAS unsigned*)F.misc)[u] = 0u;
    __syncthreads();
    XcdBarrier bar = xcd_barrier_post((unsigned*)(F.ctl + CW_BAR), (volatile LAS unsigned*)(F.misc + MO_BAR));
    (void)bar;
#define GRID_BAR() do { kargs_t ap_ = (kargs_t)__builtin_amdgcn_kernarg_segment_ptr(); asm volatile("" : "+s"(ap_)); XcdBarrier b_; \
        b_.bar = (unsigned*)(ap_->ws + WS_CTL) + CW_BAR; b_.x = xb_xcc_id(); b_.st = (volatile LAS unsigned*)(F.misc + MO_BAR); xcd_barrier(b_); } while (0)

#ifndef PH_MASK
#define PH_MASK 0xffff
#endif
#define PH(k) ((PH_MASK >> (k)) & 1)
#ifndef DUP_MASK
#define DUP_MASK 0
#endif
#define DUP(k) (1 + ((DUP_MASK >> (k)) & 1))
    if (PH(0)) { for (int rep = 0; rep < DUP(0); ++rep) { p0_prologue(F); __syncthreads(); } GRID_BAR();
    refresh(F); p0b_modsum(F); GRID_BAR(); }
    for (int L = 0; L < DEPTH; ++L) {
        refresh(F);
        if (PH(1)) { if (L == 0) p1_rows<0>(F, L); else p1_rows<1>(F, L); if (DUP(6) > 1) { __syncthreads(); if (L == 0) p1_rows<0>(F, L); else p1_rows<1>(F, L, 0.0f); } }
        const bool own_panels = false;
        if (own_panels) { VM_WAIT(); __syncthreads(); __builtin_amdgcn_fence(__ATOMIC_ACQUIRE, "agent"); VM_WAIT(); } else { GRID_BAR(); }
        refresh(F);
        if (PH(2)) for (int rep = 0; rep < DUP(1); ++rep) { pg8::Gemm g{F.H, F.WIN + (size_t)L * INW * DM, DM}; EpiProj E{F.PROJ, (unsigned*)(F.ctl + CW_NRM + L * 256)};
          if (own_panels) { pg8::PanelOrder S{INW / 256, NTOK / 256, F.G, F.vcu}; pg8::gemm_phase<EpiProj, pg8::PanelOrder, false>(F.lds, g, S, E, F.wave); }
          else { pg8::StaticOrder S; S.init(NTOK, INW, F.G, (int)blockIdx.x); pg8::gemm_phase<EpiProj, pg8::StaticOrder, false>(F.lds, g, S, E, F.wave); } }
        GRID_BAR();
        refresh(F);
        if (PH(3)) p3_attention<DUP(2), DUP(3)>(F, L);
        GRID_BAR();
        refresh(F);
        const bool own_panels4 = (F.G == NTOK / 256);
        if (PH(4)) for (int rep = 0; rep < DUP(7); ++rep) { pg8::Gemm g{F.MIXED, F.WOUT + (size_t)L * DM * DM, DM}; EpiOut E{F.XB, F.mod + (size_t)L * NBATCH * 6144 + 2 * DM, rep ? 0.0f : 1.0f};
          if (own_panels4) { pg8::PanelOrder S{DM / 256, NTOK / 256, F.G, F.vcu}; pg8::gemm_phase<EpiOut, pg8::PanelOrder, false>(F.lds, g, S, E, F.wave); }
          else { pg8::StaticOrder S; S.init(NTOK, DM, F.G, (int)blockIdx.x); pg8::gemm_phase<EpiOut, pg8::StaticOrder, false>(F.lds, g, S, E, F.wave); } }
        if (own_panels4) { VM_WAIT(); __syncthreads(); __builtin_amdgcn_fence(__ATOMIC_ACQUIRE, "agent"); VM_WAIT(); } else { GRID_BAR(); }
        refresh(F);
        if (PH(5)) { p5_route(F, L, L); if (DUP(8) > 1) { __syncthreads(); p5_route(F, L, L + 4); } }
        GRID_BAR();
        refresh(F);
        moe_table(F, L);
        if (PH(7)) for (int rep = 0; rep < DUP(4); ++rep) { const LAS int* tab = (const LAS int*)(F.misc + MO_TAB);
          pg8::Gemm g{F.H, (const bf16_t*)((const unsigned char*)F.WGU + (size_t)L * NE * 2048 * DM), DM / 2}; MoeSched S{tab, 3, tab[96], F.G, F.vcu, F.ltok};
          EpiGU E{(unsigned char*)F.HIDDEN, F.b_gate + (size_t)L * NE * DM, F.b_up + (size_t)L * NE * DM};
          pg8::gemm_phase<EpiGU, MoeSched, true, true>(F.lds, g, S, E, F.wave); }
        GRID_BAR();
        refresh(F);
        if (PH(8)) for (int rep = 0; rep < DUP(5); ++rep) { const LAS int* tab = (const LAS int*)(F.misc + MO_TAB);
          pg8::Gemm g{F.HIDDEN, (const bf16_t*)((const unsigned char*)F.WDN + (size_t)L * NE * DM * DM), DM / 2}; MoeSched S{tab, 2, tab[96], F.G, F.vcu, F.ltok};
          EpiDown E{(unsigned char*)F.Y, F.b_down + (size_t)L * NE * DM, tab, F.lg, F.misc + EPI_STG};
          pg8::gemm_phase<EpiDown, MoeSched, false, true>(F.lds, g, S, E, F.wave); }
        GRID_BAR();
    }
    refresh(F);
    if (PH(9)) p1_rows<2>(F, DEPTH);
}

extern "C" void kernel_launch(void* const* d_in, const int* in_sizes, int n_in, void* d_out, int out_size, void* d_ws, size_t ws_size, hipStream_t stream) {
    static int grid = 0;
    if (grid == 0) {
        if (n_in != 23 || in_sizes[0] != NTOK * DM || out_size != NTOK * DM || ws_size < WS_END) {
            fprintf(stderr, "kernel_launch: unexpected shapes/workspace: n_in %d in0 %d out %d ws %zu (need %zu); nothing launched\n", n_in, n_in > 0 ? in_sizes[0] : -1, out_size, ws_size, (size_t)WS_END); grid = -1; return; }
        int dev = 0, cus = 0, per_cu = 0;
        if (hipGetDevice(&dev) != hipSuccess || hipDeviceGetAttribute(&cus, hipDeviceAttributeMultiprocessorCount, dev) != hipSuccess) { grid = -1; return; }
        if (hipFuncSetAttribute((const void*)fwd_kernel, hipFuncAttributeMaxDynamicSharedMemorySize, LDS_BYTES) != hipSuccess) { fprintf(stderr, "kernel_launch: hipFuncSetAttribute failed\n"); grid = -1; return; }
        if (hipOccupancyMaxActiveBlocksPerMultiprocessor(&per_cu, (const void*)fwd_kernel, NTHREADS, LDS_BYTES) != hipSuccess || per_cu < 1)
            fprintf(stderr, "kernel_launch: note: occupancy query reports %d workgroups per CU\n", per_cu);
        (void)hipGetLastError();
        grid = cus;
    }
    if (grid < 0) return;
    if (hipMemsetAsync((char*)d_ws + WS_CTL, 0, CTL_ZERO_BYTES, stream) != hipSuccess) return;
    Args a{};
    for (int i = 0; i < 23; ++i) a.in[i] = (const float*)d_in[i];
    a.out = (float*)d_out; a.ws = (unsigned char*)d_ws;
    hipLaunchKernelGGL(fwd_kernel, dim3(grid), dim3(NTHREADS), LDS_BYTES, stream, a);
}
```

```cpp
#include <hip/hip_runtime.h>
#include <cstdio>
#include <cstdint>

#define LAS __attribute__((address_space(3)))
#define GAS __attribute__((address_space(1)))
typedef unsigned short bf16_t;
typedef short bf16x8 __attribute__((ext_vector_type(8)));
typedef short s16x4 __attribute__((ext_vector_type(4)));
typedef float f32x4 __attribute__((ext_vector_type(4)));
typedef float f32x2 __attribute__((ext_vector_type(2)));
typedef float f32x16 __attribute__((ext_vector_type(16)));
typedef unsigned u32x4 __attribute__((ext_vector_type(4)));
typedef unsigned u32x2 __attribute__((ext_vector_type(2)));
typedef GAS unsigned gu32;

constexpr int NBATCH = 8, SEQ = 8192, DM = 1024, NTOK = NBATCH * SEQ, DEPTH = 4;
constexpr int INW = 2816;
constexpr int C_QA = 0, C_KA = 256, C_VA = 512, C_QB = 768, C_KB = 1024, C_VB = 1152, C_QC = 1280, C_KC = 1792, C_VC = 2304;
constexpr int NE = 32, TOPK = 4, LCAP = NTOK;
constexpr float RMS_EPS = 1e-6f;
constexpr float LOG2E = 1.4426950408889634f;
constexpr float QSCALE = 0.125f * LOG2E;
constexpr int NWAVES = 8, NTHREADS = 512;
#ifndef C_TILE_SKIP
#define C_TILE_SKIP 1
#endif
constexpr int CW_NRM = 16384;

constexpr size_t MiB = 1u << 20;
constexpr size_t WS_CTL = 0, CTL_ZERO_BYTES = 1 * MiB;
constexpr size_t WS_MODP = 1 * MiB;
constexpr size_t WS_MOD = 4 * MiB;
constexpr size_t WS_LTOK = 5 * MiB;
constexpr size_t WS_LG = 13 * MiB;
constexpr size_t WS_WIN = 21 * MiB;
constexpr size_t WS_WOUT = 43 * MiB;
constexpr size_t WS_WGU = 51 * MiB;
constexpr size_t WS_WDN = 563 * MiB;
constexpr size_t WS_H = 819 * MiB;
constexpr size_t WS_R1 = 947 * MiB;
constexpr size_t WS_MIXED = WS_R1 + 352 * MiB;
constexpr size_t WS_Y = 1475 * MiB;
constexpr size_t WS_INV = WS_MODP;
constexpr size_t WS_XB = WS_Y + 264 * MiB;
constexpr size_t WS_PART = WS_XB + 128 * MiB;
constexpr size_t WS_END = 1987 * MiB;
static_assert(WS_PART + (size_t)NTOK * 4 * 68 * 4 <= WS_END, "d_ws map");
constexpr int CW_TMO = 0, CW_CODE = 1, CW_BAR = 4096, CW_CNT = 8192;

constexpr int RING_BYTES = 131072;
constexpr int BAND_WL = 16896;
constexpr int MISC_OFF = 8 * BAND_WL;
constexpr int EPI_STG = 1024, EPI_STG_ROW = 144, EPI_STG_GRP = 64 * EPI_STG_ROW;
constexpr int LDS_BYTES = MISC_OFF + EPI_STG + 2 * EPI_STG_GRP;
constexpr int MO_BAR = 0, MO_HIST = 64, MO_BASE = 192, MO_TAB = 320, MO_SELE = 1024, MO_SELG = 5120;

#define RLX_AGENT __ATOMIC_RELAXED, __HIP_MEMORY_SCOPE_AGENT
#define LDS_WAIT() asm volatile("s_waitcnt lgkmcnt(0)" ::: "memory")
#define VM_WAIT() asm volatile("s_waitcnt vmcnt(0)" ::: "memory")
__device__ __forceinline__ unsigned cvt_pk_bf16(float lo, float hi) { unsigned r; asm volatile("v_cvt_pk_bf16_f32 %0, %1, %2" : "=v"(r) : "v"(lo), "v"(hi)); return r; }
__device__ __forceinline__ unsigned f2bf(float f) { unsigned u = __builtin_bit_cast(unsigned, f); return (u + 0x7fffu + ((u >> 16) & 1u)) >> 16; }
__device__ __forceinline__ unsigned pk2(float lo, float hi) { return f2bf(lo) | (f2bf(hi) << 16); }
typedef int i32x8 __attribute__((ext_vector_type(8)));
typedef int i32x4 __attribute__((ext_vector_type(4)));
__device__ __forceinline__ unsigned pk4_fp8_nc(float a, float b, float c, float d) {
    unsigned w = 0u; w = (unsigned)__builtin_amdgcn_cvt_pk_fp8_f32(a, b, (int)w, false); w = (unsigned)__builtin_amdgcn_cvt_pk_fp8_f32(c, d, (int)w, true); return w;
}
__device__ __forceinline__ unsigned pk4_fp8(float a, float b, float c, float d) {
    a = fminf(fmaxf(a, -448.f), 448.f); b = fminf(fmaxf(b, -448.f), 448.f); c = fminf(fmaxf(c, -448.f), 448.f); d = fminf(fmaxf(d, -448.f), 448.f);
    unsigned w = 0u; w = (unsigned)__builtin_amdgcn_cvt_pk_fp8_f32(a, b, (int)w, false); w = (unsigned)__builtin_amdgcn_cvt_pk_fp8_f32(c, d, (int)w, true); return w;
}
constexpr float W8_SCALE = 64.f, H8_SCALE = 8.f, HID8_SCALE = 4.f, Y8_SCALE = 64.f;
__device__ __forceinline__ float bf_lo(unsigned u) { return __builtin_bit_cast(float, u << 16); }
__device__ __forceinline__ float bf_hi(unsigned u) { return __builtin_bit_cast(float, u & 0xffff0000u); }
__device__ __forceinline__ int lane_id() { unsigned ones = ~0u; asm volatile("" : "+s"(ones)); return (int)__builtin_amdgcn_mbcnt_hi(ones, __builtin_amdgcn_mbcnt_lo(ones, 0u)); }
template <int CTRL> __device__ __forceinline__ float dpp_mov(float v) { return __builtin_bit_cast(float, __builtin_amdgcn_update_dpp(0, __builtin_bit_cast(int, v), CTRL, 0xf, 0xf, true)); }
__device__ __forceinline__ float row16_sum(float v) { v += dpp_mov<0xB1>(v); v += dpp_mov<0x4E>(v); v += dpp_mov<0x141>(v); v += dpp_mov<0x140>(v); return v; }
__device__ __forceinline__ float row16_max(float v) { v = fmaxf(v, dpp_mov<0xB1>(v)); v = fmaxf(v, dpp_mov<0x4E>(v)); v = fmaxf(v, dpp_mov<0x141>(v)); v = fmaxf(v, dpp_mov<0x140>(v)); return v; }
__device__ __forceinline__ float x16_sum(float v) { const auto r = __builtin_amdgcn_permlane16_swap(__float_as_uint(v), __float_as_uint(v), false, false); return __uint_as_float(r[0]) + __uint_as_float(r[1]); }
__device__ __forceinline__ float x32_sum(float v) { const auto r = __builtin_amdgcn_permlane32_swap(__float_as_uint(v), __float_as_uint(v), false, false); return __uint_as_float(r[0]) + __uint_as_float(r[1]); }
__device__ __forceinline__ float wave_sum(float v) { return x32_sum(x16_sum(row16_sum(v))); }

#define XB_TMO      128
#define XB_XCNT(j)  (256  + 64 * (j))
#define XB_XSUB(j)  (1280 + 64 * (j))
#define XB_XGEN(j)  (2304 + 64 * (j))
#define XB_TOP      3328
#define XB_TOPGEN   3392
#define XCD_BAR_WORDS 3456
#define XB_SPIN_CAP (1u << 20)

__device__ __forceinline__ unsigned xb_ld(unsigned* p)              { return __hip_atomic_load(p, __ATOMIC_RELAXED, __HIP_MEMORY_SCOPE_AGENT); }
__device__ __forceinline__ unsigned xb_add(unsigned* p, unsigned v) { return __hip_atomic_fetch_add(p, v, __ATOMIC_RELAXED, __HIP_MEMORY_SCOPE_AGENT); }
__device__ __forceinline__ unsigned xb_xcc_id() { return (unsigned)__builtin_amdgcn_s_getreg((3 << 11) | 20) & 0xFu; }
#define XB_SPIN(cond, bar) do { unsigned _sp = 0; while (cond) { __builtin_amdgcn_s_sleep(1); \
    if ((++_sp & 255u) == 0u) { if (xb_ld(&(bar)[XB_TMO])) break; if (_sp > XB_SPIN_CAP) { atomicAdd(&(bar)[XB_TMO], 1u); break; } } } } while (0)

struct XcdBarrier { unsigned* bar; unsigned x; volatile LAS unsigned* st; };
__device__ __forceinline__ XcdBarrier xcd_barrier_post(unsigned* bar, volatile LAS unsigned* st) {
    XcdBarrier b; b.bar = bar; b.x = xb_xcc_id(); b.st = st;
    if (threadIdx.x == 0) (void)xb_add(&bar[XB_XCNT(b.x)], 1u);
    return b;
}
__device__ __forceinline__ void xcd_barrier_complete(unsigned* bar, unsigned x, unsigned& nloc, unsigned& nx) {
    const unsigned G = gridDim.x * gridDim.y * gridDim.z;
    unsigned sum, cnt, mine, sp = 0u;
    for (;;) {
        sum = 0u; cnt = 0u; mine = 0u;
#pragma unroll
        for (unsigned j = 0; j < 16; ++j) { const unsigned c = xb_ld(&bar[XB_XCNT(j)]); sum += c; cnt += (c > 0u) ? 1u : 0u; mine = (j == x) ? c : mine; }
        if (sum == G) break;
        __builtin_amdgcn_s_sleep(1);
        if ((++sp & 255u) == 0u) { if (xb_ld(&bar[XB_TMO])) break; if (sp > XB_SPIN_CAP) { atomicAdd(&bar[XB_TMO], 1u); break; } }
    }
    nloc = mine > 0u ? mine : 1u; nx = cnt > 0u ? cnt : 1u;
}
__device__ __forceinline__ void xcd_barrier(const XcdBarrier& b) {
    asm volatile("s_waitcnt vmcnt(0)" ::: "memory");
    __syncthreads();
    if (threadIdx.x == 0) {
        unsigned* bar = b.bar;
        __builtin_amdgcn_s_waitcnt(0);
        unsigned nloc = b.st[0], nx = b.st[1];
        if (nloc == 0u) { xcd_barrier_complete(bar, b.x, nloc, nx); b.st[0] = nloc; b.st[1] = nx; }
        const unsigned old = xb_add(&bar[XB_XSUB(b.x)], 1u);
        const unsigned gen = old / nloc;
        if (old + 1u == (gen + 1u) * nloc) {
            __builtin_amdgcn_fence(__ATOMIC_RELEASE, "agent");
            asm volatile("s_waitcnt vmcnt(0)" ::: "memory");
            const unsigned og = xb_add(&bar[XB_TOP], 1u);
            const unsigned tg = og / nx;
            if (og + 1u == (tg + 1u) * nx) xb_add(&bar[XB_TOPGEN], 1u);
            else XB_SPIN(xb_ld(&bar[XB_TOPGEN]) == tg, bar);
            __builtin_amdgcn_fence(__ATOMIC_ACQUIRE, "agent");
            xb_add(&bar[XB_XGEN(b.x)], 1u);
            asm volatile("s_waitcnt vmcnt(0)" ::: "memory");
        } else {
            XB_SPIN(xb_ld(&bar[XB_XGEN(b.x)]) == gen, bar);
            __builtin_amdgcn_fence(__ATOMIC_ACQUIRE, "agent");
            asm volatile("s_waitcnt vmcnt(0)" ::: "memory");
        }
    }
    __syncthreads();
}

__device__ __forceinline__ unsigned ld_untracked(const void* p) { unsigned v; asm volatile("global_load_dword %0, %1, off" : "=v"(v) : "v"(p) : "memory"); return v; }
namespace pg8 {
constexpr int BM = 256, BK = 64, HALF = 128, HTB = HALF * BK * 2, STAGE_BYTES = 8 * HTB, NXCD = 8, WGM = 8;
__host__ __device__ __forceinline__ int lds_byte(int r, int c) { const int st = (r >> 4) * 2 + (c >> 5), rr = r & 15, cc = c & 31, ob = rr * 64 + cc * 2; return st * 1024 + (ob ^ (((ob >> 9) & 1) << 5)); }
__host__ __device__ __forceinline__ void stage_rc(int b, int& R, int& C) { const int st = b / 1024, sb = b % 1024, swz = sb ^ (((sb >> 9) & 1) << 5); R = (st >> 1) * 16 + swz / 64; C = (st & 1) * 32 + (swz % 64) / 2; }
__host__ __device__ __forceinline__ int perm32(int rho) { const int n = rho >> 4, i = rho & 15; return 8 * (i >> 2) + 4 * n + (i & 3); }

struct Unit { int pm, pn; };
struct Gemm { const bf16_t* A; const bf16_t* Bt; int K; };

struct StaticOrder {
    int nM, nN, nwg, G, c;
    __device__ void init(int M, int N, int G_, int c_) { nM = M / BM; nN = N / BM; nwg = nM * nN; G = G_; c = c_; }
    __device__ bool next(int i, Unit& u) const {
        const long L = (long)i * G + c; if (L >= nwg) return false;
        int wgid = (int)L; { const int q = nwg / NXCD, r = nwg % NXCD, xcd = wgid % NXCD, off = wgid / NXCD; wgid = (xcd < r ? xcd * (q + 1) : r * (q + 1) + (xcd - r) * q) + off; }
        const int nig = WGM * nN, gid = wgid / nig, fm = gid * WGM, gsz = (nM - fm) < WGM ? (nM - fm) : WGM;
        u.pm = fm + ((wgid % nig) % gsz); u.pn = (wgid % nig) / gsz; return true;
    }
    __device__ __forceinline__ unsigned arow(const Unit&, int) const { return 0u; }
    __device__ __forceinline__ unsigned arow_raw(const Unit&, int) const { return 0u; }
};

struct PanelOrder {
    int nN, nP, G, vcu;
    __device__ bool next(int i, Unit& u) const { const int p = vcu + (i / nN) * G; if (p >= nP) return false; u.pm = p; u.pn = i % nN; return true; }
    __device__ __forceinline__ unsigned arow(const Unit&, int) const { return 0u; }
    __device__ __forceinline__ unsigned arow_raw(const Unit&, int) const { return 0u; }
};
template <int N> __device__ __forceinline__ void wait_v() { asm volatile("s_waitcnt vmcnt(%0)" :: "n"(N) : "memory"); }
template <class Epi, class Sched, bool GATHER, bool FP8 = false>
__device__ __forceinline__ void gemm_phase(LAS unsigned char* lds, const Gemm g, const Sched& S, const Epi& E, int wave_in) {
    int tid_ = wave_in * 64 + lane_id(); asm volatile("" : "+v"(tid_));
    const int tid = tid_, wid = __builtin_amdgcn_readfirstlane(tid >> 6), lane = tid & 63, wr = wid >> 2, wc = wid & 3, fr = lane & 15, fq = lane >> 4;
    int K_ = g.K; asm volatile("" : "+s"(K_));
    const int K = K_, nt = K / BK;
    unsigned voffA[2], voffB[2]; int Rr[2], Cb[2];
#pragma unroll
    for (int i = 0; i < 2; ++i) { int R, C; stage_rc(tid * 16 + i * 8192, R, C); const int Rb = Epi::PERM ? ((R & ~31) + perm32(R & 31)) : R;
        Rr[i] = R; Cb[i] = C * 2; voffA[i] = (unsigned)(R * K + C) * 2u; voffB[i] = (unsigned)(Rb * K + C) * 2u; }
    const size_t kstep = (size_t)(BK * 2);
    const size_t hstep = (size_t)HALF * K * 2;
    const size_t tstep = 2 * hstep;
    const unsigned ldsw = (unsigned)wid * 1024u;
    const int aoff = lds_byte(wr * 64 + fr, fq * 8), boff = lds_byte(wc * 32 + fr, fq * 8);
#define PG8_SA(b, h) (((b) * 2 + (h)) * HTB)
#define PG8_SB(b, h) ((4 + (b) * 2 + (h)) * HTB)
#define PG8_STAGE(bufoff, gbase, voff) do { _Pragma("unroll") for (int _i = 0; _i < 2; ++_i) \
        __builtin_amdgcn_global_load_lds((const unsigned*)((const char*)(gbase) + (voff)[_i]), (LAS unsigned*)(lds + (bufoff) + ldsw + _i * 8192), 16, 0, 0); } while (0)
#define PG8_STGA(b, h, base, vs) do { if constexpr (GATHER) { PG8_STAGE(PG8_SA(b, h), (base), vs[h]); } else { PG8_STAGE(PG8_SA(b, h), (base) + (h) * hstep, voffA); } } while (0)
#define PG8_LDA(dst, b, h) do { _Pragma("unroll") for (int m = 0; m < 4; ++m) _Pragma("unroll") for (int k = 0; k < 2; ++k) dst[m][k] = *(const LAS bf16x8*)(lds + PG8_SA(b, h) + aoff + m * 2048 + k * 1024); } while (0)
#define PG8_LDB(dst, b, h) do { _Pragma("unroll") for (int n = 0; n < 2; ++n) _Pragma("unroll") for (int k = 0; k < 2; ++k) dst[n][k] = *(const LAS bf16x8*)(lds + PG8_SB(b, h) + boff + n * 2048 + k * 1024); } while (0)
#define PG8_CAT(x, y) __builtin_shufflevector(__builtin_bit_cast(i32x4, (x)), __builtin_bit_cast(i32x4, (y)), 0, 1, 2, 3, 4, 5, 6, 7)
#define PG8_MMA(ai, bj, At, Bt) do { __builtin_amdgcn_s_setprio(1); \
        if constexpr (FP8) { _Pragma("unroll") for (int m = 0; m < 4; ++m) _Pragma("unroll") for (int n = 0; n < 2; ++n) \
            { const i32x8 a8_ = PG8_CAT(Bt[n][0], Bt[n][1]), b8_ = PG8_CAT(At[m][0], At[m][1]); \
              asm volatile("v_mfma_scale_f32_16x16x128_f8f6f4 %0, %1, %2, %0, %3, %3 op_sel_hi:[0,0,0]" : "+v"(acc[ai][bj][m][n]) : "v"(a8_), "v"(b8_), "v"(one8)); } } \
        else { _Pragma("unroll") for (int m = 0; m < 4; ++m) _Pragma("unroll") for (int n = 0; n < 2; ++n) _Pragma("unroll") for (int k = 0; k < 2; ++k) \
            acc[ai][bj][m][n] = __builtin_amdgcn_mfma_f32_16x16x32_bf16(Bt[n][k], At[m][k], acc[ai][bj][m][n], 0, 0, 0); } \
        __builtin_amdgcn_s_setprio(0); } while (0)
#define PG8_PIECE(bufoff, gbase, voff, i) __builtin_amdgcn_global_load_lds((const unsigned*)((const char*)(gbase) + (voff)[i]), (LAS unsigned*)(lds + (bufoff) + ldsw + (i) * 8192), 16, 0, 0)
#define PG8_PCA(b, h, base, vs, i) do { if constexpr (GATHER) { PG8_PIECE(PG8_SA(b, h), (base), vs[h], i); } else { PG8_PIECE(PG8_SA(b, h), (base) + (h) * hstep, voffA, i); } PG8_SCHED; } while (0)
#define PG8_PCB(b, h, base, i) do { PG8_PIECE(PG8_SB(b, h), (base) + (h) * hstep, voffB, i); PG8_SCHED; } while (0)
#define PG8_MMAH(ai, bj, At, Bt, HK) do { __builtin_amdgcn_s_setprio(1); \
        if constexpr (FP8) { _Pragma("unroll") for (int m = 0; m < 4; ++m) _Pragma("unroll") for (int n = 0; n < 2; ++n) \
            { const i32x8 a8_ = PG8_CAT(Bt[n][0], Bt[n][1]), b8_ = PG8_CAT(At[m][0], At[m][1]); \
              asm volatile("v_mfma_scale_f32_16x16x128_f8f6f4 %0, %1, %2, %0, %3, %3 op_sel_hi:[0,0,0]" : "+v"(acc[ai][bj][m][n]) : "v"(a8_), "v"(b8_), "v"(one8)); HK(m * 2 + n); } } \
        else { _Pragma("unroll") for (int k = 0; k < 2; ++k) _Pragma("unroll") for (int m = 0; m < 4; ++m) { _Pragma("unroll") for (int n = 0; n < 2; ++n) \
            acc[ai][bj][m][n] = __builtin_amdgcn_mfma_f32_16x16x32_bf16(Bt[n][k], At[m][k], acc[ai][bj][m][n], 0, 0, 0); HK(k * 4 + m); } } \
        __builtin_amdgcn_s_setprio(0); } while (0)
#define PG8_WAIT_V(n) asm volatile("s_waitcnt vmcnt(" #n ")" ::: "memory")
#define PG8_WAIT_L(n) asm volatile("s_waitcnt lgkmcnt(" #n ")" ::: "memory")
#define PG8_BAR __builtin_amdgcn_s_barrier()
#define PG8_SCHED __builtin_amdgcn_sched_barrier(0)
    Unit cur, nxt; int ui = 0;
    if (!S.next(0, cur)) return;
    int one8 = 0x7f7f7f7f; asm volatile("" : "+v"(one8));
    f32x4 acc[2][2][4][2];
#pragma unroll
    for (int a = 0; a < 2; ++a)
#pragma unroll
        for (int b = 0; b < 2; ++b)
#pragma unroll
            for (int m = 0; m < 4; ++m)
#pragma unroll
                for (int n = 0; n < 2; ++n) acc[a][b][m][n] = (f32x4){0.f, 0.f, 0.f, 0.f};
    bf16x8 At[4][2], B0[2][2], B1[2][2];
    unsigned vc[2][2], vn[2][2], v2[2][2];
#pragma unroll
    for (int h = 0; h < 2; ++h)
#pragma unroll
        for (int i = 0; i < 2; ++i) { vc[h][i] = GATHER ? S.arow(cur, h * HALF + Rr[i]) * (unsigned)(K * 2) + (unsigned)Cb[i] : 0u; vn[h][i] = vc[h][i]; v2[h][i] = vc[h][i]; }
    const char* cA = GATHER ? (const char*)g.A : (const char*)g.A + (size_t)cur.pm * tstep; const char* cB = (const char*)g.Bt + (size_t)cur.pn * tstep;
    PG8_STAGE(PG8_SB(0, 0), cB, voffB); PG8_STAGE(PG8_SB(0, 1), cB + hstep, voffB); PG8_STGA(0, 0, cA, vc); PG8_STGA(0, 1, cA, vc);
    if (wr == 1) PG8_BAR;
    PG8_WAIT_V(2); PG8_BAR;
    constexpr bool PEEL = FP8;
    PG8_STAGE(PG8_SB(1, 0), cB + kstep, voffB); PG8_STGA(1, 0, cA + kstep, vc); PG8_STAGE(PG8_SB(1, 1), cB + hstep + kstep, voffB);
    PG8_STGA(1, 1, cA + kstep, vc); PG8_WAIT_V(8);
    PG8_BAR;
    constexpr int XW = Epi::NVM + Epi::NPRE + (GATHER ? 4 : 0);
    { LAS unsigned* dump = (LAS unsigned*)(lds + STAGE_BYTES + (unsigned)wave_in * 256u);
#pragma unroll
      for (int s_ = 0; s_ < Epi::NVM; ++s_) __builtin_amdgcn_global_load_lds((const unsigned*)g.Bt, dump, 4, 0, 0); }
#define PG8_ITER(FIRST) do { \
            const bool last = !(FIRST) && (t == nt - 2); \
            const char* a1 = cA + (size_t)(t + 1) * kstep; \
            const char* a2 = last ? nA : cA + (size_t)(t + 2) * kstep; const char* b2 = last ? nB : cB + (size_t)(t + 2) * kstep; \
            const char* a3 = a2 + kstep; const char* b3 = b2 + kstep; \
            if (GATHER) { \
                _Pragma("unroll") for (int h = 0; h < 2; ++h) _Pragma("unroll") for (int i = 0; i < 2; ++i) v2[h][i] = last ? vn[h][i] : vc[h][i]; \
            } \
              \
            PG8_LDB(B0, 0, 0); PG8_LDB(B1, 0, 1); PG8_SCHED; PG8_LDA(At, 0, 0); if (!(FIRST)) PG8_STGA(1, 1, a1, vc); \
            if (FIRST) wait_v<8 + XW>(); else wait_v<8>(); PG8_WAIT_L(0); PG8_BAR; PG8_MMA(0, 0, At, B0); PG8_MMA(0, 1, At, B1); PG8_BAR; PG8_SCHED; \
              \
            PG8_LDA(At, 0, 1); PG8_STAGE(PG8_SB(0, 0), b2, voffB); PG8_STAGE(PG8_SB(0, 1), b2 + hstep, voffB); PG8_STGA(0, 0, a2, v2); \
            if (FIRST) wait_v<8 + XW>(); else wait_v<8>(); PG8_WAIT_L(0); PG8_BAR; PG8_MMA(1, 0, At, B0); PG8_MMA(1, 1, At, B1); PG8_BAR; PG8_SCHED; \
              \
            PG8_LDB(B0, 1, 0); PG8_LDB(B1, 1, 1); PG8_SCHED; PG8_LDA(At, 1, 0); PG8_STGA(0, 1, a2, v2); \
            if (FIRST) wait_v<8 + XW>(); else wait_v<8>(); PG8_WAIT_L(0); PG8_BAR; PG8_MMA(0, 0, At, B0); PG8_MMA(0, 1, At, B1); PG8_BAR; PG8_SCHED; \
              \
            PG8_LDA(At, 1, 1); PG8_STAGE(PG8_SB(1, 0), b3, voffB); PG8_STAGE(PG8_SB(1, 1), b3 + hstep, voffB); PG8_STGA(1, 0, a3, v2); \
            PG8_WAIT_V(8); PG8_WAIT_L(0); PG8_BAR; PG8_MMA(1, 0, At, B0); PG8_MMA(1, 1, At, B1); PG8_BAR; PG8_SCHED; \
        } while (0)
#define PG8_H1A(j) if ((j) == 3 && !(FIRST_)) PG8_PCA(1, 1, a1, vc, 0)
#define PG8_H1B(j) if ((j) == 3 && !(FIRST_)) PG8_PCA(1, 1, a1, vc, 1)
#define PG8_H2A(j) if ((j) == 1) PG8_PCB(0, 0, b2, 0); else if ((j) == 3) PG8_PCB(0, 0, b2, 1); else if ((j) == 5) PG8_PCB(0, 1, b2, 0)
#define PG8_H2B(j) if ((j) == 1) PG8_PCB(0, 1, b2, 1); else if ((j) == 3) PG8_PCA(0, 0, a2, v2, 0); else if ((j) == 5) PG8_PCA(0, 0, a2, v2, 1)
#define PG8_H3A(j) if ((j) == 3) PG8_PCA(0, 1, a2, v2, 0)
#define PG8_H3B(j) if ((j) == 3) PG8_PCA(0, 1, a2, v2, 1)
#define PG8_H4A(j) if ((j) == 1) PG8_PCB(1, 0, b3, 0); else if ((j) == 3) PG8_PCB(1, 0, b3, 1); else if ((j) == 5) PG8_PCB(1, 1, b3, 0)
#define PG8_H4B(j) if ((j) == 1) PG8_PCB(1, 1, b3, 1); else if ((j) == 3) PG8_PCA(1, 0, a3, v2, 0); else if ((j) == 5) PG8_PCA(1, 0, a3, v2, 1)
#define PG8_ITER2(FIRST) do { \
            const bool FIRST_ = (FIRST); \
            const bool last = !(FIRST) && (t == nt - 2); \
            const char* a1 = cA + (size_t)(t + 1) * kstep; \
            const char* a2 = last ? nA : cA + (size_t)(t + 2) * kstep; const char* b2 = last ? nB : cB + (size_t)(t + 2) * kstep; \
            const char* a3 = a2 + kstep; const char* b3 = b2 + kstep; \
            if (GATHER) { \
                _Pragma("unroll") for (int h = 0; h < 2; ++h) _Pragma("unroll") for (int i = 0; i < 2; ++i) v2[h][i] = last ? vn[h][i] : vc[h][i]; \
            } \
            PG8_LDB(B0, 0, 0); PG8_LDB(B1, 0, 1); PG8_SCHED; PG8_LDA(At, 0, 0); \
            if (FIRST) wait_v<8 + XW>(); else wait_v<6>(); PG8_WAIT_L(0); PG8_BAR; PG8_MMAH(0, 0, At, B0, PG8_H1A); PG8_MMAH(0, 1, At, B1, PG8_H1B); PG8_BAR; PG8_SCHED; \
            PG8_LDA(At, 0, 1); \
            if (FIRST) wait_v<2 + XW>(); else wait_v<2>(); PG8_WAIT_L(0); PG8_BAR; PG8_MMAH(1, 0, At, B0, PG8_H2A); PG8_MMAH(1, 1, At, B1, PG8_H2B); PG8_BAR; PG8_SCHED; \
            PG8_LDB(B0, 1, 0); PG8_LDB(B1, 1, 1); PG8_SCHED; PG8_LDA(At, 1, 0); \
            if (FIRST) wait_v<6 + XW>(); else wait_v<6>(); PG8_WAIT_L(0); PG8_BAR; PG8_MMAH(0, 0, At, B0, PG8_H3A); PG8_MMAH(0, 1, At, B1, PG8_H3B); PG8_BAR; PG8_SCHED; \
            PG8_LDA(At, 1, 1); \
            wait_v<2>(); PG8_WAIT_L(0); PG8_BAR; PG8_MMAH(1, 0, At, B0, PG8_H4A); PG8_MMAH(1, 1, At, B1, PG8_H4B); PG8_BAR; PG8_SCHED; \
        } while (0)
    constexpr bool MD = FP8;
#define PG8_IT(FIRST) do { if constexpr (MD) PG8_ITER2(FIRST); else PG8_ITER(FIRST); } while (0)
    for (;;) {
        const bool has_next = S.next(ui + 1, nxt);
        if (GATHER && has_next && !PEEL) {
            int t2 = wave_in * 64 + lane_id(); asm volatile("" : "+v"(t2));
#pragma unroll
            for (int i = 0; i < 2; ++i) { int R, C; stage_rc(t2 * 16 + i * 8192, R, C);
#pragma unroll
                for (int h = 0; h < 2; ++h) vn[h][i] = S.arow(nxt, h * HALF + R) * (unsigned)(K * 2) + (unsigned)(C * 2); }
        }
        if (GATHER && PEEL) {
            int t2 = wave_in * 64 + lane_id(); asm volatile("" : "+v"(t2));
#pragma unroll
            for (int i = 0; i < 2; ++i) { int R, C; stage_rc(t2 * 16 + i * 8192, R, C);
#pragma unroll
                for (int h = 0; h < 2; ++h) vn[h][i] = S.arow_raw(has_next ? nxt : cur, h * HALF + R); }
        }
        typename Epi::Pre pre = E.preload(cur, wr, wc, fr, fq);
        const char* nA = has_next ? (GATHER ? (const char*)g.A : (const char*)g.A + (size_t)nxt.pm * tstep) : cA; const char* nB = has_next ? (const char*)g.Bt + (size_t)nxt.pn * tstep : cB;
        if constexpr (PEEL) { int t = 0; PG8_IT(true); }
        if (GATHER && PEEL) {
            int t2 = wave_in * 64 + lane_id(); asm volatile("" : "+v"(t2));
#pragma unroll
            for (int i = 0; i < 2; ++i) { int R, C; stage_rc(t2 * 16 + i * 8192, R, C);
#pragma unroll
                for (int h = 0; h < 2; ++h) vn[h][i] = (vn[h][i] >> 2) * (unsigned)(K * 2) + (unsigned)(C * 2); }
        }
        if constexpr (PEEL) {
#pragma unroll 1
            for (int t = 2; t < nt; t += 2) PG8_IT(false); }
        else {
#pragma unroll 1
            for (int t = 0; t < nt; t += 2) PG8_IT(t == 0); }
        PG8_STGA(1, 1, nA + kstep, vn);
        if (wr == 0) PG8_BAR;
        if constexpr (FP8) asm volatile("s_nop 15\n\ts_nop 15" ::: "memory");
        E(acc, cur, wr, wc, fr, fq, pre);
        if (!has_next) break;
#pragma unroll
        for (int a = 0; a < 2; ++a)
#pragma unroll
            for (int b = 0; b < 2; ++b)
#pragma unroll
                for (int m = 0; m < 4; ++m)
#pragma unroll
                    for (int n = 0; n < 2; ++n) acc[a][b][m][n] = (f32x4){0.f, 0.f, 0.f, 0.f};
        cur = nxt; cA = nA; cB = nB; ++ui;
#pragma unroll
        for (int h = 0; h < 2; ++h)
#pragma unroll
            for (int i = 0; i < 2; ++i) vc[h][i] = vn[h][i];
        if (wr == 1) PG8_BAR;
    }
    PG8_WAIT_V(0);
    PG8_BAR;
#undef PG8_SA
#undef PG8_SB
#undef PG8_STAGE
#undef PG8_STGA
#undef PG8_LDA
#undef PG8_LDB
#undef PG8_MMA
#undef PG8_CAT
#undef PG8_WAIT_V
#undef PG8_WAIT_L
#undef PG8_BAR
#undef PG8_SCHED
#undef PG8_ITER
#undef PG8_ITER2
#undef PG8_IT
#undef PG8_PIECE
#undef PG8_PCA
#undef PG8_PCB
#undef PG8_MMAH
#undef PG8_H1A
#undef PG8_H1B
#undef PG8_H2A
#undef PG8_H2B
#undef PG8_H3A
#undef PG8_H3B
#undef PG8_H4A
#undef PG8_H4B
}
}

struct Frame {
    LAS unsigned char* lds;
    LAS unsigned char* misc;
    gu32* ctl;
    int tid, lane, wave, vcu, G, wave0;
    const float *x_in, *c_in, *w_ada, *b_ada, *norm1, *w_in, *sinks, *lq1, *lk1, *lq2, *lk2, *subln, *w_out, *norm2, *w_router, *b_router, *w_gate, *b_gate, *w_up, *b_up, *w_down, *b_down, *norm_f;
    float* out;
    float *modp, *mod, *part; int* ltok; float* lg; int* inv;
    bf16_t *WIN, *WOUT, *WGU, *WDN, *H, *PROJ, *MIXED, *HIDDEN, *Y, *XB;
};

__device__ __forceinline__ void p0_transpose_tile(const float* src, int N, bf16_t* dst, int ldd, LAS float* scr, int lane) {
#pragma unroll
    for (int i = 0; i < 32; ++i) { const int kk = 2 * i + (lane >> 5); scr[kk * 33 + (lane & 31)] = src[(size_t)kk * N + (lane & 31)]; }
    LDS_WAIT(); asm volatile("" ::: "memory");
    const int c = lane & 7;
#pragma unroll
    for (int j = 0; j < 4; ++j) { const int n = (lane >> 3) + 8 * j; const LAS float* s = scr + (8 * c) * 33 + n;
        u32x4 o; o.x = pk2(s[0 * 33], s[1 * 33]); o.y = pk2(s[2 * 33], s[3 * 33]); o.z = pk2(s[4 * 33], s[5 * 33]); o.w = pk2(s[6 * 33], s[7 * 33]);
        *(GAS u32x4*)(dst + (size_t)n * ldd + 8 * c) = o; }
    LDS_WAIT(); asm volatile("" ::: "memory");
}
__device__ __forceinline__ void p0_transpose_tile8(const float* src, int N, unsigned char* dst, int ldd, LAS float* scr, int lane) {
#pragma unroll
    for (int i = 0; i < 32; ++i) { const int kk = 2 * i + (lane >> 5); scr[kk * 33 + (lane & 31)] = src[(size_t)kk * N + (lane & 31)]; }
    LDS_WAIT(); asm volatile("" ::: "memory");
    const int c = lane & 7;
#pragma unroll
    for (int j = 0; j < 4; ++j) { const int n = (lane >> 3) + 8 * j; const LAS float* s = scr + (8 * c) * 33 + n;
        u32x2 o; o.x = pk4_fp8(s[0 * 33] * W8_SCALE, s[1 * 33] * W8_SCALE, s[2 * 33] * W8_SCALE, s[3 * 33] * W8_SCALE); o.y = pk4_fp8(s[4 * 33] * W8_SCALE, s[5 * 33] * W8_SCALE, s[6 * 33] * W8_SCALE, s[7 * 33] * W8_SCALE);
        *(GAS u32x2*)(dst + (size_t)n * ldd + 8 * c) = o; }
    LDS_WAIT(); asm volatile("" ::: "memory");
}
__device__ __forceinline__ void p0_prologue(Frame& F) {
    LAS float* cond = (LAS float*)F.lds;
    for (int i = F.tid; i < NBATCH * DM; i += NTHREADS) { const float v = F.c_in[i]; cond[i] = v / (1.f + __expf(-v)); }
    __syncthreads();
    LAS float* scr = (LAS float*)(F.lds + 32768 + F.wave * 8448);
    const int gw = F.vcu * NWAVES + F.wave, NGW = F.G * NWAVES;
    constexpr int I_MOD = DEPTH * 24 * 4;
    constexpr int I_IN = DEPTH * 16 * 88, I_OUT = DEPTH * 16 * 32, I_E = DEPTH * NE * 16 * 32;
    constexpr int NITEMS = I_MOD + I_IN + I_OUT + 3 * I_E;
    for (int it = gw; it < NITEMS; it += NGW) {
        int r = it;
        if (r < I_MOD) {
            const int kq = r & 3, cg = (r >> 2) % 24, L = (r >> 2) / 24, col = cg * 256 + 4 * F.lane;
            f32x4 acc[NBATCH];
#pragma unroll
            for (int b = 0; b < NBATCH; ++b) acc[b] = (f32x4){0.f, 0.f, 0.f, 0.f};
            const float* wp = F.w_ada + ((size_t)L * DM + kq * 256) * 6144 + col;
            for (int k4 = 0; k4 < 64; ++k4) {
                f32x4 w[4];
#pragma unroll
                for (int j = 0; j < 4; ++j) w[j] = *(const GAS f32x4*)(wp + (size_t)(k4 * 4 + j) * 6144);
#pragma unroll
                for (int b = 0; b < NBATCH; ++b) { const f32x4 cv = *(const LAS f32x4*)(cond + b * DM + kq * 256 + k4 * 4);
                    acc[b] += w[0] * cv.x + w[1] * cv.y + w[2] * cv.z + w[3] * cv.w; }
            }
#pragma unroll
            for (int b = 0; b < NBATCH; ++b) *(GAS f32x4*)(F.modp + (((size_t)kq * DEPTH + L) * NBATCH + b) * 6144 + col) = acc[b];
            continue;
        }
        r -= I_MOD;
        if (r < I_IN) { const int L = r / (16 * 88), q = r % (16 * 88), kb = q / 88, nb = q % 88;
            p0_transpose_tile(F.w_in + ((size_t)L * DM + kb * 64) * INW + nb * 32, INW, F.WIN + ((size_t)L * INW + nb * 32) * DM + kb * 64, DM, scr, F.lane); continue; }
        r -= I_IN;
        if (r < I_OUT) { const int L = r / 512, q = r % 512, kb = q / 32, nb = q % 32;
            p0_transpose_tile(F.w_out + ((size_t)L * DM + kb * 64) * DM + nb * 32, DM, F.WOUT + ((size_t)L * DM + nb * 32) * DM + kb * 64, DM, scr, F.lane); continue; }
        r -= I_OUT;
        { const int which = r / I_E, q0 = r % I_E, le = q0 / 512, q = q0 % 512, kb = q / 32, nb = q % 32, n0 = nb * 32;
          unsigned char* WGU8 = (unsigned char*)F.WGU; unsigned char* WDN8 = (unsigned char*)F.WDN;
          if (which == 0) p0_transpose_tile8(F.w_gate + ((size_t)le * DM + kb * 64) * DM + n0, DM, WGU8 + ((size_t)le * 2048 + (n0 >> 7) * 256 + (n0 & 127)) * DM + kb * 64, DM, scr, F.lane);
          else if (which == 1) p0_transpose_tile8(F.w_up + ((size_t)le * DM + kb * 64) * DM + n0, DM, WGU8 + ((size_t)le * 2048 + (n0 >> 7) * 256 + 128 + (n0 & 127)) * DM + kb * 64, DM, scr, F.lane);
          else p0_transpose_tile8(F.w_down + ((size_t)le * DM + kb * 64) * DM + n0, DM, WDN8 + ((size_t)le * DM + n0) * DM + kb * 64, DM, scr, F.lane); }
    }
}
__device__ __forceinline__ void p0b_modsum(Frame& F) {
    const int gt = F.vcu * NTHREADS + F.tid, NGT = F.G * NTHREADS;
    for (int i = gt; i < DEPTH * NBATCH * 6144 / 4; i += NGT) {
        const int e = i * 4, L = e / (NBATCH * 6144), j = e % 6144;
        f32x4 s = *(const GAS f32x4*)(F.b_ada + (size_t)L * 6144 + j);
#pragma unroll
        for (int kq = 0; kq < 4; ++kq) s += *(const GAS f32x4*)(F.modp + (size_t)kq * DEPTH * NBATCH * 6144 + e);
        *(GAS f32x4*)(F.mod + e) = s;
    }
}

template <int MODE>
__device__ __forceinline__ void p1_rows(Frame& F, int L, float g2mul = 1.0f) {
    const int gw = F.vcu * NWAVES + F.wave, NGW = F.G * NWAVES, lane = F.lane;
    const float* gain = (MODE == 2) ? F.norm_f : F.norm1 + (size_t)L * DM;
    f32x4 gn[4];
#pragma unroll
    for (int j = 0; j < 4; ++j) gn[j] = *(const GAS f32x4*)(gain + 4 * lane + 256 * j);
    for (int chunk = gw; chunk < NTOK / 32; chunk += NGW) {
        const int m0 = chunk * 32, b = m0 >> 13;
        f32x4 sc[4], sh[4], g2[4];
#pragma unroll
        for (int j = 0; j < 4; ++j) {
            if (MODE != 2) { const float* mp = F.mod + ((size_t)L * NBATCH + b) * 6144; sh[j] = *(const GAS f32x4*)(mp + 0 * DM + 4 * lane + 256 * j); sc[j] = *(const GAS f32x4*)(mp + 1 * DM + 4 * lane + 256 * j); }
            if (MODE != 0) { const float* mq = F.mod + ((size_t)(L - 1) * NBATCH + b) * 6144; g2[j] = *(const GAS f32x4*)(mq + 5 * DM + 4 * lane + 256 * j) * (g2mul * (1.0f / Y8_SCALE)); }
        }
        f32x4 xa[4], xb[4]; unsigned ya[4][4], yb[4][4];
        int pst = 0; i32x4 iv = {0, 0, 0, 0};
        if (MODE != 0) {
            const int c = (int)__hip_atomic_load((unsigned*)(F.ctl + CW_CNT + ((L - 1) * NE + (lane & 31)) * 16), RLX_AGENT);
            const int p = (c + 255) & ~255;
#pragma unroll
            for (int e2 = 0; e2 < 31; ++e2) { const int v_ = __builtin_amdgcn_readlane(p, e2); pst += ((lane & 31) > e2) ? v_ : 0; }
            iv = *(const GAS i32x4*)(F.inv + ((size_t)m0 + (lane & 31)) * 4);
        }
#define P1_LOAD(X, Yv, mrow) do { const size_t m_ = (size_t)(mrow); \
            _Pragma("unroll") for (int j = 0; j < 4; ++j) { if (MODE == 0) X[j] = *(const GAS f32x4*)(F.x_in + m_ * DM + 4 * lane + 256 * j); \
                else { const u32x2 xb_ = *(const GAS u32x2*)(F.XB + m_ * DM + 4 * lane + 256 * j); X[j] = (f32x4){bf_lo(xb_.x), bf_hi(xb_.x), bf_lo(xb_.y), bf_hi(xb_.y)}; } } \
            if (MODE != 0) { const int li_ = (int)(m_ - (size_t)m0); \
                _Pragma("unroll") for (int k = 0; k < TOPK; ++k) { const int w_ = __builtin_amdgcn_readlane(k == 0 ? iv.x : k == 1 ? iv.y : k == 2 ? iv.z : iv.w, li_); \
                    const size_t row_ = (size_t)(__builtin_amdgcn_readlane(pst, w_ & 255) + (w_ >> 8)); \
                    _Pragma("unroll") for (int j = 0; j < 4; ++j) Yv[j][k] = *(const GAS unsigned*)((const unsigned char*)F.Y + row_ * DM + 4 * lane + 256 * j); } } } while (0)
#define P1_PROC(X, Yv, mrow) do { const size_t m = (size_t)(mrow); f32x4 v[4]; \
            _Pragma("unroll") for (int j = 0; j < 4; ++j) { v[j] = X[j]; \
                if (MODE != 0) { f32x4 ys = (f32x4){0.f, 0.f, 0.f, 0.f}; \
                    _Pragma("unroll") for (int k = 0; k < TOPK; ++k) { const f32x2 ylo = __builtin_amdgcn_cvt_pk_f32_fp8((int)Yv[j][k], false), yhi = __builtin_amdgcn_cvt_pk_f32_fp8((int)Yv[j][k], true); ys += (f32x4){ylo.x, ylo.y, yhi.x, yhi.y}; } \
                    v[j] += g2[j] * ys; } } \
            float ss = 0.f; \
            _Pragma("unroll") for (int j = 0; j < 4; ++j) ss += (v[j].x * v[j].x + v[j].y * v[j].y) + (v[j].z * v[j].z + v[j].w * v[j].w); \
            const float rs = 1.0f / sqrtf(wave_sum(ss) * (1.f / DM) + RMS_EPS); \
            if (MODE == 2) { _Pragma("unroll") for (int j = 0; j < 4; ++j) *(GAS f32x4*)(F.out + m * DM + 4 * lane + 256 * j) = v[j] * rs * gn[j]; } \
            else { _Pragma("unroll") for (int j = 0; j < 4; ++j) { { u32x2 xo_; xo_.x = pk2(v[j].x, v[j].y); xo_.y = pk2(v[j].z, v[j].w); *(GAS u32x2*)(F.XB + m * DM + 4 * lane + 256 * j) = xo_; } \
                    const f32x4 h = (v[j] * rs * gn[j]) * (sc[j] + 1.0f) + sh[j]; \
                    u32x2 o; o.x = pk2(h.x, h.y); o.y = pk2(h.z, h.w); \
                    *(GAS u32x2*)(F.H + m * DM + 4 * lane + 256 * j) = o; } } } while (0)
        P1_LOAD(xa, ya, m0);
        for (int i = 0; i < 32; i += 2) {
            P1_LOAD(xb, yb, m0 + i + 1);
            P1_PROC(xa, ya, m0 + i);
            if (i + 2 < 32) P1_LOAD(xa, ya, m0 + i + 2);
            P1_PROC(xb, yb, m0 + i + 1);
        }
#undef P1_LOAD
#undef P1_PROC
    }
}

constexpr int MO_RS = 9216, MO_BIASP = 10240, MO_PART = 10368;
__device__ __forceinline__ void p5_route(Frame& F, int L, int LC) {
    const int lane = F.lane, r32 = lane & 31, hi = lane >> 5;
    LAS float* Wl = (LAS float*)F.lds;
    LAS int* hist = (LAS int*)(F.misc + MO_HIST); LAS int* base = (LAS int*)(F.misc + MO_BASE);
    LAS int* sel_e = (LAS int*)(F.misc + MO_SELE); LAS float* sel_g = (LAS float*)(F.misc + MO_SELG);
    LAS float* rsl = (LAS float*)(F.misc + MO_RS); LAS float* biasp = (LAS float*)(F.misc + MO_BIASP); LAS float* part = (LAS float*)(F.misc + MO_PART);
    const float* Wr = F.w_router + (size_t)L * DM * NE;
    f32x4 gn[4];
#pragma unroll
    for (int j = 0; j < 4; ++j) gn[j] = *(const GAS f32x4*)(F.norm2 + (size_t)L * DM + 4 * lane + 256 * j);
    for (int blk = F.vcu; blk < NTOK / 256; blk += F.G) {
        const int tok0 = blk * 256 + F.wave * 32, b = tok0 >> 13;
        const float* mp = F.mod + ((size_t)L * NBATCH + b) * 6144;
        if (F.tid < NE) hist[F.tid] = 0;
        for (int it = F.tid; it < (DM / 8) * NE; it += NTHREADS) { const int kg = it >> 5, e = it & 31, k0 = kg * 8;
            const f32x4 n0 = *(const GAS f32x4*)(F.norm2 + (size_t)L * DM + k0), n1 = *(const GAS f32x4*)(F.norm2 + (size_t)L * DM + k0 + 4);
            const f32x4 s0 = *(const GAS f32x4*)(mp + 4 * DM + k0), s1 = *(const GAS f32x4*)(mp + 4 * DM + k0 + 4);
            float w[8];
#pragma unroll
            for (int i = 0; i < 8; ++i) w[i] = Wr[(size_t)(k0 + i) * NE + e] * ((i < 4 ? n0[i & 3] : n1[i & 3]) * (1.0f + (i < 4 ? s0[i & 3] : s1[i & 3])));
            u32x4 hv, mv;
#pragma unroll
            for (int i = 0; i < 4; ++i) { const unsigned hb = cvt_pk_bf16(w[2 * i], w[2 * i + 1]); hv[i] = hb; mv[i] = cvt_pk_bf16(w[2 * i] - bf_lo(hb), w[2 * i + 1] - bf_hi(hb)); }
            const int off = ((kg * 32) + e) * 16;
            *(LAS u32x4*)((LAS unsigned char*)Wl + off) = hv; *(LAS u32x4*)((LAS unsigned char*)Wl + 65536 + off) = mv; }
        { const int e = lane & 31, k0 = F.wave * 128 + hi * 64; float acc = 0.f;
#pragma unroll 8
          for (int k = 0; k < 64; ++k) acc = __builtin_fmaf(mp[3 * DM + k0 + k], Wr[(size_t)(k0 + k) * NE + e], acc);
          part[(F.wave * 2 + hi) * 32 + e] = acc; }
        f32x4 sc[4], sh[4];
#pragma unroll
        for (int j = 0; j < 4; ++j) { sh[j] = *(const GAS f32x4*)(mp + 3 * DM + 4 * lane + 256 * j); sc[j] = *(const GAS f32x4*)(mp + 4 * DM + 4 * lane + 256 * j); }
        f32x4 xa[4], xb[4];
#define P5_LOAD(X, mrow) do { _Pragma("unroll") for (int j = 0; j < 4; ++j) { const u32x2 xb_ = *(const GAS u32x2*)(F.XB + (size_t)(mrow) * DM + 4 * lane + 256 * j); X[j] = (f32x4){bf_lo(xb_.x), bf_hi(xb_.x), bf_lo(xb_.y), bf_hi(xb_.y)}; } } while (0)
#define P5_PROC(X, mrow, irow) do { const size_t m = (size_t)(mrow); float ss = 0.f; \
            _Pragma("unroll") for (int j = 0; j < 4; ++j) ss += (X[j].x * X[j].x + X[j].y * X[j].y) + (X[j].z * X[j].z + X[j].w * X[j].w); \
            const float rs = 1.0f / sqrtf(wave_sum(ss) * (1.f / DM) + RMS_EPS); \
            _Pragma("unroll") for (int j = 0; j < 4; ++j) { const f32x4 h = ((X[j] * rs * gn[j]) * (sc[j] + 1.0f) + sh[j]) * H8_SCALE; \
                *(GAS unsigned*)((unsigned char*)F.H + m * DM + 4 * lane + 256 * j) = pk4_fp8(h.x, h.y, h.z, h.w); } \
            if (lane == 0) rsl[F.wave * 32 + (irow)] = rs; } while (0)
        P5_LOAD(xa, tok0);
        for (int i = 0; i < 32; i += 2) {
            P5_LOAD(xb, tok0 + i + 1);
            P5_PROC(xa, tok0 + i, i);
            if (i + 2 < 32) P5_LOAD(xa, tok0 + i + 2);
            P5_PROC(xb, tok0 + i + 1, i + 1);
        }
#undef P5_LOAD
#undef P5_PROC
        __syncthreads();
        if (F.tid < NE) { float s = F.b_router[L * NE + F.tid];
#pragma unroll
            for (int p = 0; p < 16; ++p) s += part[p * 32 + F.tid];
            biasp[F.tid] = s; }
        __syncthreads();
        {
            f32x16 a0, a1;
#pragma unroll
            for (int r = 0; r < 16; ++r) { a0[r] = 0.f; a1[r] = 0.f; }
            const bf16_t* xr = F.XB + ((size_t)tok0 + r32) * DM + 8 * hi;
            const LAS unsigned char* wl = (const LAS unsigned char*)Wl + (hi * 32 + r32) * 16;
#pragma unroll 4
            for (int j = 0; j < 64; ++j) {
                const bf16x8 xv = *(const GAS bf16x8*)(xr + 16 * j);
                const bf16x8 wh = *(const LAS bf16x8*)(wl + j * 1024), wm = *(const LAS bf16x8*)(wl + 65536 + j * 1024);
                a0 = __builtin_amdgcn_mfma_f32_32x32x16_bf16(wh, xv, a0, 0, 0, 0); a1 = __builtin_amdgcn_mfma_f32_32x32x16_bf16(wm, xv, a1, 0, 0, 0);
            }
            const float rs = rsl[F.wave * 32 + r32];
            float v[16];
#pragma unroll
            for (int r = 0; r < 16; ++r) v[r] = (a0[r] + a1[r]) * rs + biasp[(r & 3) + 8 * (r >> 2) + 4 * hi];
            float tv[4]; int ti[4];
#pragma unroll
            for (int rd = 0; rd < 4; ++rd) {
                float bv = v[0]; int bi = 4 * hi;
#pragma unroll
                for (int r = 1; r < 16; ++r) { const int ei = (r & 3) + 8 * (r >> 2) + 4 * hi; if (v[r] > bv) { bv = v[r]; bi = ei; } }
                { const auto rv_ = __builtin_amdgcn_permlane32_swap(__float_as_uint(bv), __float_as_uint(bv), false, false); const auto ri_ = __builtin_amdgcn_permlane32_swap((unsigned)bi, (unsigned)bi, false, false);
                  const float v0_ = __uint_as_float(rv_[0]), v1_ = __uint_as_float(rv_[1]); const int i0_ = (int)ri_[0], i1_ = (int)ri_[1];
                  const bool up_ = (v1_ > v0_) || (v1_ == v0_ && i1_ < i0_); bv = up_ ? v1_ : v0_; bi = up_ ? i1_ : i0_; }
                tv[rd] = bv; ti[rd] = bi;
#pragma unroll
                for (int r = 0; r < 16; ++r) { const int ei = (r & 3) + 8 * (r >> 2) + 4 * hi; if (ei == bi) v[r] = -INFINITY; }
            }
            const float e1 = __expf(tv[1] - tv[0]), e2 = __expf(tv[2] - tv[0]), e3 = __expf(tv[3] - tv[0]); const float inv = 1.0f / (1.0f + e1 + e2 + e3);
#pragma unroll
            for (int kk = 0; kk < 2; ++kk) {
                const int me = hi ? (kk ? ti[3] : ti[2]) : (kk ? ti[1] : ti[0]);
                const float mg = (hi ? (kk ? e3 : e2) : (kk ? e1 : 1.0f)) * inv;
                const int pos = __hip_atomic_fetch_add(&hist[me], 1, __ATOMIC_RELAXED, __HIP_MEMORY_SCOPE_WORKGROUP);
                const int a = (F.wave * 32 + r32) * 4 + 2 * hi + kk;
                sel_e[a] = me | (pos << 8); sel_g[a] = mg;
            }
        }
        __syncthreads();
        if (F.tid < NE) base[F.tid] = (int)__hip_atomic_fetch_add((unsigned*)(F.ctl + CW_CNT + (LC * NE + F.tid) * 16), (unsigned)hist[F.tid], RLX_AGENT);
        __syncthreads();
        for (int a = F.tid; a < 1024; a += NTHREADS) { const int se = sel_e[a], ex = se & 255, pos = se >> 8, slot = base[ex] + pos;
            F.ltok[(size_t)ex * LCAP + slot] = (blk * 256 + (a >> 2)) * 4 + (a & 3); F.lg[(size_t)ex * LCAP + slot] = sel_g[a];
            F.inv[(size_t)blk * 1024 + a] = ex | (slot << 8); }
        __syncthreads();
    }
}

struct EpiProj {
    static constexpr bool PERM = true; static constexpr int NVM = 16;
    struct Pre {}; static constexpr int NPRE = 0;
    __device__ __forceinline__ Pre preload(const pg8::Unit&, int, int, int, int) const { return Pre{}; }
    __device__ __forceinline__ void operator()(const f32x4 (&acc)[2][2][4][2], const pg8::Unit& u, int wr, int wc, int fr, int fq, const Pre&) const { (*this)(acc, u, wr, wc, fr, fq); }
    bf16_t* O; unsigned* nrm;
    __device__ __forceinline__ void operator()(const f32x4 (&acc)[2][2][4][2], const pg8::Unit& u, int wr, int wc, int fr, int fq) const {
        const int row0 = u.pm * 256 + wr * 64 + fr, col0 = u.pn * 256 + wc * 32 + 8 * fq;
        const float sc = (u.pn == 0 || u.pn == 3 || u.pn == 5 || u.pn == 6) ? QSCALE : 1.0f;
        float nmx[2] = {0.f, 0.f};
#pragma unroll
        for (int ai = 0; ai < 2; ++ai)
#pragma unroll
            for (int m = 0; m < 4; ++m) { bf16_t* rowp = O + (size_t)(row0 + ai * 128 + m * 16) * INW + col0;
#pragma unroll
                for (int bj = 0; bj < 2; ++bj) { const f32x4 v0 = acc[ai][bj][m][0] * sc, v1 = acc[ai][bj][m][1] * sc;
                    u32x4 w; w.x = cvt_pk_bf16(v0[0], v0[1]); w.y = cvt_pk_bf16(v0[2], v0[3]); w.z = cvt_pk_bf16(v1[0], v1[1]); w.w = cvt_pk_bf16(v1[2], v1[3]);
                    *(GAS u32x4*)(rowp + bj * 128) = w;
                    if (C_TILE_SKIP && u.pn >= 5 && u.pn <= 8) {
                        float q = (v0[0] * v0[0] + v0[1] * v0[1]) + (v0[2] * v0[2] + v0[3] * v0[3]) + (v1[0] * v1[0] + v1[1] * v1[1]) + (v1[2] * v1[2] + v1[3] * v1[3]);
                        q = x32_sum(x16_sum(q)); nmx[bj] = fmaxf(nmx[bj], q); } } }
        if (C_TILE_SKIP && u.pn >= 5 && u.pn <= 8) {
#pragma unroll
            for (int bj = 0; bj < 2; ++bj) { float v = row16_max(nmx[bj]);
                if (fr == 0 && fq == 0) { const int b = u.pm >> 5, qk = u.pn >= 7, blk = (u.pn - (qk ? 7 : 5)) * 8 + bj * 4 + wc;
                    atomicMax(nrm + (b * 2 + qk) * 16 + blk, __float_as_uint(v)); } }
        }
    }
};
struct EpiOut {
    static constexpr bool PERM = false; static constexpr int NVM = 32;
    struct Pre {}; static constexpr int NPRE = 0;
    __device__ __forceinline__ Pre preload(const pg8::Unit&, int, int, int, int) const { return Pre{}; }
    __device__ __forceinline__ void operator()(const f32x4 (&acc)[2][2][4][2], const pg8::Unit& u, int wr, int wc, int fr, int fq, const Pre&) const { (*this)(acc, u, wr, wc, fr, fq); }
    bf16_t* X; const float* g1; float gmul;
    __device__ __forceinline__ void operator()(const f32x4 (&acc)[2][2][4][2], const pg8::Unit& u, int wr, int wc, int fr, int fq) const {
        const int b = u.pm >> 5, col0 = u.pn * 256 + wc * 32 + 4 * fq;
        f32x4 gv[2][2];
#pragma unroll
        for (int bj = 0; bj < 2; ++bj)
#pragma unroll
            for (int n = 0; n < 2; ++n) gv[bj][n] = *(const GAS f32x4*)(g1 + (size_t)b * 6144 + col0 + bj * 128 + n * 16) * gmul;
#pragma unroll
        for (int ai = 0; ai < 2; ++ai) {
            u32x2 xv[4][2][2];
#pragma unroll
            for (int m = 0; m < 4; ++m)
#pragma unroll
                for (int bj = 0; bj < 2; ++bj)
#pragma unroll
                    for (int n = 0; n < 2; ++n) xv[m][bj][n] = *(const GAS u32x2*)(X + (size_t)(u.pm * 256 + ai * 128 + wr * 64 + m * 16 + fr) * DM + col0 + bj * 128 + n * 16);
#pragma unroll
            for (int m = 0; m < 4; ++m)
#pragma unroll
                for (int bj = 0; bj < 2; ++bj)
#pragma unroll
                    for (int n = 0; n < 2; ++n) { const u32x2 xb = xv[m][bj][n]; const f32x4 o = (f32x4){bf_lo(xb.x), bf_hi(xb.x), bf_lo(xb.y), bf_hi(xb.y)} + gv[bj][n] * acc[ai][bj][m][n];
                        u32x2 w; w.x = cvt_pk_bf16(o[0], o[1]); w.y = cvt_pk_bf16(o[2], o[3]);
                        *(GAS u32x2*)(X + (size_t)(u.pm * 256 + ai * 128 + wr * 64 + m * 16 + fr) * DM + col0 + bj * 128 + n * 16) = w; }
            asm volatile("" ::: "memory");
        }
    }
};
struct EpiGU {
    static constexpr bool PERM = true; static constexpr int NVM = 8;
    unsigned char* Hd; const float* bg; const float* bu;
    struct Pre { float b; }; static constexpr int NPRE = 1;
    __device__ __forceinline__ Pre preload(const pg8::Unit& u, int wr, int wc, int fr, int fq) const {
        const int e = u.pn >> 3, pnl = u.pn & 7, hc = pnl * 128 + wc * 32 + 8 * fq; Pre p;
        p.b = __uint_as_float(ld_untracked(((fr & 8) ? bu : bg) + (size_t)e * DM + hc + (fr & 7)));
        return p;
    }
    __device__ __forceinline__ void operator()(const f32x4 (&acc)[2][2][4][2], const pg8::Unit& u, int wr, int wc, int fr, int fq, const Pre& pre) const {
        const int pnl = u.pn & 7, hc = pnl * 128 + wc * 32 + 8 * fq;
        constexpr float ds = 1.0f / (W8_SCALE * H8_SCALE);
        f32x4 bgv[2], buv[2];
        { const int base4 = (lane_id() & 48) * 4;
#pragma unroll
          for (int n = 0; n < 2; ++n)
#pragma unroll
            for (int i = 0; i < 4; ++i) { bgv[n][i] = __int_as_float(__builtin_amdgcn_ds_bpermute(base4 + (n * 4 + i) * 4, __float_as_int(pre.b)));
                                          buv[n][i] = __int_as_float(__builtin_amdgcn_ds_bpermute(base4 + (8 + n * 4 + i) * 4, __float_as_int(pre.b))); } }
        constexpr float KS = -1.702f * LOG2E, US = HID8_SCALE / KS;
        f32x4 kbg[2], ubu[2];
#pragma unroll
        for (int n = 0; n < 2; ++n) { kbg[n] = bgv[n] * KS; ubu[n] = buv[n] * US + US; }
        f32x2 cks2 = {KS * ds, KS * ds}, cus2 = {US * ds, US * ds}, one2 = {1.0f, 1.0f};
#pragma unroll
        for (int ai = 0; ai < 2; ++ai)
#pragma unroll
            for (int m = 0; m < 4; ++m) {
                float hv[8];
#pragma unroll
                for (int n = 0; n < 2; ++n) {
#pragma unroll
                    for (int i2 = 0; i2 < 2; ++i2) {
                        const f32x2 g2 = {acc[ai][0][m][n][2 * i2], acc[ai][0][m][n][2 * i2 + 1]}, u2 = {acc[ai][1][m][n][2 * i2], acc[ai][1][m][n][2 * i2 + 1]};
                        const f32x2 kb2 = {kbg[n][2 * i2], kbg[n][2 * i2 + 1]}, ub2 = {ubu[n][2 * i2], ubu[n][2 * i2 + 1]};
                        f32x2 ap2 = __builtin_elementwise_fma(g2, cks2, kb2), up2 = __builtin_elementwise_fma(u2, cus2, ub2);
                        ap2[0] = fmaxf(ap2[0], 7.0f * KS); ap2[1] = fmaxf(ap2[1], 7.0f * KS);
                        up2[0] = __builtin_amdgcn_fmed3f(up2[0], 8.0f * US, -6.0f * US); up2[1] = __builtin_amdgcn_fmed3f(up2[1], 8.0f * US, -6.0f * US);
                        f32x2 e2 = {__builtin_amdgcn_exp2f(ap2[0]), __builtin_amdgcn_exp2f(ap2[1])};
                        e2 = e2 + one2;
                        const f32x2 s2 = {__builtin_amdgcn_rcpf(e2[0]), __builtin_amdgcn_rcpf(e2[1])};
                        const f32x2 h2 = (ap2 * s2) * up2;
                        hv[n * 4 + 2 * i2] = h2[0]; hv[n * 4 + 2 * i2 + 1] = h2[1]; } }
                u32x2 w; w.x = pk4_fp8_nc(hv[0], hv[1], hv[2], hv[3]); w.y = pk4_fp8_nc(hv[4], hv[5], hv[6], hv[7]);
                *(GAS u32x2*)(Hd + (size_t)(u.pm * 256 + ai * 128 + wr * 64 + m * 16 + fr) * DM + hc) = w; }
    }
};
struct EpiDown {
    static constexpr bool PERM = true; static constexpr int NVM = 8;
    unsigned char* Y; const float* bd; const LAS int* tab; const float* lg; LAS unsigned char* stg;
    struct Pre { float b; float g[2]; }; static constexpr int NPRE = 3;
    __device__ __forceinline__ Pre preload(const pg8::Unit& u, int wr, int wc, int fr, int fq) const {
        const int e = u.pn >> 2, pnl = u.pn & 3, col0 = pnl * 256 + wc * 32 + 8 * fq;
        const int pstart = tab[32 + e], cnt = tab[64 + e]; Pre p;
        p.b = __uint_as_float(ld_untracked(bd + (size_t)e * DM + col0 + (fr >> 3) * 128 + (fr & 7)));
#pragma unroll
        for (int ai = 0; ai < 2; ++ai) { const int i = u.pm * 256 + ai * 128 + wr * 64 + fq * 16 + fr - pstart; p.g[ai] = __uint_as_float(ld_untracked(lg + (size_t)e * LCAP + (i < cnt ? i : 0))); }
        return p;
    }
    __device__ __forceinline__ void operator()(const f32x4 (&acc)[2][2][4][2], const pg8::Unit& u, int wr, int wc, int fr, int fq, const Pre& pre) const {
        const int pnl = u.pn & 3, col0 = pnl * 256 + wc * 32 + 8 * fq;
        f32x4 bv[2][2]; float gt[2][4];
        { const int l_ = lane_id(), base4 = (l_ & 48) * 4, fr4 = (l_ & 15) * 4;
#pragma unroll
          for (int bj = 0; bj < 2; ++bj)
#pragma unroll
            for (int n = 0; n < 2; ++n)
#pragma unroll
                for (int i = 0; i < 4; ++i) bv[bj][n][i] = __int_as_float(__builtin_amdgcn_ds_bpermute(base4 + (bj * 8 + n * 4 + i) * 4, __float_as_int(pre.b)));
#pragma unroll
          for (int ai = 0; ai < 2; ++ai)
#pragma unroll
            for (int m = 0; m < 4; ++m) gt[ai][m] = __int_as_float(__builtin_amdgcn_ds_bpermute(m * 64 + fr4, __float_as_int(pre.g[ai]))); }
        LAS unsigned char* sg_ = stg + wr * EPI_STG_GRP;
        const int l_ = lane_id(), rrow = wc * 16 + (l_ >> 3), rch = l_ & 7;
#pragma unroll
        for (int ai = 0; ai < 2; ++ai)
#pragma unroll
            for (int bj = 0; bj < 2; ++bj) {
#pragma unroll
                for (int m = 0; m < 4; ++m) { constexpr float ds = 1.0f / (W8_SCALE * HID8_SCALE); const float g_ = gt[ai][m] * Y8_SCALE;
                    const f32x4 v0 = (acc[ai][bj][m][0] * ds + bv[bj][0]) * g_, v1 = (acc[ai][bj][m][1] * ds + bv[bj][1]) * g_;
                    u32x2 w; w.x = pk4_fp8(v0[0], v0[1], v0[2], v0[3]); w.y = pk4_fp8(v1[0], v1[1], v1[2], v1[3]);
                    *(LAS u32x2*)(sg_ + (m * 16 + fr) * EPI_STG_ROW + wc * 32 + 8 * fq) = w; }
                asm volatile("s_waitcnt lgkmcnt(0)\n\ts_barrier" ::: "memory");
#pragma unroll
                for (int k = 0; k < 2; ++k) { const int r64 = rrow + 8 * k; const u32x4 v = *(const LAS u32x4*)(sg_ + r64 * EPI_STG_ROW + rch * 16);
                    __builtin_nontemporal_store(v, (GAS u32x4*)(Y + (size_t)(u.pm * 256 + ai * 128 + wr * 64 + r64) * DM + pnl * 256 + bj * 128 + rch * 16)); }
                asm volatile("s_waitcnt lgkmcnt(0)\n\ts_barrier" ::: "memory");
            }
    }
};
struct MoeSched {
    const LAS int* tab; int NTs  , NBk, G, vcu; const int* ltok;
    __device__ __forceinline__ bool next(int i, pg8::Unit& u) const {
        const int L = i * G + vcu, per = 32 << NTs, chunk = L / per, rem = L % per, pnl = rem & ((1 << NTs) - 1), rb = chunk * 32 + (rem >> NTs);
        if (rb >= NBk) return false;
        const int pe = tab[lane_id() & 31];
        const unsigned long long bal = __ballot(pe <= rb * 256);
        const int e = __popc((unsigned)bal);
        u.pm = rb; u.pn = (e << NTs) + pnl; return true;
    }
    __device__ __forceinline__ unsigned arow(const pg8::Unit& u, int r) const {
        const int e = u.pn >> NTs, i = u.pm * 256 + r - tab[32 + e];
        return (i < tab[64 + e]) ? ((unsigned)ltok[(size_t)e * LCAP + i] >> 2) : 0u;
    }
    __device__ __forceinline__ unsigned arow_raw(const pg8::Unit& u, int r) const {
        const int e = u.pn >> NTs, i = u.pm * 256 + r - tab[32 + e];
        return ld_untracked(ltok + (size_t)e * LCAP + (i < tab[64 + e] ? i : 0));
    }
};
__device__ __forceinline__ void moe_table(Frame& F, int L) {
    LAS int* tab = (LAS int*)(F.misc + MO_TAB);
    if (F.tid < 64) {
        const int e = F.tid & 31;
        const int c = (int)__hip_atomic_load((unsigned*)(F.ctl + CW_CNT + (L * NE + e) * 16), RLX_AGENT);
        int p = (c + 255) & ~255, incl = p;
#pragma unroll
        for (int e2 = 0; e2 < 31; ++e2) { const int v_ = __builtin_amdgcn_readlane(p, e2); incl += (e > e2) ? v_ : 0; }
        if (F.tid < 32) { tab[e] = incl; tab[32 + e] = incl - p; tab[64 + e] = c; if (e == 31) tab[96] = incl >> 8; }
    }
    __syncthreads();
}

namespace att {
typedef short v4i16_t __attribute__((ext_vector_type(4)));
typedef LAS const char* lds_cptr;
__device__ __forceinline__ int crow(int r, int hi) { return (r & 3) + 8 * (r >> 2) + 4 * hi; }
__device__ __forceinline__ void glds16(const void* gsrc, unsigned lds_dst) { unsigned keep;
    asm volatile("s_mov_b32 %0, m0\n\ts_mov_b32 m0, %2\n\ts_nop 0\n\tglobal_load_lds_dwordx4 %1, off\n\ts_mov_b32 m0, %0" : "=&s"(keep) : "v"(gsrc), "s"(lds_dst) : "memory"); }
__device__ __forceinline__ void glds16s(const void* sbase, unsigned voff, unsigned lds_dst) { unsigned keep;
    asm volatile("s_mov_b32 %0, m0\n\ts_mov_b32 m0, %3\n\ts_nop 0\n\tglobal_load_lds_dwordx4 %1, %2\n\ts_mov_b32 m0, %0" : "=&s"(keep) : "v"(voff), "s"(sbase), "s"(lds_dst) : "memory"); }
__device__ __forceinline__ u32x2 vtr2(lds_cptr p) { return __builtin_bit_cast(u32x2, __builtin_amdgcn_ds_read_tr16_b64_v4i16((LAS v4i16_t*)p)); }
__device__ __forceinline__ bf16x8 vcat(u32x2 lo, u32x2 hv) { return __builtin_bit_cast(bf16x8, (u32x4){lo.x, lo.y, hv.x, hv.y}); }
__device__ __forceinline__ s16x4 vtr(lds_cptr p) { return __builtin_bit_cast(s16x4, __builtin_amdgcn_ds_read_tr16_b64_v4i16((LAS v4i16_t*)p)); }
#define ATT_WAIT_BAR(N) asm volatile("s_waitcnt vmcnt(" #N ") lgkmcnt(0)\n\ts_barrier" ::: "memory")
#define ATT_MFMA(a, b, c) __builtin_amdgcn_mfma_f32_32x32x16_bf16((a), (b), (c), 0, 0, 0)
__device__ __forceinline__ bf16x8 pack8(const f32x16& p, int s) {
    u32x4 w; w.x = cvt_pk_bf16(p[8 * s + 0], p[8 * s + 1]); w.y = cvt_pk_bf16(p[8 * s + 2], p[8 * s + 3]); w.z = cvt_pk_bf16(p[8 * s + 4], p[8 * s + 5]); w.w = cvt_pk_bf16(p[8 * s + 6], p[8 * s + 7]);
    return __builtin_bit_cast(bf16x8, w);
}
__device__ __forceinline__ u32x4 pair16(u32x2 w0, u32x2 w1) {
    const auto x = __builtin_amdgcn_permlane32_swap(w0.x, w1.x, false, false);
    const auto y = __builtin_amdgcn_permlane32_swap(w0.y, w1.y, false, false);
    return (u32x4){x[0], y[0], x[1], y[1]};
}
__device__ __forceinline__ float xmax32(float v) { const auto r = __builtin_amdgcn_permlane32_swap(__float_as_uint(v), __float_as_uint(v), false, false); return fmaxf(__uint_as_float(r[0]), __uint_as_float(r[1])); }
__device__ __forceinline__ float xsum32(float v) { const auto r = __builtin_amdgcn_permlane32_swap(__float_as_uint(v), __float_as_uint(v), false, false); return __uint_as_float(r[0]) + __uint_as_float(r[1]); }
__device__ __forceinline__ float max16(const f32x16& p) {
    float a = fmaxf(fmaxf(p[0], p[1]), fmaxf(p[2], p[3])), b = fmaxf(fmaxf(p[4], p[5]), fmaxf(p[6], p[7]));
    float c = fmaxf(fmaxf(p[8], p[9]), fmaxf(p[10], p[11])), d = fmaxf(fmaxf(p[12], p[13]), fmaxf(p[14], p[15]));
    return fmaxf(fmaxf(a, b), fmaxf(c, d));
}
__device__ __forceinline__ float sum16(const f32x16& p) {
    float a = (p[0] + p[1]) + (p[2] + p[3]), b = (p[4] + p[5]) + (p[6] + p[7]), c = (p[8] + p[9]) + (p[10] + p[11]), d = (p[12] + p[13]) + (p[14] + p[15]);
    return (a + b) + (c + d);
}

constexpr int C_KSLOT = 16384, C_VRING = 65536;
#define SBAR() __builtin_amdgcn_sched_barrier(0)
#define PIN(x) asm volatile("" : "+v"(x))
#define MX3(a, b, c) __builtin_fmaxf(__builtin_fmaxf((a), (b)), (c))
#define EX2(v) __builtin_amdgcn_exp2f(v)
#define PAF(k) __builtin_bit_cast(bf16x8, pw##k)
#define VRD(i) do { vl_[i] = vtr2(vp_ + (((i) & 3) * 4096 + ((i) >> 2) * 1024)); vh_[i] = vtr2(vp_ + (((i) & 3) * 4096 + ((i) >> 2) * 1024 + 512)); } while (0)
#define VFR(i) vcat(vl_[i], vh_[i])
#define FMAMK(d, a, K, c) asm("v_fmamk_f32 %0, %1, %3, %2" : "=v"(d) : "v"(a), "v"(c), "i"(__builtin_bit_cast(int, (float)(K))))
#define ATTC_STEP(C0, C1, P0, P1, t, GK, GV, GL) do { SBAR(); \
    const lds_cptr kc_ = kp0 + (((t) & 3) << 14); float sacc = P0[0] + P0[1]; \
    kf[2] = *(const LAS bf16x8*)(KXA(kc_, 1) + 0); C0 = ATT_MFMA(kf[0], qr[0], C0); sacc += P0[2]; sacc += P0[3]; sacc += P0[4]; sacc += P0[5]; PIN(sacc); pw0[0] = cvt_pk_bf16(P0[0], P0[1]); pw0[1] = cvt_pk_bf16(P0[2], P0[3]); PIN(pw0); SBAR(); \
    kf[3] = *(const LAS bf16x8*)(KXA(kc_, 1) + 4096); C1 = ATT_MFMA(kf[1], qr[0], C1); sacc += P0[6]; sacc += P0[7]; sacc += P0[8]; sacc += P0[9]; PIN(sacc); pw0[2] = cvt_pk_bf16(P0[4], P0[5]); pw0[3] = cvt_pk_bf16(P0[6], P0[7]); PIN(pw0); SBAR(); \
    kf[4] = *(const LAS bf16x8*)(KXA(kc_, 2) + 0); C0 = ATT_MFMA(kf[2], qr[1], C0); sacc += P0[10]; sacc += P0[11]; sacc += P0[12]; sacc += P0[13]; PIN(sacc); pw1[0] = cvt_pk_bf16(P0[8], P0[9]); pw1[1] = cvt_pk_bf16(P0[10], P0[11]); PIN(pw1); SBAR(); \
    kf[5] = *(const LAS bf16x8*)(KXA(kc_, 2) + 4096); C1 = ATT_MFMA(kf[3], qr[1], C1); sacc += P0[14]; sacc += P0[15]; sacc += P1[0]; sacc += P1[1]; PIN(sacc); pw1[2] = cvt_pk_bf16(P0[12], P0[13]); pw1[3] = cvt_pk_bf16(P0[14], P0[15]); PIN(pw1); SBAR(); \
    kf[6] = *(const LAS bf16x8*)(KXA(kc_, 3) + 0); C0 = ATT_MFMA(kf[4], qr[2], C0); sacc += P1[2]; sacc += P1[3]; sacc += P1[4]; sacc += P1[5]; PIN(sacc); pw2[0] = cvt_pk_bf16(P1[0], P1[1]); pw2[1] = cvt_pk_bf16(P1[2], P1[3]); PIN(pw2); SBAR(); \
    kf[7] = *(const LAS bf16x8*)(KXA(kc_, 3) + 4096); C1 = ATT_MFMA(kf[5], qr[2], C1); sacc += P1[6]; sacc += P1[7]; sacc += P1[8]; sacc += P1[9]; PIN(sacc); pw2[2] = cvt_pk_bf16(P1[4], P1[5]); pw2[3] = cvt_pk_bf16(P1[6], P1[7]); PIN(pw2); SBAR(); \
    C0 = ATT_MFMA(kf[6], qr[3], C0); sacc += P1[10]; sacc += P1[11]; sacc += P1[12]; sacc += P1[13]; PIN(sacc); pw3[0] = cvt_pk_bf16(P1[8], P1[9]); pw3[1] = cvt_pk_bf16(P1[10], P1[11]); PIN(pw3); SBAR(); \
    C1 = ATT_MFMA(kf[7], qr[3], C1); sacc += P1[14]; sacc += P1[15]; PIN(sacc); pw3[2] = cvt_pk_bf16(P1[12], P1[13]); pw3[3] = cvt_pk_bf16(P1[14], P1[15]); PIN(pw3); SBAR(); \
    l_reg += sacc; \
    if (GK) { C_DMA_K((t) + 3, ((((t) + 3) & 3) << 14)); } if (GV) { C_DMA_V((t) + 1, sl_next); } \
    const lds_cptr vp_ = vp0 + sl_prev; const lds_cptr kn_ = kp0 + ((((t) + 1) & 3) << 14); \
    const int tn_ = (t) + 1; float sg_ = (tn_ < tm) ? slope2 : -slope2; PIN(sg_); \
    u32x2 vl_[16], vh_[16]; \
    VRD(0); VRD(1); SBAR(); \
    VRD(2); o[0] = ATT_MFMA(VFR(0), PAF(0), o[0]); float ma_ = MX3(C0[0], C0[1], C0[2]); float mb_ = MX3(C0[3], C0[4], C0[5]); ma_ = MX3(ma_, C0[6], C0[7]); mb_ = MX3(mb_, C0[8], C0[9]); PIN(ma_); PIN(mb_); SBAR(); \
    VRD(3); o[1] = ATT_MFMA(VFR(1), PAF(0), o[1]); ma_ = MX3(ma_, C0[10], C0[11]); mb_ = MX3(mb_, C0[12], C0[13]); ma_ = MX3(ma_, C0[14], C0[15]); mb_ = MX3(mb_, C1[0], C1[1]); PIN(ma_); PIN(mb_); SBAR(); \
    VRD(4); o[2] = ATT_MFMA(VFR(2), PAF(0), o[2]); ma_ = MX3(ma_, C1[2], C1[3]); mb_ = MX3(mb_, C1[4], C1[5]); ma_ = MX3(ma_, C1[6], C1[7]); mb_ = MX3(mb_, C1[8], C1[9]); PIN(ma_); PIN(mb_); SBAR(); \
    VRD(5); o[3] = ATT_MFMA(VFR(3), PAF(0), o[3]); ma_ = MX3(ma_, C1[10], C1[11]); mb_ = MX3(mb_, C1[12], C1[13]); ma_ = MX3(ma_, C1[14], C1[15]); PIN(ma_); PIN(mb_); SBAR(); \
    { float rm_ = __builtin_fmaxf(ma_, mb_); { auto rr_ = __builtin_amdgcn_permlane32_swap(__float_as_uint(rm_), __float_as_uint(rm_), false, false); rm_ = __builtin_fmaxf(__uint_as_float(rr_[0]), __uint_as_float(rr_[1])); } \
      resc = false; \
      if (__builtin_expect(__any(rm_ > 8.0f), 0)) { const float dl_ = __builtin_fmaxf(rm_, 0.f); m += dl_; \
        _Pragma("unroll") for (int r_ = 0; r_ < 16; ++r_) { C0[r_] -= dl_; C1[r_] -= dl_; } \
        fsc = __builtin_amdgcn_exp2f(-dl_); l_reg *= fsc; resc = true; rm_ -= dl_; } \
      pz = __all(rm_ < -150.0f); } \
    const float ib_ = sg_ * ((float)(64 * tn_ + 4 * hi) - qf) - m; SBAR(); \
    VRD(6); o[0] = ATT_MFMA(VFR(4), PAF(1), o[0]); C0[0] = EX2(C0[0]); C0[1] = EX2(C0[1]); C0[2] = EX2(C0[2]); FMAMK(P0[0], sg_, 0.0f, ib_); FMAMK(P0[1], sg_, 1.0f, ib_); FMAMK(P0[2], sg_, 2.0f, ib_); PIN(C0); PIN(P0); SBAR(); \
    VRD(7); o[1] = ATT_MFMA(VFR(5), PAF(1), o[1]); C0[3] = EX2(C0[3]); C0[4] = EX2(C0[4]); C0[5] = EX2(C0[5]); FMAMK(P0[3], sg_, 3.0f, ib_); FMAMK(P0[4], sg_, 8.0f, ib_); FMAMK(P0[5], sg_, 9.0f, ib_); PIN(C0); PIN(P0); SBAR(); \
    VRD(8); o[2] = ATT_MFMA(VFR(6), PAF(1), o[2]); C0[6] = EX2(C0[6]); C0[7] = EX2(C0[7]); FMAMK(P0[6], sg_, 10.0f, ib_); FMAMK(P0[7], sg_, 11.0f, ib_); PIN(C0); PIN(P0); SBAR(); \
    VRD(9); o[3] = ATT_MFMA(VFR(7), PAF(1), o[3]); C0[8] = EX2(C0[8]); C0[9] = EX2(C0[9]); C0[10] = EX2(C0[10]); FMAMK(P0[8], sg_, 16.0f, ib_); FMAMK(P0[9], sg_, 17.0f, ib_); FMAMK(P0[10], sg_, 18.0f, ib_); PIN(C0); PIN(P0); SBAR(); \
    VRD(10); o[0] = ATT_MFMA(VFR(8), PAF(2), o[0]); C0[11] = EX2(C0[11]); C0[12] = EX2(C0[12]); C0[13] = EX2(C0[13]); FMAMK(P0[11], sg_, 19.0f, ib_); FMAMK(P0[12], sg_, 24.0f, ib_); FMAMK(P0[13], sg_, 25.0f, ib_); PIN(C0); PIN(P0); SBAR(); \
    VRD(11); o[1] = ATT_MFMA(VFR(9), PAF(2), o[1]); C0[14] = EX2(C0[14]); C0[15] = EX2(C0[15]); FMAMK(P0[14], sg_, 26.0f, ib_); FMAMK(P0[15], sg_, 27.0f, ib_); PIN(C0); PIN(P0); SBAR(); \
    if (GL) { kf[0] = *(const LAS bf16x8*)(KXA(kn_, 0) + 0); } VRD(12); o[2] = ATT_MFMA(VFR(10), PAF(2), o[2]); C1[0] = EX2(C1[0]); C1[1] = EX2(C1[1]); C1[2] = EX2(C1[2]); FMAMK(P1[0], sg_, 32.0f, ib_); FMAMK(P1[1], sg_, 33.0f, ib_); FMAMK(P1[2], sg_, 34.0f, ib_); PIN(C1); PIN(P1); SBAR(); \
    if (GL) { kf[1] = *(const LAS bf16x8*)(KXA(kn_, 0) + 4096); } VRD(13); o[3] = ATT_MFMA(VFR(11), PAF(2), o[3]); C1[3] = EX2(C1[3]); C1[4] = EX2(C1[4]); C1[5] = EX2(C1[5]); FMAMK(P1[3], sg_, 35.0f, ib_); FMAMK(P1[4], sg_, 40.0f, ib_); FMAMK(P1[5], sg_, 41.0f, ib_); PIN(C1); PIN(P1); SBAR(); \
    VRD(14); o[0] = ATT_MFMA(VFR(12), PAF(3), o[0]); C1[6] = EX2(C1[6]); C1[7] = EX2(C1[7]); FMAMK(P1[6], sg_, 42.0f, ib_); FMAMK(P1[7], sg_, 43.0f, ib_); PIN(C1); PIN(P1); SBAR(); \
    VRD(15); o[1] = ATT_MFMA(VFR(13), PAF(3), o[1]); C1[8] = EX2(C1[8]); C1[9] = EX2(C1[9]); C1[10] = EX2(C1[10]); FMAMK(P1[8], sg_, 48.0f, ib_); FMAMK(P1[9], sg_, 49.0f, ib_); FMAMK(P1[10], sg_, 50.0f, ib_); PIN(C1); PIN(P1); SBAR(); \
    o[2] = ATT_MFMA(VFR(14), PAF(3), o[2]); C1[11] = EX2(C1[11]); C1[12] = EX2(C1[12]); C1[13] = EX2(C1[13]); FMAMK(P1[11], sg_, 51.0f, ib_); FMAMK(P1[12], sg_, 56.0f, ib_); FMAMK(P1[13], sg_, 57.0f, ib_); PIN(C1); PIN(P1); SBAR(); \
    o[3] = ATT_MFMA(VFR(15), PAF(3), o[3]); C1[14] = EX2(C1[14]); C1[15] = EX2(C1[15]); FMAMK(P1[14], sg_, 58.0f, ib_); FMAMK(P1[15], sg_, 59.0f, ib_); PIN(C1); PIN(P1); SBAR(); \
    if (tn_ == tm) { const float db_ = (float)(64 * tn_ + 4 * hi) - qf; \
      _Pragma("unroll") for (int r_ = 0; r_ < 16; ++r_) { const float c_ = (float)((r_ & 3) + 8 * (r_ >> 2)); \
        P0[r_] = __builtin_fmaf(-__builtin_fabsf(db_ + c_), slope2, -m); P1[r_] = __builtin_fmaf(-__builtin_fabsf(db_ + (32.f + c_)), slope2, -m); } } \
    } while (0)

__device__ __forceinline__ bool attnC_unit(const bf16_t* P, bf16_t* MX, const float* gainv  , int b, int h, int qb, float slope2, float lam, float post, LAS unsigned char* shm, int wid, int lane, int T0, int NT, volatile LAS unsigned* badw) {
    const int r32 = lane & 31, hi = lane >> 5, rg = wid & 3, mp = wid >> 2;
    const size_t rowbase = (size_t)b * SEQ;
    const int q0 = qb * 128 + rg * 32, tm = (q0 >> 6) - T0;
    const bf16_t* qp = P + (rowbase + q0 + r32) * INW + C_QC + h * 128 + mp * 64 + hi * 8;
    bf16x8 qr[4];
#pragma unroll
    for (int d0 = 0; d0 < 4; ++d0) qr[d0] = *(const GAS bf16x8*)(qp + d0 * 16);
    const bf16_t* kbase = P + (rowbase + (size_t)T0 * 64) * INW + C_KC + h * 128;
    const bf16_t* vbase = P + (rowbase + (size_t)T0 * 64) * INW + C_VC + h * 128;
    const int c4 = wid >> 1, ks0 = 2 * (wid & 1);
    const int frow = 8 * wid + (lane >> 3);
    const unsigned voffk = (unsigned)(frow * INW + (((lane & 7) ^ ((frow >> 1) & 7)) * 8)) * 2u;
    const unsigned voffv = (unsigned)((16 * ks0 + (lane >> 2)) * INW + c4 * 32 + (lane & 3) * 8) * 2u;
    const unsigned lds0 = (unsigned)(size_t)shm;
    const unsigned d_k1 = lds0 + wid * 1024, d_k2 = lds0 + 8192 + wid * 1024, d_v0 = lds0 + C_VRING + (2 * wid) * 1024, d_v1 = d_v0 + 1024;
#define C_DMA_K(t, slot) do { const bf16_t* _b = kbase + (size_t)(t) * 64 * INW; \
        glds16s(_b, voffk, (unsigned)__builtin_amdgcn_readfirstlane(d_k1 + (slot))); glds16s(_b + 64, voffk, (unsigned)__builtin_amdgcn_readfirstlane(d_k2 + (slot))); } while (0)
#define C_DMA_V(t, slot) do { const bf16_t* _b = vbase + (size_t)(t) * 64 * INW; \
        glds16s(_b, voffv, (unsigned)__builtin_amdgcn_readfirstlane(d_v0 + (slot))); glds16s(_b + 16 * INW, voffv, (unsigned)__builtin_amdgcn_readfirstlane(d_v1 + (slot))); } while (0)
    const lds_cptr shm3 = (lds_cptr)shm;
    const lds_cptr kp0 = shm3 + mp * 8192 + r32 * 128 + ((hi ^ ((r32 >> 1) & 7)) * 16);
#define KXA(base, d0) ((lds_cptr)(size_t)((unsigned)(size_t)(base) ^ (unsigned)((d0) << 5)))
    const lds_cptr vp0 = shm3 + C_VRING + ((lane >> 4) & 1) * 32 + (lane & 3) * 8 + (4 * hi + ((lane & 15) >> 2)) * 64;
    if (C_TILE_SKIP == 1 && wid == 0 && lane == 0) *badw = 0u;
    C_DMA_K(0, 0); C_DMA_V(0, 0); C_DMA_K(1, C_KSLOT);
    float m = 0.f, l_reg = 0.f, fsc = 1.f; bool resc = false, pz = false; (void)pz;
    f32x16 o[4];
#pragma unroll
    for (int c = 0; c < 4; ++c)
#pragma unroll
        for (int r = 0; r < 16; ++r) o[c][r] = 0.f;
    const float qf = (float)(q0 + r32 - 64 * T0);
    f32x16 pA0, pA1, pB0, pB1; bf16x8 kf[8]; u32x4 pw0, pw1, pw2, pw3;
    int sl_prev = 0, sl_cur = 0, sl_next = C_KSLOT;
#define C_ROT() do { sl_prev = sl_cur; sl_cur = sl_next; sl_next = (sl_next == 2 * C_KSLOT) ? 0 : sl_next + C_KSLOT; } while (0)
#define C_RESC() do { if (resc) { _Pragma("unroll") for (int c_ = 0; c_ < 4; ++c_) _Pragma("unroll") for (int r_ = 0; r_ < 16; ++r_) o[c_][r_] *= fsc; } } while (0)
#define C_INIT(X0, X1, tn) do { const float db_ = (float)(64 * (tn) + 4 * hi) - qf; \
        _Pragma("unroll") for (int r_ = 0; r_ < 16; ++r_) { const float c_ = (float)((r_ & 3) + 8 * (r_ >> 2)); \
            X0[r_] = __builtin_fmaf(-__builtin_fabsf(db_ + c_), slope2, -m); X1[r_] = __builtin_fmaf(-__builtin_fabsf(db_ + (32.f + c_)), slope2, -m); } } while (0)
#define C_KLOAD8(kp) do { _Pragma("unroll") for (int j_ = 0; j_ < 8; ++j_) kf[j_] = *(const LAS bf16x8*)(KXA((kp), j_ >> 1) + (j_ & 1) * 4096); } while (0)
    C_DMA_K(2, 2 * C_KSLOT);
    C_INIT(pA0, pA1, 0);
    ATT_WAIT_BAR(6);
    C_KLOAD8(kp0);
#pragma unroll
    for (int i = 0; i < 8; ++i) { if (i & 1) pA1 = ATT_MFMA(kf[i], qr[i >> 1], pA1); else pA0 = ATT_MFMA(kf[i], qr[i >> 1], pA0); }
    { float rm = fmaxf(max16(pA0), max16(pA1)); rm = xmax32(rm);
      if (__any(rm > 8.0f)) { const float dl = fmaxf(rm, 0.f); m += dl;
#pragma unroll
          for (int r = 0; r < 16; ++r) { pA0[r] -= dl; pA1[r] -= dl; } }
#pragma unroll
      for (int r = 0; r < 16; ++r) { pA0[r] = EX2(pA0[r]); pA1[r] = EX2(pA1[r]); } }
    ATT_WAIT_BAR(0);
    C_DMA_K(3, 3 * C_KSLOT); C_DMA_V(1, C_KSLOT);
    C_ROT();
    { const lds_cptr k1_ = kp0 + C_KSLOT; kf[0] = *(const LAS bf16x8*)(k1_); kf[1] = *(const LAS bf16x8*)(k1_ + 4096); }
    C_INIT(pB0, pB1, 1);
    if (wid >= 4) __builtin_amdgcn_s_setprio(1);
    int t = 1;
    for (; t + 5 < NT; t += 2) {
        ATTC_STEP(pB0, pB1, pA0, pA1, t, true, true, true);     ATT_WAIT_BAR(4); C_RESC(); C_ROT();
        ATTC_STEP(pA0, pA1, pB0, pB1, t + 1, true, true, true); ATT_WAIT_BAR(4); C_RESC(); C_ROT();
    }
#define C_ENDW(tt) do { if ((tt) + 3 < NT) { ATT_WAIT_BAR(4); } else if ((tt) + 2 < NT) { ATT_WAIT_BAR(2); } else { ATT_WAIT_BAR(0); } } while (0)
    for (; t + 1 < NT; t += 2) {
        ATTC_STEP(pB0, pB1, pA0, pA1, t, (t + 3 < NT), (t + 1 < NT), (t + 1 < NT));         C_ENDW(t);     C_RESC(); C_ROT();
        ATTC_STEP(pA0, pA1, pB0, pB1, t + 1, (t + 4 < NT), (t + 2 < NT), (t + 2 < NT));     C_ENDW(t + 1); C_RESC(); C_ROT();
    }
    ATTC_STEP(pB0, pB1, pA0, pA1, NT - 1, false, false, false); C_RESC();
    __builtin_amdgcn_s_setprio(0);
    { l_reg += sum16(pB0) + sum16(pB1);
      const bf16x8 q0_ = pack8(pB0, 0), q1_ = pack8(pB0, 1), q2_ = pack8(pB1, 0), q3_ = pack8(pB1, 1);
      const lds_cptr vp = vp0 + sl_cur;
#pragma unroll
      for (int c = 0; c < 4; ++c)
#pragma unroll
          for (int s = 0; s < 4; ++s) {
              const bf16x8 vf = vcat(vtr2(vp + c * 4096 + s * 1024), vtr2(vp + c * 4096 + s * 1024 + 512));
              o[c] = ATT_MFMA(vf, s == 0 ? q0_ : s == 1 ? q1_ : s == 2 ? q2_ : q3_, o[c]);
          } }
    if (C_TILE_SKIP == 1 && NT < SEQ / 64) {
        const int NF = SEQ / 64 - NT;
        ATT_WAIT_BAR(0);
#define C_FAR(i) (((i) < T0) ? (i) - T0 : (i) - T0 + NT)
#define C_DMA_KF(trel, slot) do { const bf16_t* _b = kbase + (ptrdiff_t)(trel) * 64 * INW; \
        glds16s(_b, voffk, (unsigned)__builtin_amdgcn_readfirstlane(d_k1 + (slot))); glds16s(_b + 64, voffk, (unsigned)__builtin_amdgcn_readfirstlane(d_k2 + (slot))); } while (0)
        const int NP = NF >> 1;
        C_DMA_KF(C_FAR(0), 0); C_DMA_KF(C_FAR(1), C_KSLOT);
        if (NP > 1) { C_DMA_KF(C_FAR(2), 2 * C_KSLOT); C_DMA_KF(C_FAR(3), 3 * C_KSLOT); }
        bool badl = false;
        int s0 = 0, s2 = 4 * C_KSLOT;
        for (int p = 0; p < NP; ++p) {
            if (p + 1 < NP) { ATT_WAIT_BAR(4); } else { ATT_WAIT_BAR(0); }
            if (p + 2 < NP) { C_DMA_KF(C_FAR(2 * p + 4), s2); C_DMA_KF(C_FAR(2 * p + 5), s2 + C_KSLOT); }
            f32x16 c[2][2];
#pragma unroll
            for (int u = 0; u < 2; ++u)
#pragma unroll
                for (int r = 0; r < 16; ++r) { c[u][0][r] = 0.f; c[u][1][r] = 0.f; }
#pragma unroll
            for (int j = 0; j < 8; ++j)
#pragma unroll
                for (int u = 0; u < 2; ++u) { const bf16x8 kfj = *(const LAS bf16x8*)(KXA(kp0 + s0 + u * C_KSLOT, j >> 1) + (j & 1) * 4096);
                    c[u][j & 1] = ATT_MFMA(kfj, qr[j >> 1], c[u][j & 1]); }
#pragma unroll
            for (int u = 0; u < 2; ++u) {
                const int trel = C_FAR(2 * p + u);
                const float dmin = (trel < tm) ? (qf - (float)(64 * trel + 63)) : ((float)(64 * trel) - qf);
                badl |= !(fmaxf(max16(c[u][0]), max16(c[u][1])) - slope2 * dmin - m < -150.0f);
            }
            s0 = (s0 == 4 * C_KSLOT) ? 0 : s0 + 2 * C_KSLOT; s2 = (s2 == 4 * C_KSLOT) ? 0 : s2 + 2 * C_KSLOT;
        }
        if (__any(badl) && lane == 0) *badw = 1u;
#undef C_FAR
#undef C_DMA_KF
    }
#undef C_DMA_K
#undef C_DMA_V
#undef C_ROT
#undef C_RESC
#undef C_INIT
#undef C_KLOAD8
#undef KXA
#undef C_ENDW
    float l = xsum32(l_reg);
    const float inv = 1.0f / l;
    ATT_WAIT_BAR(0);
    LAS float* x2 = (LAS float*)shm + rg * 4096;
    if (mp == 1) {
        const float sc = inv * lam;
#pragma unroll
        for (int c = 0; c < 4; ++c)
#pragma unroll
            for (int r = 0; r < 16; ++r) x2[(c * 16 + r) * 64 + lane] = o[c][r] * sc;
    }
    ATT_WAIT_BAR(0);
    if (mp == 0) {
        float ss = 0.f;
#pragma unroll
        for (int c = 0; c < 4; ++c)
#pragma unroll
            for (int r = 0; r < 16; ++r) { const float v = o[c][r] * inv - x2[(c * 16 + r) * 64 + lane]; o[c][r] = v; ss += v * v; }
        ss = xsum32(ss);
        const float rn = post / sqrtf(ss * (1.0f / 128.0f) + RMS_EPS);
        bf16_t* op = MX + (rowbase + q0 + r32) * DM + 512 + h * 128;
#pragma unroll
        for (int c = 0; c < 4; ++c)
#pragma unroll
            for (int g = 0; g < 4; g += 2) { const f32x4 gv0 = *(const GAS f32x4*)(gainv + 32 * c + 8 * g + 4 * hi), gv1 = *(const GAS f32x4*)(gainv + 32 * c + 8 * g + 8 + 4 * hi);
                u32x2 w0, w1;
                w0.x = cvt_pk_bf16(o[c][4 * g + 0] * rn * gv0.x, o[c][4 * g + 1] * rn * gv0.y); w0.y = cvt_pk_bf16(o[c][4 * g + 2] * rn * gv0.z, o[c][4 * g + 3] * rn * gv0.w);
                w1.x = cvt_pk_bf16(o[c][4 * g + 4] * rn * gv1.x, o[c][4 * g + 5] * rn * gv1.y); w1.y = cvt_pk_bf16(o[c][4 * g + 6] * rn * gv1.z, o[c][4 * g + 7] * rn * gv1.w);
                *(GAS u32x4*)(op + 32 * c + 8 * (g + hi)) = pair16(w0, w1); }
    }
    const bool bad = (C_TILE_SKIP == 1) && (*badw != 0u);
    asm volatile("s_waitcnt lgkmcnt(0)\n\ts_barrier" ::: "memory");
    return bad;
}
#undef SBAR
#undef PIN
#undef MX3
#undef EX2
#undef PAF
#undef VRD
#undef VFR
#undef FMAMK

template <int MODE> __device__ __forceinline__ void band_desc(int n, int q0, int& kb, int& ks, int& W) {
    if (MODE == 1) { if (n < 3) { kb = q0 - 1024 + 1024 * n; ks = 16; W = 1024; } else { kb = q0 - 256 + 256 * (n - 3); ks = 4; W = 256; } }
    else if (MODE == 2) { kb = q0 - 64 + 64 * n; ks = 1; W = 64; }
    else { kb = q0 - 128 + 64 * n; ks = 1; W = 128; }
}
constexpr int BK_S = 1056, BV_OFF = 8 * BK_S, BV_S = 4224;
template <int MODE, int NQ>
__device__ __forceinline__ void band_task(const bf16_t* P, size_t rowbase, int kcol, int vcol, int q0, const float (&slope2)[NQ], int qtok,
                                          const bf16_t* const (&qp)[NQ]  , float (&m)[NQ], float (&l)[NQ], f32x16 (&o)[NQ][2], LAS unsigned char* wl, int lane_in) {
    const int lane = lane_id(); (void)lane_in;
    const int r32 = lane & 31, hi = lane >> 5;
    const unsigned kbase_l = (unsigned)(size_t)((lds_cptr)wl + r32 * 128 + ((hi ^ ((r32 >> 1) & 7)) * 16));
    const lds_cptr vp = (lds_cptr)wl + BV_OFF + ((lane >> 4) & 1) * 32 + (lane & 3) * 8 + (4 * hi + ((lane & 15) >> 2)) * 64;
    const unsigned ldsk = (unsigned)(size_t)wl;
    const float qf = (float)qtok;
    constexpr int NTL = MODE == 1 ? 7 : (MODE == 2 ? 3 : 5);
    unsigned mask = 0u;
#pragma unroll
    for (int n = 0; n < NTL; ++n) { int kb, ks, W; band_desc<MODE>(n, q0, kb, ks, W); if (!(kb + ks * 63 < 0 || kb >= SEQ)) mask |= 1u << n; }
    if (!mask) return;
    u32x4 vr[8];
    const int lrow = lane >> 3, lch = lane & 7;
    LAS unsigned char* vw = wl + BV_OFF + (lch >> 2) * BV_S + lrow * 64 + (lch & 3) * 16;
    const bf16_t* kgb = P + rowbase * INW + kcol; const char* vgb = (const char*)(P + rowbase * INW + vcol);
#define BAND_DMAK(n_) do { int kb_, ks_, W_; band_desc<MODE>((n_), q0, kb_, ks_, W_); \
        _Pragma("unroll") for (int i = 0; i < 8; ++i) { const int row_ = lrow + 8 * i; int kt = kb_ + ks_ * row_; kt = kt < 0 ? 0 : (kt > SEQ - 1 ? SEQ - 1 : kt); \
            glds16s(kgb, (unsigned)(kt * INW + ((lch ^ ((row_ >> 1) & 7)) * 8)) * 2u, (unsigned)__builtin_amdgcn_readfirstlane(ldsk + i * 1024)); } } while (0)
#define BAND_LOADV(n_) do { int kb_, ks_, W_; band_desc<MODE>((n_), q0, kb_, ks_, W_); \
        _Pragma("unroll") for (int i = 0; i < 8; ++i) { int kt = kb_ + ks_ * (lrow + 8 * i); kt = kt < 0 ? 0 : (kt > SEQ - 1 ? SEQ - 1 : kt); \
            vr[i] = *(const GAS u32x4*)(vgb + (unsigned)((kt * INW + lch * 8) * 2)); } } while (0)
    bf16x8 qr[4];
    if (NQ == 1) {
#pragma unroll
        for (int d0 = 0; d0 < 4; ++d0) qr[d0] = *(const GAS bf16x8*)(qp[0] + d0 * 16); }
    LDS_WAIT();
    { const int n0 = __builtin_ctz(mask); BAND_DMAK(n0); BAND_LOADV(n0); }
    while (mask) {
        const int n = __builtin_ctz(mask); mask &= mask - 1u;
        const int nn = mask ? __builtin_ctz(mask) : -1;
        int kb, ks, W; band_desc<MODE>(n, q0, kb, ks, W);
        float ksf = (float)ks; asm volatile("" : "+v"(ksf));
        const float dlo = fmaxf(-qf, -(float)W), dhi = fminf((float)W, (float)(SEQ - 1) - qf);
        VM_WAIT();
#pragma unroll
        for (int i = 0; i < 8; ++i) *(LAS u32x4*)(vw + i * 512) = vr[i];
        if (nn >= 0) BAND_LOADV(nn);
        const float dbase = (float)kb - qf + ksf * (float)(4 * hi);
#pragma unroll
        for (int qi = 0; qi < NQ; ++qi) {
            if (NQ > 1) {
#pragma unroll
                for (int d0 = 0; d0 < 4; ++d0) qr[d0] = *(const GAS bf16x8*)(qp[qi] + d0 * 16); }
            f32x16 p0, p1;
#pragma unroll
            for (int r = 0; r < 16; ++r) { p0[r] = 0.f; p1[r] = 0.f; }
#pragma unroll
            for (int d0 = 0; d0 < 4; ++d0) { const lds_cptr ka_ = (lds_cptr)(size_t)(kbase_l ^ (unsigned)(d0 << 5));
                const bf16x8 a0 = *(const LAS bf16x8*)(ka_), a1 = *(const LAS bf16x8*)(ka_ + 4096);
                p0 = ATT_MFMA(a0, qr[d0], p0); p1 = ATT_MFMA(a1, qr[d0], p1);
            }
            if (qi == NQ - 1 && nn >= 0) { LDS_WAIT(); BAND_DMAK(nn); }
#pragma unroll
            for (int r = 0; r < 16; ++r) { const float c = (float)((r & 3) + 8 * (r >> 2));
                const float d0 = __builtin_fmaf(ksf, c, dbase), d1 = __builtin_fmaf(ksf, 32.f + c, dbase);
                p0[r] = (d0 >= dlo && d0 <= dhi) ? __builtin_fmaf(-__builtin_fabsf(d0), slope2[qi], p0[r]) : -INFINITY;
                p1[r] = (d1 >= dlo && d1 <= dhi) ? __builtin_fmaf(-__builtin_fabsf(d1), slope2[qi], p1[r]) : -INFINITY; }
            float mx = fmaxf(max16(p0), max16(p1));
            mx = xmax32(mx);
            if (__any(mx > m[qi] + 8.0f)) {
                const float mn = fmaxf(m[qi], mx), f = __builtin_amdgcn_exp2f(m[qi] - mn);
                l[qi] *= f; m[qi] = mn;
#pragma unroll
                for (int c = 0; c < 2; ++c)
#pragma unroll
                    for (int r = 0; r < 16; ++r) o[qi][c][r] *= f;
            }
#pragma unroll
            for (int r = 0; r < 16; ++r) { p0[r] = __builtin_amdgcn_exp2f(p0[r] - m[qi]); p1[r] = __builtin_amdgcn_exp2f(p1[r] - m[qi]); }
            l[qi] += sum16(p0) + sum16(p1);
            bf16x8 pw[4]; pw[0] = pack8(p0, 0); pw[1] = pack8(p0, 1); pw[2] = pack8(p1, 0); pw[3] = pack8(p1, 1);
#pragma unroll
            for (int c = 0; c < 2; ++c)
#pragma unroll
                for (int s = 0; s < 4; ++s) {
                    const bf16x8 vf = vcat(vtr2(vp + c * BV_S + s * 1024), vtr2(vp + c * BV_S + s * 1024 + 512));
                    o[qi][c] = ATT_MFMA(vf, pw[s], o[qi][c]);
                }
        }
    }
#undef BAND_DMAK
#undef BAND_LOADV
}
__device__ __forceinline__ void band_store(bf16_t* op  , int hi, const f32x16 (&o)[2], float inv) {
#pragma unroll
    for (int c = 0; c < 2; ++c)
#pragma unroll
        for (int g = 0; g < 4; g += 2) { u32x2 w0, w1;
            w0.x = cvt_pk_bf16(o[c][4 * g + 0] * inv, o[c][4 * g + 1] * inv); w0.y = cvt_pk_bf16(o[c][4 * g + 2] * inv, o[c][4 * g + 3] * inv);
            w1.x = cvt_pk_bf16(o[c][4 * g + 4] * inv, o[c][4 * g + 5] * inv); w1.y = cvt_pk_bf16(o[c][4 * g + 6] * inv, o[c][4 * g + 7] * inv);
            *(GAS u32x4*)(op + 32 * c + 8 * (g + hi)) = pair16(w0, w1); }
}
}

template <int DAB, int DC>
__device__ __forceinline__ void p3_attention(Frame& F, int L) {
    const int lane = F.lane, r32 = lane & 31, hi = lane >> 5, wid = F.wave;
    LAS unsigned char* wl = F.lds + wid * BAND_WL;
    for (int rep = 0; rep < DAB; ++rep) {
    for (int bt = F.vcu; bt < NBATCH * 4 * 16; bt += F.G) {
        const int b = bt >> 6, h = (bt >> 4) & 3, blk = bt & 15;
        const float sl1[1] = {__builtin_amdgcn_exp2f(-2.0f * (float)(h + 1)) * LOG2E};
        const size_t rowbase = (size_t)b * SEQ;
        for (int rr = 0; rr < 2; ++rr) {
            const int lane = lane_id(), r32 = lane & 31, hi = lane >> 5;
            const int q0 = blk * 512 + rr * 8 + wid, qtok = q0 + 16 * r32;
            const bf16_t* const qp[1] = {F.PROJ + (rowbase + qtok) * INW + C_QA + h * 64 + hi * 8};
            float m[1] = {-1e30f}, l[1] = {0.f}; f32x16 o[1][2];
#pragma unroll
            for (int c = 0; c < 2; ++c)
#pragma unroll
                for (int r = 0; r < 16; ++r) o[0][c][r] = 0.f;
            att::band_task<1, 1>(F.PROJ, rowbase, C_KA + h * 64, C_VA + h * 64, q0, sl1, qtok, qp, m, l, o, wl, lane);
            float* pp = F.part + ((rowbase + qtok) * 4 + h) * 68;
#pragma unroll
            for (int c = 0; c < 2; ++c)
#pragma unroll
                for (int g = 0; g < 4; ++g) *(GAS f32x4*)(pp + 32 * c + 8 * g + 4 * hi) = (f32x4){o[0][c][4 * g], o[0][c][4 * g + 1], o[0][c][4 * g + 2], o[0][c][4 * g + 3]};
            if (hi == 0) pp[64] = m[0];
            pp[65 + hi] = l[0];
        }
        VM_WAIT(); __syncthreads(); __builtin_amdgcn_fence(__ATOMIC_ACQUIRE, "agent"); VM_WAIT();
        for (int rr = 0; rr < 2; ++rr) {
            const int lane = lane_id(), r32 = lane & 31, hi = lane >> 5;
            const int q0 = blk * 512 + (rr * 8 + wid) * 32, qtok = q0 + r32;
            const bf16_t* const qp[1] = {F.PROJ + (rowbase + qtok) * INW + C_QA + h * 64 + hi * 8};
            const float* pp = F.part + ((rowbase + qtok) * 4 + h) * 68;
            f32x16 o[1][2];
#pragma unroll
            for (int c = 0; c < 2; ++c)
#pragma unroll
                for (int g = 0; g < 4; ++g) { const f32x4 t = *(const GAS f32x4*)(pp + 32 * c + 8 * g + 4 * hi); o[0][c][4 * g] = t[0]; o[0][c][4 * g + 1] = t[1]; o[0][c][4 * g + 2] = t[2]; o[0][c][4 * g + 3] = t[3]; }
            float m[1] = {pp[64]}, l[1] = {pp[65 + hi]};
            att::band_task<2, 1>(F.PROJ, rowbase, C_KA + h * 64, C_VA + h * 64, q0, sl1, qtok, qp, m, l, o, wl, lane);
            att::band_store(F.MIXED + (rowbase + qtok) * DM + h * 64, hi, o[0], 1.0f / att::xsum32(l[0]));
        }
        __syncthreads();
    }
    for (int bt = F.vcu; bt < NBATCH * 2 * 32; bt += F.G) {
        const int b = bt >> 6, hk = (bt >> 5) & 1, blk = bt & 31;
        const size_t rowbase = (size_t)b * SEQ;
        const int lane = lane_id(), r32 = lane & 31, hi = lane >> 5;
        const int q0 = blk * 256 + wid * 32, qtok = q0 + r32;
        float sl2[2], m[2], l[2]; f32x16 o[2][2];
        const bf16_t* const qp[2] = {F.PROJ + (rowbase + qtok) * INW + C_QB + (2 * hk) * 64 + hi * 8, F.PROJ + (rowbase + qtok) * INW + C_QB + (2 * hk + 1) * 64 + hi * 8};
#pragma unroll
        for (int g = 0; g < 2; ++g) { const int hq = 2 * hk + g;
            sl2[g] = __builtin_amdgcn_exp2f(-2.0f * (float)(hq + 1)) * LOG2E;
            m[g] = F.sinks[L * 4 + hq] * LOG2E; l[g] = 0.5f;
#pragma unroll
            for (int c = 0; c < 2; ++c)
#pragma unroll
                for (int r = 0; r < 16; ++r) o[g][c][r] = 0.f; }
        att::band_task<0, 2>(F.PROJ, rowbase, C_KB + hk * 64, C_VB + hk * 64, q0, sl2, qtok, qp, m, l, o, wl, lane);
#pragma unroll
        for (int g = 0; g < 2; ++g) att::band_store(F.MIXED + (rowbase + qtok) * DM + 256 + (2 * hk + g) * 64, hi, o[g], 1.0f / att::xsum32(l[g]));
    }
    }
    VM_WAIT(); LDS_WAIT();
    __syncthreads();
    {
        float lam_init = 0.8f - 0.6f * __expf(-0.3f * (float)L);
        const float s1 = wave_sum(F.lq1[L * 64 + lane] * F.lk1[L * 64 + lane]), s2 = wave_sum(F.lq2[L * 64 + lane] * F.lk2[L * 64 + lane]);
        const float lam = __expf(s1) - __expf(s2) + lam_init;
        for (int rep = 0; rep < DC; ++rep)
        for (int uid = F.vcu; uid < 2048; uid += F.G) {
            const int i = uid >> 8, v = uid & 255, bh = 4 * (v >> 5) + (i >> 1), qb = (i & 1) * 32 + (v & 31), b = bh >> 2, h = bh & 3;
            const float slope2 = __builtin_amdgcn_exp2f(-2.0f * (float)(h + 1)) * LOG2E;
            int T0 = 0, NT = SEQ / 64;
            if (C_TILE_SKIP) {
                const unsigned* nq = (const unsigned*)(F.ctl + CW_NRM + L * 256) + (b * 2 + 0) * 16 + h * 4; const unsigned* nk = nq + 16;
                float R2 = 0.f;
#pragma unroll
                for (int c = 0; c < 2; ++c) R2 = fmaxf(R2, sqrtf(__uint_as_float(nq[c * 2]) * __uint_as_float(nk[c * 2])) + sqrtf(__uint_as_float(nq[c * 2 + 1]) * __uint_as_float(nk[c * 2 + 1])));
                const float Dstar = (C_TILE_SKIP == 1) ? (150.0f + 8.0f + 0.4f * R2) / slope2
                                                       : (120.0f * LOG2E + 2.0f * 1.02f * R2) / slope2;
                if (Dstar < 16384.f) {
                    const int D = (int)Dstar + 1, qlo = qb * 128, qhi = qb * 128 + 127;
                    int tlo = (qlo - D - 63 + 63) / 64; if (qlo - D - 63 <= 0) tlo = 0;
                    int thi = (qhi + D) / 64; if (thi > SEQ / 64 - 1) thi = SEQ / 64 - 1;
                    if (((thi - tlo + 1) & 1) != 0) { if (tlo > 0) --tlo; else ++thi; }
                    if (thi > SEQ / 64 - 1) { thi = SEQ / 64 - 1; if (((thi - tlo + 1) & 1) != 0) --tlo; }
                    if (thi - tlo + 1 >= 4 && tlo >= 0) { T0 = tlo; NT = thi - tlo + 1; }
                }
            }
            volatile LAS unsigned* badw = (volatile LAS unsigned*)(F.misc + MO_HIST);
            const bool bad = att::attnC_unit(F.PROJ, F.MIXED, F.subln + L * 128, b, h, qb, slope2, lam, 1.0f - lam_init, F.lds, wid, lane, T0, NT, badw);
            if (bad) (void)att::attnC_unit(F.PROJ, F.MIXED, F.subln + L * 128, b, h, qb, slope2, lam, 1.0f - lam_init, F.lds, wid, lane, 0, SEQ / 64, badw);
        }
    }
}

struct Args { const float* in[23]; float* out; unsigned char* ws; };
typedef const __attribute__((address_space(4))) Args* kargs_t;
__device__ __forceinline__ void refresh(Frame& F) {
    kargs_t ap = (kargs_t)__builtin_amdgcn_kernarg_segment_ptr(); asm volatile("" : "+s"(ap));
    int w = F.wave0; asm volatile("" : "+s"(w)); int l = lane_id(); asm volatile("" : "+v"(l));
    F.tid = w * 64 + l; F.lane = l; F.wave = w;
    unsigned char* ws = ap->ws;
    F.ctl = (gu32*)(ws + WS_CTL);
    F.x_in = ap->in[0]; F.c_in = ap->in[1]; F.w_ada = ap->in[2]; F.b_ada = ap->in[3]; F.norm1 = ap->in[4]; F.w_in = ap->in[5]; F.sinks = ap->in[6];
    F.lq1 = ap->in[7]; F.lk1 = ap->in[8]; F.lq2 = ap->in[9]; F.lk2 = ap->in[10]; F.subln = ap->in[11]; F.w_out = ap->in[12]; F.norm2 = ap->in[13];
    F.w_router = ap->in[14]; F.b_router = ap->in[15]; F.w_gate = ap->in[16]; F.b_gate = ap->in[17]; F.w_up = ap->in[18]; F.b_up = ap->in[19];
    F.w_down = ap->in[20]; F.b_down = ap->in[21]; F.norm_f = ap->in[22]; F.out = ap->out;
    F.modp = (float*)(ws + WS_MODP); F.mod = (float*)(ws + WS_MOD); F.ltok = (int*)(ws + WS_LTOK); F.lg = (float*)(ws + WS_LG);
    F.WIN = (bf16_t*)(ws + WS_WIN); F.WOUT = (bf16_t*)(ws + WS_WOUT); F.WGU = (bf16_t*)(ws + WS_WGU); F.WDN = (bf16_t*)(ws + WS_WDN);
    F.H = (bf16_t*)(ws + WS_H); F.PROJ = (bf16_t*)(ws + WS_R1); F.MIXED = (bf16_t*)(ws + WS_MIXED); F.HIDDEN = (bf16_t*)(ws + WS_R1); F.Y = (bf16_t*)(ws + WS_Y); F.XB = (bf16_t*)(ws + WS_XB); F.part = (float*)(ws + WS_PART); F.inv = (int*)(ws + WS_INV);
}
__global__ void __launch_bounds__(NTHREADS, 2) fwd_kernel(Args args) {
    extern __shared__ __attribute__((aligned(16))) unsigned char lds[];
    Frame F;
    F.lds = (LAS unsigned char*)lds; F.misc = F.lds + MISC_OFF;
    F.wave0 = __builtin_amdgcn_readfirstlane((int)threadIdx.x >> 6);
    F.G = gridDim.x; { const int bx = blockIdx.x; F.vcu = (F.G % 8 == 0) ? (bx % 8) * (F.G / 8) + bx / 8 : bx; }
    refresh(F);
    for (int u = F.tid; u < 256; u += NTHREADS) ((LAS unsigned*)F.misc)[u] = 0u;
    __syncthreads();
    XcdBarrier bar = xcd_barrier_post((unsigned*)(F.ctl + CW_BAR), (volatile LAS unsigned*)(F.misc + MO_BAR));
    (void)bar;
#define GRID_BAR() do { kargs_t ap_ = (kargs_t)__builtin_amdgcn_kernarg_segment_ptr(); asm volatile("" : "+s"(ap_)); XcdBarrier b_; \
        b_.bar = (unsigned*)(ap_->ws + WS_CTL) + CW_BAR; b_.x = xb_xcc_id(); b_.st = (volatile LAS unsigned*)(F.misc + MO_BAR); xcd_barrier(b_); } while (0)

#ifndef PH_MASK
#define PH_MASK 0xffff
#endif
#define PH(k) ((PH_MASK >> (k)) & 1)
#ifndef DUP_MASK
#define DUP_MASK 0
#endif
#define DUP(k) (1 + ((DUP_MASK >> (k)) & 1))
    if (PH(0)) { for (int rep = 0; rep < DUP(0); ++rep) { p0_prologue(F); __syncthreads(); } GRID_BAR();
    refresh(F); p0b_modsum(F); GRID_BAR(); }
    for (int L = 0; L < DEPTH; ++L) {
        refresh(F);
        if (PH(1)) { if (L == 0) p1_rows<0>(F, L); else p1_rows<1>(F, L); if (DUP(6) > 1) { __syncthreads(); if (L == 0) p1_rows<0>(F, L); else p1_rows<1>(F, L, 0.0f); } }
        const bool own_panels = false;
        if (own_panels) { VM_WAIT(); __syncthreads(); __builtin_amdgcn_fence(__ATOMIC_ACQUIRE, "agent"); VM_WAIT(); } else { GRID_BAR(); }
        refresh(F);
        if (PH(2)) for (int rep = 0; rep < DUP(1); ++rep) { pg8::Gemm g{F.H, F.WIN + (size_t)L * INW * DM, DM}; EpiProj E{F.PROJ, (unsigned*)(F.ctl + CW_NRM + L * 256)};
          if (own_panels) { pg8::PanelOrder S{INW / 256, NTOK / 256, F.G, F.vcu}; pg8::gemm_phase<EpiProj, pg8::PanelOrder, false>(F.lds, g, S, E, F.wave); }
          else { pg8::StaticOrder S; S.init(NTOK, INW, F.G, (int)blockIdx.x); pg8::gemm_phase<EpiProj, pg8::StaticOrder, false>(F.lds, g, S, E, F.wave); } }
        GRID_BAR();
        refresh(F);
        if (PH(3)) p3_attention<DUP(2), DUP(3)>(F, L);
        GRID_BAR();
        refresh(F);
        const bool own_panels4 = (F.G == NTOK / 256);
        if (PH(4)) for (int rep = 0; rep < DUP(7); ++rep) { pg8::Gemm g{F.MIXED, F.WOUT + (size_t)L * DM * DM, DM}; EpiOut E{F.XB, F.mod + (size_t)L * NBATCH * 6144 + 2 * DM, rep ? 0.0f : 1.0f};
          if (own_panels4) { pg8::PanelOrder S{DM / 256, NTOK / 256, F.G, F.vcu}; pg8::gemm_phase<EpiOut, pg8::PanelOrder, false>(F.lds, g, S, E, F.wave); }
          else { pg8::StaticOrder S; S.init(NTOK, DM, F.G, (int)blockIdx.x); pg8::gemm_phase<EpiOut, pg8::StaticOrder, false>(F.lds, g, S, E, F.wave); } }
        if (own_panels4) { VM_WAIT(); __syncthreads(); __builtin_amdgcn_fence(__ATOMIC_ACQUIRE, "agent"); VM_WAIT(); } else { GRID_BAR(); }
        refresh(F);
        if (PH(5)) { p5_route(F, L, L); if (DUP(8) > 1) { __syncthreads(); p5_route(F, L, L + 4); } }
        GRID_BAR();
        refresh(F);
        moe_table(F, L);
        if (PH(7)) for (int rep = 0; rep < DUP(4); ++rep) { const LAS int* tab = (const LAS int*)(F.misc + MO_TAB);
          pg8::Gemm g{F.H, (const bf16_t*)((const unsigned char*)F.WGU + (size_t)L * NE * 2048 * DM), DM / 2}; MoeSched S{tab, 3, tab[96], F.G, F.vcu, F.ltok};
          EpiGU E{(unsigned char*)F.HIDDEN, F.b_gate + (size_t)L * NE * DM, F.b_up + (size_t)L * NE * DM};
          pg8::gemm_phase<EpiGU, MoeSched, true, true>(F.lds, g, S, E, F.wave); }
        GRID_BAR();
        refresh(F);
        if (PH(8)) for (int rep = 0; rep < DUP(5); ++rep) { const LAS int* tab = (const LAS int*)(F.misc + MO_TAB);
          pg8::Gemm g{F.HIDDEN, (const bf16_t*)((const unsigned char*)F.WDN + (size_t)L * NE * DM * DM), DM / 2}; MoeSched S{tab, 2, tab[96], F.G, F.vcu, F.ltok};
          EpiDown E{(unsigned char*)F.Y, F.b_down + (size_t)L * NE * DM, tab, F.lg, F.misc + EPI_STG};
          pg8::gemm_phase<EpiDown, MoeSched, false, true>(F.lds, g, S, E, F.wave); }
        GRID_BAR();
    }
    refresh(F);
    if (PH(9)) p1_rows<2>(F, DEPTH);
}

extern "C" void kernel_launch(void* const* d_in, const int* in_sizes, int n_in, void* d_out, int out_size, void* d_ws, size_t ws_size, hipStream_t stream) {
    static int grid = 0;
    if (grid == 0) {
        if (n_in != 23 || in_sizes[0] != NTOK * DM || out_size != NTOK * DM || ws_size < WS_END) {
            fprintf(stderr, "kernel_launch: unexpected shapes/workspace: n_in %d in0 %d out %d ws %zu (need %zu); nothing launched\n", n_in, n_in > 0 ? in_sizes[0] : -1, out_size, ws_size, (size_t)WS_END); grid = -1; return; }
        int dev = 0, cus = 0, per_cu = 0;
        if (hipGetDevice(&dev) != hipSuccess || hipDeviceGetAttribute(&cus, hipDeviceAttributeMultiprocessorCount, dev) != hipSuccess) { grid = -1; return; }
        if (hipFuncSetAttribute((const void*)fwd_kernel, hipFuncAttributeMaxDynamicSharedMemorySize, LDS_BYTES) != hipSuccess) { fprintf(stderr, "kernel_launch: hipFuncSetAttribute failed\n"); grid = -1; return; }
        if (hipOccupancyMaxActiveBlocksPerMultiprocessor(&per_cu, (const void*)fwd_kernel, NTHREADS, LDS_BYTES) != hipSuccess || per_cu < 1)
            fprintf(stderr, "kernel_launch: note: occupancy query reports %d workgroups per CU\n", per_cu);
        (void)hipGetLastError();
        grid = cus;
    }
    if (grid < 0) return;
    if (hipMemsetAsync((char*)d_ws + WS_CTL, 0, CTL_ZERO_BYTES, stream) != hipSuccess) return;
    Args a{};
    for (int i = 0; i < 23; ++i) a.in[i] = (const float*)d_in[i];
    a.out = (float*)d_out; a.ws = (unsigned char*)d_ws;
    hipLaunchKernelGGL(fwd_kernel, dim3(grid), dim3(NTHREADS), LDS_BYTES, stream, a);
}
```

```cpp
#include <hip/hip_runtime.h>
#include <cstdio>
#include <cstdint>

#define LAS __attribute__((address_space(3)))
#define GAS __attribute__((address_space(1)))
typedef unsigned short bf16_t;
typedef short bf16x8 __attribute__((ext_vector_type(8)));
typedef short s16x4 __attribute__((ext_vector_type(4)));
typedef float f32x4 __attribute__((ext_vector_type(4)));
typedef float f32x2 __attribute__((ext_vector_type(2)));
typedef float f32x16 __attribute__((ext_vector_type(16)));
typedef unsigned u32x4 __attribute__((ext_vector_type(4)));
typedef unsigned u32x2 __attribute__((ext_vector_type(2)));
typedef GAS unsigned gu32;

constexpr int NBATCH = 8, SEQ = 8192, DM = 1024, NTOK = NBATCH * SEQ, DEPTH = 4;
constexpr int INW = 2816;
constexpr int C_QA = 0, C_KA = 256, C_VA = 512, C_QB = 768, C_KB = 1024, C_VB = 1152, C_QC = 1280, C_KC = 1792, C_VC = 2304;
constexpr int NE = 32, TOPK = 4, LCAP = NTOK;
constexpr float RMS_EPS = 1e-6f;
constexpr float LOG2E = 1.4426950408889634f;
constexpr float QSCALE = 0.125f * LOG2E;
constexpr int NWAVES = 8, NTHREADS = 512;
#ifndef C_TILE_SKIP
#define C_TILE_SKIP 1
#endif
constexpr int CW_NRM = 16384;

constexpr size_t MiB = 1u << 20;
constexpr size_t WS_CTL = 0, CTL_ZERO_BYTES = 1 * MiB;
constexpr size_t WS_MODP = 1 * MiB;
constexpr size_t WS_MOD = 4 * MiB;
constexpr size_t WS_LTOK = 5 * MiB;
constexpr size_t WS_LG = 13 * MiB;
constexpr size_t WS_WIN = 21 * MiB;
constexpr size_t WS_WOUT = 43 * MiB;
constexpr size_t WS_WGU = 51 * MiB;
constexpr size_t WS_WDN = 563 * MiB;
constexpr size_t WS_H = 819 * MiB;
constexpr size_t WS_R1 = 947 * MiB;
constexpr size_t WS_MIXED = WS_R1 + 352 * MiB;
constexpr size_t WS_Y = 1475 * MiB;
constexpr size_t WS_INV = WS_MODP;
constexpr size_t WS_XB = WS_Y + 264 * MiB;
constexpr size_t WS_PART = WS_XB + 128 * MiB;
constexpr size_t WS_END = 1987 * MiB;
static_assert(WS_PART + (size_t)NTOK * 4 * 68 * 4 <= WS_END, "d_ws map");
constexpr int CW_TMO = 0, CW_CODE = 1, CW_BAR = 4096, CW_CNT = 8192;

constexpr int RING_BYTES = 131072;
constexpr int BAND_WL = 16896;
constexpr int MISC_OFF = 8 * BAND_WL;
constexpr int EPI_STG = 1024, EPI_STG_ROW = 144, EPI_STG_GRP = 64 * EPI_STG_ROW;
constexpr int LDS_BYTES = MISC_OFF + EPI_STG + 2 * EPI_STG_GRP;
constexpr int MO_BAR = 0, MO_HIST = 64, MO_BASE = 192, MO_TAB = 320, MO_SELE = 1024, MO_SELG = 5120;

#define RLX_AGENT __ATOMIC_RELAXED, __HIP_MEMORY_SCOPE_AGENT
#define LDS_WAIT() asm volatile("s_waitcnt lgkmcnt(0)" ::: "memory")
#define VM_WAIT() asm volatile("s_waitcnt vmcnt(0)" ::: "memory")
__device__ __forceinline__ unsigned cvt_pk_bf16(float lo, float hi) { unsigned r; asm volatile("v_cvt_pk_bf16_f32 %0, %1, %2" : "=v"(r) : "v"(lo), "v"(hi)); return r; }
__device__ __forceinline__ unsigned f2bf(float f) { unsigned u = __builtin_bit_cast(unsigned, f); return (u + 0x7fffu + ((u >> 16) & 1u)) >> 16; }
__device__ __forceinline__ unsigned pk2(float lo, float hi) { return f2bf(lo) | (f2bf(hi) << 16); }
typedef int i32x8 __attribute__((ext_vector_type(8)));
typedef int i32x4 __attribute__((ext_vector_type(4)));
__device__ __forceinline__ unsigned pk4_fp8_nc(float a, float b, float c, float d) {
    unsigned w = 0u; w = (unsigned)__builtin_amdgcn_cvt_pk_fp8_f32(a, b, (int)w, false); w = (unsigned)__builtin_amdgcn_cvt_pk_fp8_f32(c, d, (int)w, true); return w;
}
__device__ __forceinline__ unsigned pk4_fp8(float a, float b, float c, float d) {
    a = fminf(fmaxf(a, -448.f), 448.f); b = fminf(fmaxf(b, -448.f), 448.f); c = fminf(fmaxf(c, -448.f), 448.f); d = fminf(fmaxf(d, -448.f), 448.f);
    unsigned w = 0u; w = (unsigned)__builtin_amdgcn_cvt_pk_fp8_f32(a, b, (int)w, false); w = (unsigned)__builtin_amdgcn_cvt_pk_fp8_f32(c, d, (int)w, true); return w;
}
constexpr float W8_SCALE = 64.f, H8_SCALE = 8.f, HID8_SCALE = 4.f, Y8_SCALE = 64.f;
__device__ __forceinline__ float bf_lo(unsigned u) { return __builtin_bit_cast(float, u << 16); }
__device__ __forceinline__ float bf_hi(unsigned u) { return __builtin_bit_cast(float, u & 0xffff0000u); }
__device__ __forceinline__ int lane_id() { unsigned ones = ~0u; asm volatile("" : "+s"(ones)); return (int)__builtin_amdgcn_mbcnt_hi(ones, __builtin_amdgcn_mbcnt_lo(ones, 0u)); }
template <int CTRL> __device__ __forceinline__ float dpp_mov(float v) { return __builtin_bit_cast(float, __builtin_amdgcn_update_dpp(0, __builtin_bit_cast(int, v), CTRL, 0xf, 0xf, true)); }
__device__ __forceinline__ float row16_sum(float v) { v += dpp_mov<0xB1>(v); v += dpp_mov<0x4E>(v); v += dpp_mov<0x141>(v); v += dpp_mov<0x140>(v); return v; }
__device__ __forceinline__ float row16_max(float v) { v = fmaxf(v, dpp_mov<0xB1>(v)); v = fmaxf(v, dpp_mov<0x4E>(v)); v = fmaxf(v, dpp_mov<0x141>(v)); v = fmaxf(v, dpp_mov<0x140>(v)); return v; }
__device__ __forceinline__ float x16_sum(float v) { const auto r = __builtin_amdgcn_permlane16_swap(__float_as_uint(v), __float_as_uint(v), false, false); return __uint_as_float(r[0]) + __uint_as_float(r[1]); }
__device__ __forceinline__ float x32_sum(float v) { const auto r = __builtin_amdgcn_permlane32_swap(__float_as_uint(v), __float_as_uint(v), false, false); return __uint_as_float(r[0]) + __uint_as_float(r[1]); }
__device__ __forceinline__ float wave_sum(float v) { return x32_sum(x16_sum(row16_sum(v))); }

__device__ __forceinline__ f32x4 pk_fma4(f32x4 a, f32x4 b, f32x4 c) { const f32x2 lo = __builtin_elementwise_fma((f32x2){a[0], a[1]}, (f32x2){b[0], b[1]}, (f32x2){c[0], c[1]}), hi = __builtin_elementwise_fma((f32x2){a[2], a[3]}, (f32x2){b[2], b[3]}, (f32x2){c[2], c[3]}); return (f32x4){lo[0], lo[1], hi[0], hi[1]}; }
__device__ __forceinline__ f32x4 pk_fma4s(f32x4 a, f32x2 s, f32x4 c) { const f32x2 lo = __builtin_elementwise_fma((f32x2){a[0], a[1]}, s, (f32x2){c[0], c[1]}), hi = __builtin_elementwise_fma((f32x2){a[2], a[3]}, s, (f32x2){c[2], c[3]}); return (f32x4){lo[0], lo[1], hi[0], hi[1]}; }
__device__ __forceinline__ f32x4 pk_mul4s(f32x4 a, f32x2 s) { const f32x2 lo = (f32x2){a[0], a[1]} * s, hi = (f32x2){a[2], a[3]} * s; return (f32x4){lo[0], lo[1], hi[0], hi[1]}; }

#define XB_TMO      128
#define XB_XCNT(j)  (256  + 64 * (j))
#define XB_XSUB(j)  (1280 + 64 * (j))
#define XB_XGEN(j)  (2304 + 64 * (j))
#define XB_TOP      3328
#define XB_TOPGEN   3392
#define XCD_BAR_WORDS 3456
#define XB_SPIN_CAP (1u << 20)

__device__ __forceinline__ unsigned xb_ld(unsigned* p)              { return __hip_atomic_load(p, __ATOMIC_RELAXED, __HIP_MEMORY_SCOPE_AGENT); }
__device__ __forceinline__ unsigned xb_add(unsigned* p, unsigned v) { return __hip_atomic_fetch_add(p, v, __ATOMIC_RELAXED, __HIP_MEMORY_SCOPE_AGENT); }
__device__ __forceinline__ unsigned xb_xcc_id() { return (unsigned)__builtin_amdgcn_s_getreg((3 << 11) | 20) & 0xFu; }
#define XB_SPIN(cond, bar) do { unsigned _sp = 0; while (cond) { __builtin_amdgcn_s_sleep(1); \
    if ((++_sp & 255u) == 0u) { if (xb_ld(&(bar)[XB_TMO])) break; if (_sp > XB_SPIN_CAP) { atomicAdd(&(bar)[XB_TMO], 1u); break; } } } } while (0)

struct XcdBarrier { unsigned* bar; unsigned x; volatile LAS unsigned* st; };
__device__ __forceinline__ XcdBarrier xcd_barrier_post(unsigned* bar, volatile LAS unsigned* st) {
    XcdBarrier b; b.bar = bar; b.x = xb_xcc_id(); b.st = st;
    if (threadIdx.x == 0) (void)xb_add(&bar[XB_XCNT(b.x)], 1u);
    return b;
}
__device__ __forceinline__ void xcd_barrier_complete(unsigned* bar, unsigned x, unsigned& nloc, unsigned& nx) {
    const unsigned G = gridDim.x * gridDim.y * gridDim.z;
    unsigned sum, cnt, mine, sp = 0u;
    for (;;) {
        sum = 0u; cnt = 0u; mine = 0u;
#pragma unroll
        for (unsigned j = 0; j < 16; ++j) { const unsigned c = xb_ld(&bar[XB_XCNT(j)]); sum += c; cnt += (c > 0u) ? 1u : 0u; mine = (j == x) ? c : mine; }
        if (sum == G) break;
        __builtin_amdgcn_s_sleep(1);
        if ((++sp & 255u) == 0u) { if (xb_ld(&bar[XB_TMO])) break; if (sp > XB_SPIN_CAP) { atomicAdd(&bar[XB_TMO], 1u); break; } }
    }
    nloc = mine > 0u ? mine : 1u; nx = cnt > 0u ? cnt : 1u;
}
__device__ __forceinline__ void xcd_barrier(const XcdBarrier& b) {
    asm volatile("s_waitcnt vmcnt(0)" ::: "memory");
    __syncthreads();
    if (threadIdx.x == 0) {
        unsigned* bar = b.bar;
        __builtin_amdgcn_s_waitcnt(0);
        unsigned nloc = b.st[0], nx = b.st[1];
        if (nloc == 0u) { xcd_barrier_complete(bar, b.x, nloc, nx); b.st[0] = nloc; b.st[1] = nx; }
        const unsigned old = xb_add(&bar[XB_XSUB(b.x)], 1u);
        const unsigned gen = old / nloc;
        if (old + 1u == (gen + 1u) * nloc) {
            __builtin_amdgcn_fence(__ATOMIC_RELEASE, "agent");
            asm volatile("s_waitcnt vmcnt(0)" ::: "memory");
            const unsigned og = xb_add(&bar[XB_TOP], 1u);
            const unsigned tg = og / nx;
            if (og + 1u == (tg + 1u) * nx) xb_add(&bar[XB_TOPGEN], 1u);
            else XB_SPIN(xb_ld(&bar[XB_TOPGEN]) == tg, bar);
            __builtin_amdgcn_fence(__ATOMIC_ACQUIRE, "agent");
            xb_add(&bar[XB_XGEN(b.x)], 1u);
            asm volatile("s_waitcnt vmcnt(0)" ::: "memory");
        } else {
            XB_SPIN(xb_ld(&bar[XB_XGEN(b.x)]) == gen, bar);
            __builtin_amdgcn_fence(__ATOMIC_ACQUIRE, "agent");
            asm volatile("s_waitcnt vmcnt(0)" ::: "memory");
        }
    }
    __syncthreads();
}

__device__ __forceinline__ unsigned ld_untracked(const void* p) { unsigned v; asm volatile("global_load_dword %0, %1, off" : "=v"(v) : "v"(p) : "memory"); return v; }
namespace pg8 {
constexpr int BM = 256, BK = 64, HALF = 128, HTB = HALF * BK * 2, STAGE_BYTES = 8 * HTB, NXCD = 8, WGM = 8;
__host__ __device__ __forceinline__ int lds_byte(int r, int c) { const int st = (r >> 4) * 2 + (c >> 5), rr = r & 15, cc = c & 31, ob = rr * 64 + cc * 2; return st * 1024 + (ob ^ (((ob >> 9) & 1) << 5)); }
__host__ __device__ __forceinline__ void stage_rc(int b, int& R, int& C) { const int st = b / 1024, sb = b % 1024, swz = sb ^ (((sb >> 9) & 1) << 5); R = (st >> 1) * 16 + swz / 64; C = (st & 1) * 32 + (swz % 64) / 2; }
__host__ __device__ __forceinline__ int perm32(int rho) { const int n = rho >> 4, i = rho & 15; return 8 * (i >> 2) + 4 * n + (i & 3); }

struct Unit { int pm, pn; };
struct Gemm { const bf16_t* A; const bf16_t* Bt; int K; };

struct StaticOrder {
    int nM, nN, nwg, G, c;
    __device__ void init(int M, int N, int G_, int c_) { nM = M / BM; nN = N / BM; nwg = nM * nN; G = G_; c = c_; }
    __device__ bool next(int i, Unit& u) const {
        const long L = (long)i * G + c; if (L >= nwg) return false;
        int wgid = (int)L; { const int q = nwg / NXCD, r = nwg % NXCD, xcd = wgid % NXCD, off = wgid / NXCD; wgid = (xcd < r ? xcd * (q + 1) : r * (q + 1) + (xcd - r) * q) + off; }
        const int nig = WGM * nN, gid = wgid / nig, fm = gid * WGM, gsz = (nM - fm) < WGM ? (nM - fm) : WGM;
        u.pm = fm + ((wgid % nig) % gsz); u.pn = (wgid % nig) / gsz; return true;
    }
    __device__ __forceinline__ unsigned arow(const Unit&, int) const { return 0u; }
    __device__ __forceinline__ unsigned arow_raw(const Unit&, int) const { return 0u; }
};

struct PanelOrder {
    int nN, nP, G, vcu;
    __device__ bool next(int i, Unit& u) const { const int p = vcu + (i / nN) * G; if (p >= nP) return false; u.pm = p; u.pn = i % nN; return true; }
    __device__ __forceinline__ unsigned arow(const Unit&, int) const { return 0u; }
    __device__ __forceinline__ unsigned arow_raw(const Unit&, int) const { return 0u; }
};
template <int N> __device__ __forceinline__ void wait_v() { asm volatile("s_waitcnt vmcnt(%0)" :: "n"(N) : "memory"); }
template <class Epi, class Sched, bool GATHER, bool FP8 = false>
__device__ __forceinline__ void gemm_phase(LAS unsigned char* lds, const Gemm g, const Sched& S, const Epi& E, int wave_in) {
    int tid_ = wave_in * 64 + lane_id(); asm volatile("" : "+v"(tid_));
    const int tid = tid_, wid = __builtin_amdgcn_readfirstlane(tid >> 6), lane = tid & 63, wr = wid >> 2, wc = wid & 3, fr = lane & 15, fq = lane >> 4;
    int K_ = g.K; asm volatile("" : "+s"(K_));
    const int K = K_, nt = K / BK;
    unsigned voffA[2], voffB[2]; int Rr[2], Cb[2];
#pragma unroll
    for (int i = 0; i < 2; ++i) { int R, C; stage_rc(tid * 16 + i * 8192, R, C); const int Rb = Epi::PERM ? ((R & ~31) + perm32(R & 31)) : R;
        Rr[i] = R; Cb[i] = C * 2; voffA[i] = (unsigned)(R * K + C) * 2u; voffB[i] = (unsigned)(Rb * K + C) * 2u; }
    const size_t kstep = (size_t)(BK * 2);
    const size_t hstep = (size_t)HALF * K * 2;
    const size_t tstep = 2 * hstep;
    const unsigned ldsw = (unsigned)wid * 1024u;
    const int aoff = lds_byte(wr * 64 + fr, fq * 8), boff = lds_byte(wc * 32 + fr, fq * 8);
#define PG8_SA(b, h) (((b) * 2 + (h)) * HTB)
#define PG8_SB(b, h) ((4 + (b) * 2 + (h)) * HTB)
#define PG8_STAGE(bufoff, gbase, voff) do { _Pragma("unroll") for (int _i = 0; _i < 2; ++_i) \
        __builtin_amdgcn_global_load_lds((const unsigned*)((const char*)(gbase) + (voff)[_i]), (LAS unsigned*)(lds + (bufoff) + ldsw + _i * 8192), 16, 0, 0); } while (0)
#define PG8_STGA(b, h, base, vs) do { if constexpr (GATHER) { PG8_STAGE(PG8_SA(b, h), (base), vs[h]); } else { PG8_STAGE(PG8_SA(b, h), (base) + (h) * hstep, voffA); } } while (0)
#define PG8_LDA(dst, b, h) do { _Pragma("unroll") for (int m = 0; m < 4; ++m) _Pragma("unroll") for (int k = 0; k < 2; ++k) dst[m][k] = *(const LAS bf16x8*)(lds + PG8_SA(b, h) + aoff + m * 2048 + k * 1024); } while (0)
#define PG8_LDB(dst, b, h) do { _Pragma("unroll") for (int n = 0; n < 2; ++n) _Pragma("unroll") for (int k = 0; k < 2; ++k) dst[n][k] = *(const LAS bf16x8*)(lds + PG8_SB(b, h) + boff + n * 2048 + k * 1024); } while (0)
#define PG8_CAT(x, y) __builtin_shufflevector(__builtin_bit_cast(i32x4, (x)), __builtin_bit_cast(i32x4, (y)), 0, 1, 2, 3, 4, 5, 6, 7)
#define PG8_MMA(ai, bj, At, Bt) do { __builtin_amdgcn_s_setprio(1); \
        if constexpr (FP8) { _Pragma("unroll") for (int m = 0; m < 4; ++m) _Pragma("unroll") for (int n = 0; n < 2; ++n) \
            { const i32x8 a8_ = PG8_CAT(Bt[n][0], Bt[n][1]), b8_ = PG8_CAT(At[m][0], At[m][1]); \
              asm volatile("v_mfma_scale_f32_16x16x128_f8f6f4 %0, %1, %2, %0, %3, %3 op_sel_hi:[0,0,0]" : "+v"(acc[ai][bj][m][n]) : "v"(a8_), "v"(b8_), "v"(one8)); } } \
        else { _Pragma("unroll") for (int m = 0; m < 4; ++m) _Pragma("unroll") for (int n = 0; n < 2; ++n) _Pragma("unroll") for (int k = 0; k < 2; ++k) \
            acc[ai][bj][m][n] = __builtin_amdgcn_mfma_f32_16x16x32_bf16(Bt[n][k], At[m][k], acc[ai][bj][m][n], 0, 0, 0); } \
        __builtin_amdgcn_s_setprio(0); } while (0)
#define PG8_PIECE(bufoff, gbase, voff, i) __builtin_amdgcn_global_load_lds((const unsigned*)((const char*)(gbase) + (voff)[i]), (LAS unsigned*)(lds + (bufoff) + ldsw + (i) * 8192), 16, 0, 0)
#define PG8_PCA(b, h, base, vs, i) do { if constexpr (GATHER) { PG8_PIECE(PG8_SA(b, h), (base), vs[h], i); } else { PG8_PIECE(PG8_SA(b, h), (base) + (h) * hstep, voffA, i); } PG8_SCHED; } while (0)
#define PG8_PCB(b, h, base, i) do { PG8_PIECE(PG8_SB(b, h), (base) + (h) * hstep, voffB, i); PG8_SCHED; } while (0)
#define PG8_MMAH(ai, bj, At, Bt, HK) do { __builtin_amdgcn_s_setprio(1); \
        if constexpr (FP8) { _Pragma("unroll") for (int m = 0; m < 4; ++m) _Pragma("unroll") for (int n = 0; n < 2; ++n) \
            { const i32x8 a8_ = PG8_CAT(Bt[n][0], Bt[n][1]), b8_ = PG8_CAT(At[m][0], At[m][1]); \
              asm volatile("v_mfma_scale_f32_16x16x128_f8f6f4 %0, %1, %2, %0, %3, %3 op_sel_hi:[0,0,0]" : "+v"(acc[ai][bj][m][n]) : "v"(a8_), "v"(b8_), "v"(one8)); HK(m * 2 + n); } } \
        else { _Pragma("unroll") for (int k = 0; k < 2; ++k) _Pragma("unroll") for (int m = 0; m < 4; ++m) { _Pragma("unroll") for (int n = 0; n < 2; ++n) \
            acc[ai][bj][m][n] = __builtin_amdgcn_mfma_f32_16x16x32_bf16(Bt[n][k], At[m][k], acc[ai][bj][m][n], 0, 0, 0); HK(k * 4 + m); } } \
        __builtin_amdgcn_s_setprio(0); } while (0)
#define PG8_WAIT_V(n) asm volatile("s_waitcnt vmcnt(" #n ")" ::: "memory")
#define PG8_WAIT_L(n) asm volatile("s_waitcnt lgkmcnt(" #n ")" ::: "memory")
#define PG8_BAR __builtin_amdgcn_s_barrier()
#define PG8_SCHED __builtin_amdgcn_sched_barrier(0)
    Unit cur, nxt; int ui = 0;
    if (!S.next(0, cur)) return;
    int one8 = 0x7f7f7f7f; asm volatile("" : "+v"(one8));
    f32x4 acc[2][2][4][2];
#pragma unroll
    for (int a = 0; a < 2; ++a)
#pragma unroll
        for (int b = 0; b < 2; ++b)
#pragma unroll
            for (int m = 0; m < 4; ++m)
#pragma unroll
                for (int n = 0; n < 2; ++n) acc[a][b][m][n] = (f32x4){0.f, 0.f, 0.f, 0.f};
    bf16x8 At[4][2], B0[2][2], B1[2][2];
    unsigned vc[2][2], vn[2][2], v2[2][2];
#pragma unroll
    for (int h = 0; h < 2; ++h)
#pragma unroll
        for (int i = 0; i < 2; ++i) { vc[h][i] = GATHER ? S.arow(cur, h * HALF + Rr[i]) * (unsigned)(K * 2) + (unsigned)Cb[i] : 0u; vn[h][i] = vc[h][i]; v2[h][i] = vc[h][i]; }
    const char* cA = GATHER ? (const char*)g.A : (const char*)g.A + (size_t)cur.pm * tstep; const char* cB = (const char*)g.Bt + (size_t)cur.pn * tstep;
    PG8_STAGE(PG8_SB(0, 0), cB, voffB); PG8_STAGE(PG8_SB(0, 1), cB + hstep, voffB); PG8_STGA(0, 0, cA, vc); PG8_STGA(0, 1, cA, vc);
    if (wr == 1) PG8_BAR;
    PG8_WAIT_V(2); PG8_BAR;
    constexpr bool PEEL = FP8;
    PG8_STAGE(PG8_SB(1, 0), cB + kstep, voffB); PG8_STGA(1, 0, cA + kstep, vc); PG8_STAGE(PG8_SB(1, 1), cB + hstep + kstep, voffB);
    PG8_STGA(1, 1, cA + kstep, vc); PG8_WAIT_V(8);
    PG8_BAR;
    constexpr int XW = Epi::NVM + Epi::NPRE + (GATHER ? 4 : 0);
    { LAS unsigned* dump = (LAS unsigned*)(lds + STAGE_BYTES + (unsigned)wave_in * 256u);
#pragma unroll
      for (int s_ = 0; s_ < Epi::NVM; ++s_) __builtin_amdgcn_global_load_lds((const unsigned*)g.Bt, dump, 4, 0, 0); }
#define PG8_ITER(FIRST) do { \
            const bool last = !(FIRST) && (t == nt - 2); \
            const char* a1 = cA + (size_t)(t + 1) * kstep; \
            const char* a2 = last ? nA : cA + (size_t)(t + 2) * kstep; const char* b2 = last ? nB : cB + (size_t)(t + 2) * kstep; \
            const char* a3 = a2 + kstep; const char* b3 = b2 + kstep; \
            if (GATHER) { \
                _Pragma("unroll") for (int h = 0; h < 2; ++h) _Pragma("unroll") for (int i = 0; i < 2; ++i) v2[h][i] = last ? vn[h][i] : vc[h][i]; \
            } \
              \
            PG8_LDB(B0, 0, 0); PG8_LDB(B1, 0, 1); PG8_SCHED; PG8_LDA(At, 0, 0); if (!(FIRST)) PG8_STGA(1, 1, a1, vc); \
            if (FIRST) wait_v<8 + XW>(); else wait_v<8>(); PG8_WAIT_L(0); PG8_BAR; PG8_MMA(0, 0, At, B0); PG8_MMA(0, 1, At, B1); PG8_BAR; PG8_SCHED; \
              \
            PG8_LDA(At, 0, 1); PG8_STAGE(PG8_SB(0, 0), b2, voffB); PG8_STAGE(PG8_SB(0, 1), b2 + hstep, voffB); PG8_STGA(0, 0, a2, v2); \
            if (FIRST) wait_v<8 + XW>(); else wait_v<8>(); PG8_WAIT_L(0); PG8_BAR; PG8_MMA(1, 0, At, B0); PG8_MMA(1, 1, At, B1); PG8_BAR; PG8_SCHED; \
              \
            PG8_LDB(B0, 1, 0); PG8_LDB(B1, 1, 1); PG8_SCHED; PG8_LDA(At, 1, 0); PG8_STGA(0, 1, a2, v2); \
            if (FIRST) wait_v<8 + XW>(); else wait_v<8>(); PG8_WAIT_L(0); PG8_BAR; PG8_MMA(0, 0, At, B0); PG8_MMA(0, 1, At, B1); PG8_BAR; PG8_SCHED; \
              \
            PG8_LDA(At, 1, 1); PG8_STAGE(PG8_SB(1, 0), b3, voffB); PG8_STAGE(PG8_SB(1, 1), b3 + hstep, voffB); PG8_STGA(1, 0, a3, v2); \
            PG8_WAIT_V(8); PG8_WAIT_L(0); PG8_BAR; PG8_MMA(1, 0, At, B0); PG8_MMA(1, 1, At, B1); PG8_BAR; PG8_SCHED; \
        } while (0)
#define PG8_H1A(j) if ((j) == 3 && !(FIRST_)) PG8_PCA(1, 1, a1, vc, 0)
#define PG8_H1B(j) if ((j) == 3 && !(FIRST_)) PG8_PCA(1, 1, a1, vc, 1)
#define PG8_H2A(j) if ((j) == 1) PG8_PCB(0, 0, b2, 0); else if ((j) == 3) PG8_PCB(0, 0, b2, 1); else if ((j) == 5) PG8_PCB(0, 1, b2, 0)
#define PG8_H2B(j) if ((j) == 1) PG8_PCB(0, 1, b2, 1); else if ((j) == 3) PG8_PCA(0, 0, a2, v2, 0); else if ((j) == 5) PG8_PCA(0, 0, a2, v2, 1)
#define PG8_H3A(j) if ((j) == 3) PG8_PCA(0, 1, a2, v2, 0)
#define PG8_H3B(j) if ((j) == 3) PG8_PCA(0, 1, a2, v2, 1)
#define PG8_H4A(j) if ((j) == 1) PG8_PCB(1, 0, b3, 0); else if ((j) == 3) PG8_PCB(1, 0, b3, 1); else if ((j) == 5) PG8_PCB(1, 1, b3, 0)
#define PG8_H4B(j) if ((j) == 1) PG8_PCB(1, 1, b3, 1); else if ((j) == 3) PG8_PCA(1, 0, a3, v2, 0); else if ((j) == 5) PG8_PCA(1, 0, a3, v2, 1)
#define PG8_ITER2(FIRST) do { \
            const bool FIRST_ = (FIRST); \
            const bool last = !(FIRST) && (t == nt - 2); \
            const char* a1 = cA + (size_t)(t + 1) * kstep; \
            const char* a2 = last ? nA : cA + (size_t)(t + 2) * kstep; const char* b2 = last ? nB : cB + (size_t)(t + 2) * kstep; \
            const char* a3 = a2 + kstep; const char* b3 = b2 + kstep; \
            if (GATHER) { \
                _Pragma("unroll") for (int h = 0; h < 2; ++h) _Pragma("unroll") for (int i = 0; i < 2; ++i) v2[h][i] = last ? vn[h][i] : vc[h][i]; \
            } \
            PG8_LDB(B0, 0, 0); PG8_LDB(B1, 0, 1); PG8_SCHED; PG8_LDA(At, 0, 0); \
            if (FIRST) wait_v<8 + XW>(); else wait_v<6>(); PG8_WAIT_L(0); PG8_BAR; PG8_MMAH(0, 0, At, B0, PG8_H1A); PG8_MMAH(0, 1, At, B1, PG8_H1B); PG8_BAR; PG8_SCHED; \
            PG8_LDA(At, 0, 1); \
            if (FIRST) wait_v<2 + XW>(); else wait_v<2>(); PG8_WAIT_L(0); PG8_BAR; PG8_MMAH(1, 0, At, B0, PG8_H2A); PG8_MMAH(1, 1, At, B1, PG8_H2B); PG8_BAR; PG8_SCHED; \
            PG8_LDB(B0, 1, 0); PG8_LDB(B1, 1, 1); PG8_SCHED; PG8_LDA(At, 1, 0); \
            if (FIRST) wait_v<6 + XW>(); else wait_v<6>(); PG8_WAIT_L(0); PG8_BAR; PG8_MMAH(0, 0, At, B0, PG8_H3A); PG8_MMAH(0, 1, At, B1, PG8_H3B); PG8_BAR; PG8_SCHED; \
            PG8_LDA(At, 1, 1); \
            wait_v<2>(); PG8_WAIT_L(0); PG8_BAR; PG8_MMAH(1, 0, At, B0, PG8_H4A); PG8_MMAH(1, 1, At, B1, PG8_H4B); PG8_BAR; PG8_SCHED; \
        } while (0)
    constexpr bool MD = FP8;
#define PG8_IT(FIRST) do { if constexpr (MD) PG8_ITER2(FIRST); else PG8_ITER(FIRST); } while (0)
    for (;;) {
        const bool has_next = S.next(ui + 1, nxt);
        if (GATHER && has_next && !PEEL) {
            int t2 = wave_in * 64 + lane_id(); asm volatile("" : "+v"(t2));
#pragma unroll
            for (int i = 0; i < 2; ++i) { int R, C; stage_rc(t2 * 16 + i * 8192, R, C);
#pragma unroll
                for (int h = 0; h < 2; ++h) vn[h][i] = S.arow(nxt, h * HALF + R) * (unsigned)(K * 2) + (unsigned)(C * 2); }
        }
        if (GATHER && PEEL) {
            int t2 = wave_in * 64 + lane_id(); asm volatile("" : "+v"(t2));
#pragma unroll
            for (int i = 0; i < 2; ++i) { int R, C; stage_rc(t2 * 16 + i * 8192, R, C);
#pragma unroll
                for (int h = 0; h < 2; ++h) vn[h][i] = S.arow_raw(has_next ? nxt : cur, h * HALF + R); }
        }
        typename Epi::Pre pre = E.preload(cur, wr, wc, fr, fq);
        const char* nA = has_next ? (GATHER ? (const char*)g.A : (const char*)g.A + (size_t)nxt.pm * tstep) : cA; const char* nB = has_next ? (const char*)g.Bt + (size_t)nxt.pn * tstep : cB;
        if constexpr (PEEL) { int t = 0; PG8_IT(true); }
        if (GATHER && PEEL) {
            int t2 = wave_in * 64 + lane_id(); asm volatile("" : "+v"(t2));
#pragma unroll
            for (int i = 0; i < 2; ++i) { int R, C; stage_rc(t2 * 16 + i * 8192, R, C);
#pragma unroll
                for (int h = 0; h < 2; ++h) vn[h][i] = (vn[h][i] >> 2) * (unsigned)(K * 2) + (unsigned)(C * 2); }
        }
        if constexpr (PEEL) {
#pragma unroll 1
            for (int t = 2; t < nt; t += 2) PG8_IT(false); }
        else {
#pragma unroll 1
            for (int t = 0; t < nt; t += 2) PG8_IT(t == 0); }
        PG8_STGA(1, 1, nA + kstep, vn);
        if (wr == 0) PG8_BAR;
        if constexpr (FP8) asm volatile("s_nop 15\n\ts_nop 15" ::: "memory");
        E(acc, cur, wr, wc, fr, fq, pre);
        if (!has_next) break;
#pragma unroll
        for (int a = 0; a < 2; ++a)
#pragma unroll
            for (int b = 0; b < 2; ++b)
#pragma unroll
                for (int m = 0; m < 4; ++m)
#pragma unroll
                    for (int n = 0; n < 2; ++n) acc[a][b][m][n] = (f32x4){0.f, 0.f, 0.f, 0.f};
        cur = nxt; cA = nA; cB = nB; ++ui;
#pragma unroll
        for (int h = 0; h < 2; ++h)
#pragma unroll
            for (int i = 0; i < 2; ++i) vc[h][i] = vn[h][i];
        if (wr == 1) PG8_BAR;
    }
    PG8_WAIT_V(0);
    PG8_BAR;
#undef PG8_SA
#undef PG8_SB
#undef PG8_STAGE
#undef PG8_STGA
#undef PG8_LDA
#undef PG8_LDB
#undef PG8_MMA
#undef PG8_CAT
#undef PG8_WAIT_V
#undef PG8_WAIT_L
#undef PG8_BAR
#undef PG8_SCHED
#undef PG8_ITER
#undef PG8_ITER2
#undef PG8_IT
#undef PG8_PIECE
#undef PG8_PCA
#undef PG8_PCB
#undef PG8_MMAH
#undef PG8_H1A
#undef PG8_H1B
#undef PG8_H2A
#undef PG8_H2B
#undef PG8_H3A
#undef PG8_H3B
#undef PG8_H4A
#undef PG8_H4B
}
}

struct Frame {
    LAS unsigned char* lds;
    LAS unsigned char* misc;
    gu32* ctl;
    int tid, lane, wave, vcu, G, wave0;
    const float *x_in, *c_in, *w_ada, *b_ada, *norm1, *w_in, *sinks, *lq1, *lk1, *lq2, *lk2, *subln, *w_out, *norm2, *w_router, *b_router, *w_gate, *b_gate, *w_up, *b_up, *w_down, *b_down, *norm_f;
    float* out;
    float *modp, *mod, *part; int* ltok; float* lg; int* inv;
    bf16_t *WIN, *WOUT, *WGU, *WDN, *H, *PROJ, *MIXED, *HIDDEN, *Y, *XB;
};

__device__ __forceinline__ void p0_transpose_tile(const float* src, int N, bf16_t* dst, int ldd, LAS float* scr, int lane) {
#pragma unroll
    for (int i = 0; i < 32; ++i) { const int kk = 2 * i + (lane >> 5); scr[kk * 33 + (lane & 31)] = src[(size_t)kk * N + (lane & 31)]; }
    LDS_WAIT(); asm volatile("" ::: "memory");
    const int c = lane & 7;
#pragma unroll
    for (int j = 0; j < 4; ++j) { const int n = (lane >> 3) + 8 * j; const LAS float* s = scr + (8 * c) * 33 + n;
        u32x4 o; o.x = pk2(s[0 * 33], s[1 * 33]); o.y = pk2(s[2 * 33], s[3 * 33]); o.z = pk2(s[4 * 33], s[5 * 33]); o.w = pk2(s[6 * 33], s[7 * 33]);
        *(GAS u32x4*)(dst + (size_t)n * ldd + 8 * c) = o; }
    LDS_WAIT(); asm volatile("" ::: "memory");
}
__device__ __forceinline__ void p0_transpose_tile8(const float* src, int N, unsigned char* dst, int ldd, LAS float* scr, int lane) {
#pragma unroll
    for (int i = 0; i < 32; ++i) { const int kk = 2 * i + (lane >> 5); scr[kk * 33 + (lane & 31)] = src[(size_t)kk * N + (lane & 31)]; }
    LDS_WAIT(); asm volatile("" ::: "memory");
    const int c = lane & 7;
#pragma unroll
    for (int j = 0; j < 4; ++j) { const int n = (lane >> 3) + 8 * j; const LAS float* s = scr + (8 * c) * 33 + n;
        u32x2 o; o.x = pk4_fp8(s[0 * 33] * W8_SCALE, s[1 * 33] * W8_SCALE, s[2 * 33] * W8_SCALE, s[3 * 33] * W8_SCALE); o.y = pk4_fp8(s[4 * 33] * W8_SCALE, s[5 * 33] * W8_SCALE, s[6 * 33] * W8_SCALE, s[7 * 33] * W8_SCALE);
        *(GAS u32x2*)(dst + (size_t)n * ldd + 8 * c) = o; }
    LDS_WAIT(); asm volatile("" ::: "memory");
}
__device__ __forceinline__ void p0_prologue(Frame& F) {
    LAS float* cond = (LAS float*)F.lds;
    for (int i = F.tid; i < NBATCH * DM; i += NTHREADS) { const float v = F.c_in[i]; cond[i] = v / (1.f + __expf(-v)); }
    __syncthreads();
    LAS float* scr = (LAS float*)(F.lds + 32768 + F.wave * 8448);
    const int gw = F.vcu * NWAVES + F.wave, NGW = F.G * NWAVES;
    constexpr int I_MOD = DEPTH * 24 * 4;
    constexpr int I_IN = DEPTH * 16 * 88, I_OUT = DEPTH * 16 * 32, I_E = DEPTH * NE * 16 * 32;
    constexpr int NITEMS = I_MOD + I_IN + I_OUT + 3 * I_E;
    for (int it = gw; it < NITEMS; it += NGW) {
        int r = it;
        if (r < I_MOD) {
            const int kq = r & 3, cg = (r >> 2) % 24, L = (r >> 2) / 24, col = cg * 256 + 4 * F.lane;
            f32x4 acc[NBATCH];
#pragma unroll
            for (int b = 0; b < NBATCH; ++b) acc[b] = (f32x4){0.f, 0.f, 0.f, 0.f};
            const float* wp = F.w_ada + ((size_t)L * DM + kq * 256) * 6144 + col;
            for (int k4 = 0; k4 < 64; ++k4) {
                f32x4 w[4];
#pragma unroll
                for (int j = 0; j < 4; ++j) w[j] = *(const GAS f32x4*)(wp + (size_t)(k4 * 4 + j) * 6144);
#pragma unroll
                for (int b = 0; b < NBATCH; ++b) { const f32x4 cv = *(const LAS f32x4*)(cond + b * DM + kq * 256 + k4 * 4);
                    acc[b] += w[0] * cv.x + w[1] * cv.y + w[2] * cv.z + w[3] * cv.w; }
            }
#pragma unroll
            for (int b = 0; b < NBATCH; ++b) *(GAS f32x4*)(F.modp + (((size_t)kq * DEPTH + L) * NBATCH + b) * 6144 + col) = acc[b];
            continue;
        }
        r -= I_MOD;
        if (r < I_IN) { const int L = r / (16 * 88), q = r % (16 * 88), kb = q / 88, nb = q % 88;
            p0_transpose_tile(F.w_in + ((size_t)L * DM + kb * 64) * INW + nb * 32, INW, F.WIN + ((size_t)L * INW + nb * 32) * DM + kb * 64, DM, scr, F.lane); continue; }
        r -= I_IN;
        if (r < I_OUT) { const int L = r / 512, q = r % 512, kb = q / 32, nb = q % 32;
            p0_transpose_tile(F.w_out + ((size_t)L * DM + kb * 64) * DM + nb * 32, DM, F.WOUT + ((size_t)L * DM + nb * 32) * DM + kb * 64, DM, scr, F.lane); continue; }
        r -= I_OUT;
        { const int which = r / I_E, q0 = r % I_E, le = q0 / 512, q = q0 % 512, kb = q / 32, nb = q % 32, n0 = nb * 32;
          unsigned char* WGU8 = (unsigned char*)F.WGU; unsigned char* WDN8 = (unsigned char*)F.WDN;
          if (which == 0) p0_transpose_tile8(F.w_gate + ((size_t)le * DM + kb * 64) * DM + n0, DM, WGU8 + ((size_t)le * 2048 + (n0 >> 7) * 256 + (n0 & 127)) * DM + kb * 64, DM, scr, F.lane);
          else if (which == 1) p0_transpose_tile8(F.w_up + ((size_t)le * DM + kb * 64) * DM + n0, DM, WGU8 + ((size_t)le * 2048 + (n0 >> 7) * 256 + 128 + (n0 & 127)) * DM + kb * 64, DM, scr, F.lane);
          else p0_transpose_tile8(F.w_down + ((size_t)le * DM + kb * 64) * DM + n0, DM, WDN8 + ((size_t)le * DM + n0) * DM + kb * 64, DM, scr, F.lane); }
    }
}
__device__ __forceinline__ void p0b_modsum(Frame& F) {
    const int gt = F.vcu * NTHREADS + F.tid, NGT = F.G * NTHREADS;
    for (int i = gt; i < DEPTH * NBATCH * 6144 / 4; i += NGT) {
        const int e = i * 4, L = e / (NBATCH * 6144), j = e % 6144;
        f32x4 s = *(const GAS f32x4*)(F.b_ada + (size_t)L * 6144 + j);
#pragma unroll
        for (int kq = 0; kq < 4; ++kq) s += *(const GAS f32x4*)(F.modp + (size_t)kq * DEPTH * NBATCH * 6144 + e);
        *(GAS f32x4*)(F.mod + e) = s;
    }
}

template <int MODE>
__device__ __forceinline__ void p1_rows(Frame& F, int L, float g2mul = 1.0f) {
    const int gw = F.vcu * NWAVES + F.wave, NGW = F.G * NWAVES, lane = F.lane;
    const float* gain = (MODE == 2) ? F.norm_f : F.norm1 + (size_t)L * DM;
    f32x4 gn[4];
#pragma unroll
    for (int j = 0; j < 4; ++j) gn[j] = *(const GAS f32x4*)(gain + 4 * lane + 256 * j);
    for (int chunk = gw; chunk < NTOK / 32; chunk += NGW) {
        const int m0 = chunk * 32, b = m0 >> 13;
        f32x4 sc[4], sh[4], g2[4];
#pragma unroll
        for (int j = 0; j < 4; ++j) {
            if (MODE != 2) { const float* mp = F.mod + ((size_t)L * NBATCH + b) * 6144; sh[j] = *(const GAS f32x4*)(mp + 0 * DM + 4 * lane + 256 * j); sc[j] = *(const GAS f32x4*)(mp + 1 * DM + 4 * lane + 256 * j); }
            if (MODE != 0) { const float* mq = F.mod + ((size_t)(L - 1) * NBATCH + b) * 6144; g2[j] = *(const GAS f32x4*)(mq + 5 * DM + 4 * lane + 256 * j) * (g2mul * (1.0f / Y8_SCALE)); }
        }
        f32x4 xa[4], xb[4]; unsigned ya[4][4], yb[4][4];
        int pst = 0; i32x4 iv = {0, 0, 0, 0};
        if (MODE != 0) {
            const int c = (int)__hip_atomic_load((unsigned*)(F.ctl + CW_CNT + ((L - 1) * NE + (lane & 31)) * 16), RLX_AGENT);
            const int p = (c + 255) & ~255;
#pragma unroll
            for (int e2 = 0; e2 < 31; ++e2) { const int v_ = __builtin_amdgcn_readlane(p, e2); pst += ((lane & 31) > e2) ? v_ : 0; }
            iv = *(const GAS i32x4*)(F.inv + ((size_t)m0 + (lane & 31)) * 4);
        }
#define P1_LOAD(X, Yv, mrow) do { const size_t m_ = (size_t)(mrow); \
            _Pragma("unroll") for (int j = 0; j < 4; ++j) { if (MODE == 0) X[j] = *(const GAS f32x4*)(F.x_in + m_ * DM + 4 * lane + 256 * j); \
                else { const u32x2 xb_ = *(const GAS u32x2*)(F.XB + m_ * DM + 4 * lane + 256 * j); X[j] = (f32x4){bf_lo(xb_.x), bf_hi(xb_.x), bf_lo(xb_.y), bf_hi(xb_.y)}; } } \
            if (MODE != 0) { const int li_ = (int)(m_ - (size_t)m0); \
                _Pragma("unroll") for (int k = 0; k < TOPK; ++k) { const int w_ = __builtin_amdgcn_readlane(k == 0 ? iv.x : k == 1 ? iv.y : k == 2 ? iv.z : iv.w, li_); \
                    const size_t row_ = (size_t)(__builtin_amdgcn_readlane(pst, w_ & 255) + (w_ >> 8)); \
                    _Pragma("unroll") for (int j = 0; j < 4; ++j) Yv[j][k] = *(const GAS unsigned*)((const unsigned char*)F.Y + row_ * DM + 4 * lane + 256 * j); } } } while (0)
#define P1_PROC(X, Yv, mrow) do { const size_t m = (size_t)(mrow); f32x4 v[4]; \
            _Pragma("unroll") for (int j = 0; j < 4; ++j) { v[j] = X[j]; \
                if (MODE != 0) { f32x4 ys = (f32x4){0.f, 0.f, 0.f, 0.f}; \
                    _Pragma("unroll") for (int k = 0; k < TOPK; ++k) { const f32x2 ylo = __builtin_amdgcn_cvt_pk_f32_fp8((int)Yv[j][k], false), yhi = __builtin_amdgcn_cvt_pk_f32_fp8((int)Yv[j][k], true); ys += (f32x4){ylo.x, ylo.y, yhi.x, yhi.y}; } \
                    v[j] += g2[j] * ys; } } \
            float ss = 0.f; \
            _Pragma("unroll") for (int j = 0; j < 4; ++j) ss += (v[j].x * v[j].x + v[j].y * v[j].y) + (v[j].z * v[j].z + v[j].w * v[j].w); \
            const float rs = 1.0f / sqrtf(wave_sum(ss) * (1.f / DM) + RMS_EPS); \
            if (MODE == 2) { _Pragma("unroll") for (int j = 0; j < 4; ++j) *(GAS f32x4*)(F.out + m * DM + 4 * lane + 256 * j) = v[j] * rs * gn[j]; } \
            else { _Pragma("unroll") for (int j = 0; j < 4; ++j) { { u32x2 xo_; xo_.x = pk2(v[j].x, v[j].y); xo_.y = pk2(v[j].z, v[j].w); *(GAS u32x2*)(F.XB + m * DM + 4 * lane + 256 * j) = xo_; } \
                    const f32x4 h = (v[j] * rs * gn[j]) * (sc[j] + 1.0f) + sh[j]; \
                    u32x2 o; o.x = pk2(h.x, h.y); o.y = pk2(h.z, h.w); \
                    *(GAS u32x2*)(F.H + m * DM + 4 * lane + 256 * j) = o; } } } while (0)
        P1_LOAD(xa, ya, m0);
        for (int i = 0; i < 32; i += 2) {
            P1_LOAD(xb, yb, m0 + i + 1);
            P1_PROC(xa, ya, m0 + i);
            if (i + 2 < 32) P1_LOAD(xa, ya, m0 + i + 2);
            P1_PROC(xb, yb, m0 + i + 1);
        }
#undef P1_LOAD
#undef P1_PROC
    }
}

constexpr int MO_RS = 9216, MO_BIASP = 10240, MO_PART = 10368;
__device__ __forceinline__ void p5_route(Frame& F, int L, int LC) {
    const int lane = F.lane, r32 = lane & 31, hi = lane >> 5;
    LAS float* Wl = (LAS float*)F.lds;
    LAS int* hist = (LAS int*)(F.misc + MO_HIST); LAS int* base = (LAS int*)(F.misc + MO_BASE);
    LAS int* sel_e = (LAS int*)(F.misc + MO_SELE); LAS float* sel_g = (LAS float*)(F.misc + MO_SELG);
    LAS float* rsl = (LAS float*)(F.misc + MO_RS); LAS float* biasp = (LAS float*)(F.misc + MO_BIASP); LAS float* part = (LAS float*)(F.misc + MO_PART);
    const float* Wr = F.w_router + (size_t)L * DM * NE;
    f32x4 gn[4];
#pragma unroll
    for (int j = 0; j < 4; ++j) gn[j] = *(const GAS f32x4*)(F.norm2 + (size_t)L * DM + 4 * lane + 256 * j);
    for (int blk = F.vcu; blk < NTOK / 256; blk += F.G) {
        const int tok0 = blk * 256 + F.wave * 32, b = tok0 >> 13;
        const float* mp = F.mod + ((size_t)L * NBATCH + b) * 6144;
        if (F.tid < NE) hist[F.tid] = 0;
        for (int it = F.tid; it < (DM / 8) * NE; it += NTHREADS) { const int kg = it >> 5, e = it & 31, k0 = kg * 8;
            const f32x4 n0 = *(const GAS f32x4*)(F.norm2 + (size_t)L * DM + k0), n1 = *(const GAS f32x4*)(F.norm2 + (size_t)L * DM + k0 + 4);
            const f32x4 s0 = *(const GAS f32x4*)(mp + 4 * DM + k0), s1 = *(const GAS f32x4*)(mp + 4 * DM + k0 + 4);
            float w[8];
#pragma unroll
            for (int i = 0; i < 8; ++i) w[i] = Wr[(size_t)(k0 + i) * NE + e] * ((i < 4 ? n0[i & 3] : n1[i & 3]) * (1.0f + (i < 4 ? s0[i & 3] : s1[i & 3])));
            u32x4 hv, mv;
#pragma unroll
            for (int i = 0; i < 4; ++i) { const unsigned hb = cvt_pk_bf16(w[2 * i], w[2 * i + 1]); hv[i] = hb; mv[i] = cvt_pk_bf16(w[2 * i] - bf_lo(hb), w[2 * i + 1] - bf_hi(hb)); }
            const int off = ((kg * 32) + e) * 16;
            *(LAS u32x4*)((LAS unsigned char*)Wl + off) = hv; *(LAS u32x4*)((LAS unsigned char*)Wl + 65536 + off) = mv; }
        { const int e = lane & 31, k0 = F.wave * 128 + hi * 64; float acc = 0.f;
#pragma unroll 8
          for (int k = 0; k < 64; ++k) acc = __builtin_fmaf(mp[3 * DM + k0 + k], Wr[(size_t)(k0 + k) * NE + e], acc);
          part[(F.wave * 2 + hi) * 32 + e] = acc; }
        f32x4 sc[4], sh[4];
#pragma unroll
        for (int j = 0; j < 4; ++j) { sh[j] = *(const GAS f32x4*)(mp + 3 * DM + 4 * lane + 256 * j); sc[j] = *(const GAS f32x4*)(mp + 4 * DM + 4 * lane + 256 * j); }
        f32x4 xa[4], xb[4];
#define P5_LOAD(X, mrow) do { _Pragma("unroll") for (int j = 0; j < 4; ++j) { const u32x2 xb_ = *(const GAS u32x2*)(F.XB + (size_t)(mrow) * DM + 4 * lane + 256 * j); X[j] = (f32x4){bf_lo(xb_.x), bf_hi(xb_.x), bf_lo(xb_.y), bf_hi(xb_.y)}; } } while (0)
#define P5_PROC(X, mrow, irow) do { const size_t m = (size_t)(mrow); float ss = 0.f; \
            _Pragma("unroll") for (int j = 0; j < 4; ++j) ss += (X[j].x * X[j].x + X[j].y * X[j].y) + (X[j].z * X[j].z + X[j].w * X[j].w); \
            const float rs = 1.0f / sqrtf(wave_sum(ss) * (1.f / DM) + RMS_EPS); \
            _Pragma("unroll") for (int j = 0; j < 4; ++j) { const f32x4 h = ((X[j] * rs * gn[j]) * (sc[j] + 1.0f) + sh[j]) * H8_SCALE; \
                *(GAS unsigned*)((unsigned char*)F.H + m * DM + 4 * lane + 256 * j) = pk4_fp8(h.x, h.y, h.z, h.w); } \
            if (lane == 0) rsl[F.wave * 32 + (irow)] = rs; } while (0)
        P5_LOAD(xa, tok0);
        for (int i = 0; i < 32; i += 2) {
            P5_LOAD(xb, tok0 + i + 1);
            P5_PROC(xa, tok0 + i, i);
            if (i + 2 < 32) P5_LOAD(xa, tok0 + i + 2);
            P5_PROC(xb, tok0 + i + 1, i + 1);
        }
#undef P5_LOAD
#undef P5_PROC
        __syncthreads();
        if (F.tid < NE) { float s = F.b_router[L * NE + F.tid];
#pragma unroll
            for (int p = 0; p < 16; ++p) s += part[p * 32 + F.tid];
            biasp[F.tid] = s; }
        __syncthreads();
        {
            f32x16 a0, a1;
#pragma unroll
            for (int r = 0; r < 16; ++r) { a0[r] = 0.f; a1[r] = 0.f; }
            const bf16_t* xr = F.XB + ((size_t)tok0 + r32) * DM + 8 * hi;
            const LAS unsigned char* wl = (const LAS unsigned char*)Wl + (hi * 32 + r32) * 16;
#pragma unroll 4
            for (int j = 0; j < 64; ++j) {
                const bf16x8 xv = *(const GAS bf16x8*)(xr + 16 * j);
                const bf16x8 wh = *(const LAS bf16x8*)(wl + j * 1024), wm = *(const LAS bf16x8*)(wl + 65536 + j * 1024);
                a0 = __builtin_amdgcn_mfma_f32_32x32x16_bf16(wh, xv, a0, 0, 0, 0); a1 = __builtin_amdgcn_mfma_f32_32x32x16_bf16(wm, xv, a1, 0, 0, 0);
            }
            const float rs = rsl[F.wave * 32 + r32];
            float v[16];
#pragma unroll
            for (int r = 0; r < 16; ++r) v[r] = (a0[r] + a1[r]) * rs + biasp[(r & 3) + 8 * (r >> 2) + 4 * hi];
            float tv[4]; int ti[4];
#pragma unroll
            for (int rd = 0; rd < 4; ++rd) {
                float bv = v[0]; int bi = 4 * hi;
#pragma unroll
                for (int r = 1; r < 16; ++r) { const int ei = (r & 3) + 8 * (r >> 2) + 4 * hi; if (v[r] > bv) { bv = v[r]; bi = ei; } }
                { const auto rv_ = __builtin_amdgcn_permlane32_swap(__float_as_uint(bv), __float_as_uint(bv), false, false); const auto ri_ = __builtin_amdgcn_permlane32_swap((unsigned)bi, (unsigned)bi, false, false);
                  const float v0_ = __uint_as_float(rv_[0]), v1_ = __uint_as_float(rv_[1]); const int i0_ = (int)ri_[0], i1_ = (int)ri_[1];
                  const bool up_ = (v1_ > v0_) || (v1_ == v0_ && i1_ < i0_); bv = up_ ? v1_ : v0_; bi = up_ ? i1_ : i0_; }
                tv[rd] = bv; ti[rd] = bi;
#pragma unroll
                for (int r = 0; r < 16; ++r) { const int ei = (r & 3) + 8 * (r >> 2) + 4 * hi; if (ei == bi) v[r] = -INFINITY; }
            }
            const float e1 = __expf(tv[1] - tv[0]), e2 = __expf(tv[2] - tv[0]), e3 = __expf(tv[3] - tv[0]); const float inv = 1.0f / (1.0f + e1 + e2 + e3);
#pragma unroll
            for (int kk = 0; kk < 2; ++kk) {
                const int me = hi ? (kk ? ti[3] : ti[2]) : (kk ? ti[1] : ti[0]);
                const float mg = (hi ? (kk ? e3 : e2) : (kk ? e1 : 1.0f)) * inv;
                const int pos = __hip_atomic_fetch_add(&hist[me], 1, __ATOMIC_RELAXED, __HIP_MEMORY_SCOPE_WORKGROUP);
                const int a = (F.wave * 32 + r32) * 4 + 2 * hi + kk;
                sel_e[a] = me | (pos << 8); sel_g[a] = mg;
            }
        }
        __syncthreads();
        if (F.tid < NE) base[F.tid] = (int)__hip_atomic_fetch_add((unsigned*)(F.ctl + CW_CNT + (LC * NE + F.tid) * 16), (unsigned)hist[F.tid], RLX_AGENT);
        __syncthreads();
        for (int a = F.tid; a < 1024; a += NTHREADS) { const int se = sel_e[a], ex = se & 255, pos = se >> 8, slot = base[ex] + pos;
            F.ltok[(size_t)ex * LCAP + slot] = (blk * 256 + (a >> 2)) * 4 + (a & 3); F.lg[(size_t)ex * LCAP + slot] = sel_g[a];
            F.inv[(size_t)blk * 1024 + a] = ex | (slot << 8); }
        __syncthreads();
    }
}

struct EpiProj {
    static constexpr bool PERM = true; static constexpr int NVM = 16;
    struct Pre {}; static constexpr int NPRE = 0;
    __device__ __forceinline__ Pre preload(const pg8::Unit&, int, int, int, int) const { return Pre{}; }
    __device__ __forceinline__ void operator()(const f32x4 (&acc)[2][2][4][2], const pg8::Unit& u, int wr, int wc, int fr, int fq, const Pre&) const { (*this)(acc, u, wr, wc, fr, fq); }
    bf16_t* O; unsigned* nrm;
    __device__ __forceinline__ void operator()(const f32x4 (&acc)[2][2][4][2], const pg8::Unit& u, int wr, int wc, int fr, int fq) const {
        const int row0 = u.pm * 256 + wr * 64 + fr, col0 = u.pn * 256 + wc * 32 + 8 * fq;
        const float sc = (u.pn == 0 || u.pn == 3 || u.pn == 5 || u.pn == 6) ? QSCALE : 1.0f;
        float nmx[2] = {0.f, 0.f};
#pragma unroll
        for (int ai = 0; ai < 2; ++ai)
#pragma unroll
            for (int m = 0; m < 4; ++m) { bf16_t* rowp = O + (size_t)(row0 + ai * 128 + m * 16) * INW + col0;
#pragma unroll
                for (int bj = 0; bj < 2; ++bj) { const f32x2 sc2 = {sc, sc}; const f32x4 v0 = pk_mul4s(acc[ai][bj][m][0], sc2), v1 = pk_mul4s(acc[ai][bj][m][1], sc2);
                    u32x4 w; w.x = cvt_pk_bf16(v0[0], v0[1]); w.y = cvt_pk_bf16(v0[2], v0[3]); w.z = cvt_pk_bf16(v1[0], v1[1]); w.w = cvt_pk_bf16(v1[2], v1[3]);
                    *(GAS u32x4*)(rowp + bj * 128) = w;
                    if (C_TILE_SKIP && u.pn >= 5 && u.pn <= 8) {
                        float q = (v0[0] * v0[0] + v0[1] * v0[1]) + (v0[2] * v0[2] + v0[3] * v0[3]) + (v1[0] * v1[0] + v1[1] * v1[1]) + (v1[2] * v1[2] + v1[3] * v1[3]);
                        q = x32_sum(x16_sum(q)); nmx[bj] = fmaxf(nmx[bj], q); } } }
        if (C_TILE_SKIP && u.pn >= 5 && u.pn <= 8) {
#pragma unroll
            for (int bj = 0; bj < 2; ++bj) { float v = row16_max(nmx[bj]);
                if (fr == 0 && fq == 0) { const int b = u.pm >> 5, qk = u.pn >= 7, blk = (u.pn - (qk ? 7 : 5)) * 8 + bj * 4 + wc;
                    atomicMax(nrm + (b * 2 + qk) * 16 + blk, __float_as_uint(v)); } }
        }
    }
};
struct EpiOut {
    static constexpr bool PERM = false; static constexpr int NVM = 32;
    struct Pre {}; static constexpr int NPRE = 0;
    __device__ __forceinline__ Pre preload(const pg8::Unit&, int, int, int, int) const { return Pre{}; }
    __device__ __forceinline__ void operator()(const f32x4 (&acc)[2][2][4][2], const pg8::Unit& u, int wr, int wc, int fr, int fq, const Pre&) const { (*this)(acc, u, wr, wc, fr, fq); }
    bf16_t* X; const float* g1; float gmul;
    __device__ __forceinline__ void operator()(const f32x4 (&acc)[2][2][4][2], const pg8::Unit& u, int wr, int wc, int fr, int fq) const {
        const int b = u.pm >> 5, col0 = u.pn * 256 + wc * 32 + 4 * fq;
        f32x4 gv[2][2];
#pragma unroll
        for (int bj = 0; bj < 2; ++bj)
#pragma unroll
            for (int n = 0; n < 2; ++n) gv[bj][n] = *(const GAS f32x4*)(g1 + (size_t)b * 6144 + col0 + bj * 128 + n * 16) * gmul;
#pragma unroll
        for (int ai = 0; ai < 2; ++ai) {
            u32x2 xv[4][2][2];
#pragma unroll
            for (int m = 0; m < 4; ++m)
#pragma unroll
                for (int bj = 0; bj < 2; ++bj)
#pragma unroll
                    for (int n = 0; n < 2; ++n) xv[m][bj][n] = *(const GAS u32x2*)(X + (size_t)(u.pm * 256 + ai * 128 + wr * 64 + m * 16 + fr) * DM + col0 + bj * 128 + n * 16);
#pragma unroll
            for (int m = 0; m < 4; ++m)
#pragma unroll
                for (int bj = 0; bj < 2; ++bj)
#pragma unroll
                    for (int n = 0; n < 2; ++n) { const u32x2 xb = xv[m][bj][n]; const f32x4 o = pk_fma4(gv[bj][n], acc[ai][bj][m][n], (f32x4){bf_lo(xb.x), bf_hi(xb.x), bf_lo(xb.y), bf_hi(xb.y)});
                        u32x2 w; w.x = cvt_pk_bf16(o[0], o[1]); w.y = cvt_pk_bf16(o[2], o[3]);
                        *(GAS u32x2*)(X + (size_t)(u.pm * 256 + ai * 128 + wr * 64 + m * 16 + fr) * DM + col0 + bj * 128 + n * 16) = w; }
            asm volatile("" ::: "memory");
        }
    }
};
struct EpiGU {
    static constexpr bool PERM = true; static constexpr int NVM = 8;
    unsigned char* Hd; const float* bg; const float* bu;
    struct Pre { float b; }; static constexpr int NPRE = 1;
    __device__ __forceinline__ Pre preload(const pg8::Unit& u, int wr, int wc, int fr, int fq) const {
        const int e = u.pn >> 3, pnl = u.pn & 7, hc = pnl * 128 + wc * 32 + 8 * fq; Pre p;
        p.b = __uint_as_float(ld_untracked(((fr & 8) ? bu : bg) + (size_t)e * DM + hc + (fr & 7)));
        return p;
    }
    __device__ __forceinline__ void operator()(const f32x4 (&acc)[2][2][4][2], const pg8::Unit& u, int wr, int wc, int fr, int fq, const Pre& pre) const {
        const int pnl = u.pn & 7, hc = pnl * 128 + wc * 32 + 8 * fq;
        constexpr float ds = 1.0f / (W8_SCALE * H8_SCALE);
        f32x4 bgv[2], buv[2];
        { const int base4 = (lane_id() & 48) * 4;
#pragma unroll
          for (int n = 0; n < 2; ++n)
#pragma unroll
            for (int i = 0; i < 4; ++i) { bgv[n][i] = __int_as_float(__builtin_amdgcn_ds_bpermute(base4 + (n * 4 + i) * 4, __float_as_int(pre.b)));
                                          buv[n][i] = __int_as_float(__builtin_amdgcn_ds_bpermute(base4 + (8 + n * 4 + i) * 4, __float_as_int(pre.b))); } }
        constexpr float KS = -1.702f * LOG2E, US = HID8_SCALE / KS;
        f32x4 kbg[2], ubu[2];
#pragma unroll
        for (int n = 0; n < 2; ++n) { kbg[n] = bgv[n] * KS; ubu[n] = buv[n] * US + US; }
        f32x2 cks2 = {KS * ds, KS * ds}, cus2 = {US * ds, US * ds}, one2 = {1.0f, 1.0f};
#pragma unroll
        for (int ai = 0; ai < 2; ++ai)
#pragma unroll
            for (int m = 0; m < 4; ++m) {
                float hv[8];
#pragma unroll
                for (int n = 0; n < 2; ++n) {
#pragma unroll
                    for (int i2 = 0; i2 < 2; ++i2) {
                        const f32x2 g2 = {acc[ai][0][m][n][2 * i2], acc[ai][0][m][n][2 * i2 + 1]}, u2 = {acc[ai][1][m][n][2 * i2], acc[ai][1][m][n][2 * i2 + 1]};
                        const f32x2 kb2 = {kbg[n][2 * i2], kbg[n][2 * i2 + 1]}, ub2 = {ubu[n][2 * i2], ubu[n][2 * i2 + 1]};
                        f32x2 ap2 = __builtin_elementwise_fma(g2, cks2, kb2), up2 = __builtin_elementwise_fma(u2, cus2, ub2);
                        ap2[0] = fmaxf(ap2[0], 7.0f * KS); ap2[1] = fmaxf(ap2[1], 7.0f * KS);
                        up2[0] = __builtin_amdgcn_fmed3f(up2[0], 8.0f * US, -6.0f * US); up2[1] = __builtin_amdgcn_fmed3f(up2[1], 8.0f * US, -6.0f * US);
                        f32x2 e2 = {__builtin_amdgcn_exp2f(ap2[0]), __builtin_amdgcn_exp2f(ap2[1])};
                        e2 = e2 + one2;
                        const f32x2 s2 = {__builtin_amdgcn_rcpf(e2[0]), __builtin_amdgcn_rcpf(e2[1])};
                        const f32x2 h2 = (ap2 * s2) * up2;
                        hv[n * 4 + 2 * i2] = h2[0]; hv[n * 4 + 2 * i2 + 1] = h2[1]; } }
                u32x2 w; w.x = pk4_fp8_nc(hv[0], hv[1], hv[2], hv[3]); w.y = pk4_fp8_nc(hv[4], hv[5], hv[6], hv[7]);
                *(GAS u32x2*)(Hd + (size_t)(u.pm * 256 + ai * 128 + wr * 64 + m * 16 + fr) * DM + hc) = w; }
    }
};
struct EpiDown {
    static constexpr bool PERM = true; static constexpr int NVM = 8;
    unsigned char* Y; const float* bd; const LAS int* tab; const float* lg; LAS unsigned char* stg;
    struct Pre { float b; float g[2]; }; static constexpr int NPRE = 3;
    __device__ __forceinline__ Pre preload(const pg8::Unit& u, int wr, int wc, int fr, int fq) const {
        const int e = u.pn >> 2, pnl = u.pn & 3, col0 = pnl * 256 + wc * 32 + 8 * fq;
        const int pstart = tab[32 + e], cnt = tab[64 + e]; Pre p;
        p.b = __uint_as_float(ld_untracked(bd + (size_t)e * DM + col0 + (fr >> 3) * 128 + (fr & 7)));
#pragma unroll
        for (int ai = 0; ai < 2; ++ai) { const int i = u.pm * 256 + ai * 128 + wr * 64 + fq * 16 + fr - pstart; p.g[ai] = __uint_as_float(ld_untracked(lg + (size_t)e * LCAP + (i < cnt ? i : 0))); }
        return p;
    }
    __device__ __forceinline__ void operator()(const f32x4 (&acc)[2][2][4][2], const pg8::Unit& u, int wr, int wc, int fr, int fq, const Pre& pre) const {
        const int pnl = u.pn & 3, col0 = pnl * 256 + wc * 32 + 8 * fq;
        f32x4 bv[2][2]; float gt[2][4];
        { const int l_ = lane_id(), base4 = (l_ & 48) * 4, fr4 = (l_ & 15) * 4;
#pragma unroll
          for (int bj = 0; bj < 2; ++bj)
#pragma unroll
            for (int n = 0; n < 2; ++n)
#pragma unroll
                for (int i = 0; i < 4; ++i) bv[bj][n][i] = __int_as_float(__builtin_amdgcn_ds_bpermute(base4 + (bj * 8 + n * 4 + i) * 4, __float_as_int(pre.b)));
#pragma unroll
          for (int ai = 0; ai < 2; ++ai)
#pragma unroll
            for (int m = 0; m < 4; ++m) gt[ai][m] = __int_as_float(__builtin_amdgcn_ds_bpermute(m * 64 + fr4, __float_as_int(pre.g[ai]))); }
        LAS unsigned char* sg_ = stg + wr * EPI_STG_GRP;
        const int l_ = lane_id(), rrow = wc * 16 + (l_ >> 3), rch = l_ & 7;
#pragma unroll
        for (int ai = 0; ai < 2; ++ai)
#pragma unroll
            for (int bj = 0; bj < 2; ++bj) {
#pragma unroll
                for (int m = 0; m < 4; ++m) { constexpr float ds = 1.0f / (W8_SCALE * HID8_SCALE); const float g_ = gt[ai][m] * Y8_SCALE;
                    const f32x2 ds2 = {ds, ds}, g2 = {g_, g_};
                    const f32x4 v0 = pk_mul4s(pk_fma4s(acc[ai][bj][m][0], ds2, bv[bj][0]), g2), v1 = pk_mul4s(pk_fma4s(acc[ai][bj][m][1], ds2, bv[bj][1]), g2);
                    u32x2 w; w.x = pk4_fp8(v0[0], v0[1], v0[2], v0[3]); w.y = pk4_fp8(v1[0], v1[1], v1[2], v1[3]);
                    *(LAS u32x2*)(sg_ + (m * 16 + fr) * EPI_STG_ROW + wc * 32 + 8 * fq) = w; }
                asm volatile("s_waitcnt lgkmcnt(0)\n\ts_barrier" ::: "memory");
#pragma unroll
                for (int k = 0; k < 2; ++k) { const int r64 = rrow + 8 * k; const u32x4 v = *(const LAS u32x4*)(sg_ + r64 * EPI_STG_ROW + rch * 16);
                    __builtin_nontemporal_store(v, (GAS u32x4*)(Y + (size_t)(u.pm * 256 + ai * 128 + wr * 64 + r64) * DM + pnl * 256 + bj * 128 + rch * 16)); }
                asm volatile("s_waitcnt lgkmcnt(0)\n\ts_barrier" ::: "memory");
            }
    }
};
struct MoeSched {
    const LAS int* tab; int NTs  , NBk, G, vcu; const int* ltok;
    __device__ __forceinline__ bool next(int i, pg8::Unit& u) const {
        const int L = i * G + vcu, per = 32 << NTs, chunk = L / per, rem = L % per, pnl = rem & ((1 << NTs) - 1), rb = chunk * 32 + (rem >> NTs);
        if (rb >= NBk) return false;
        const int pe = tab[lane_id() & 31];
        const unsigned long long bal = __ballot(pe <= rb * 256);
        const int e = __popc((unsigned)bal);
        u.pm = rb; u.pn = (e << NTs) + pnl; return true;
    }
    __device__ __forceinline__ unsigned arow(const pg8::Unit& u, int r) const {
        const int e = u.pn >> NTs, i = u.pm * 256 + r - tab[32 + e];
        return (i < tab[64 + e]) ? ((unsigned)ltok[(size_t)e * LCAP + i] >> 2) : 0u;
    }
    __device__ __forceinline__ unsigned arow_raw(const pg8::Unit& u, int r) const {
        const int e = u.pn >> NTs, i = u.pm * 256 + r - tab[32 + e];
        return ld_untracked(ltok + (size_t)e * LCAP + (i < tab[64 + e] ? i : 0));
    }
};
__device__ __forceinline__ void moe_table(Frame& F, int L) {
    LAS int* tab = (LAS int*)(F.misc + MO_TAB);
    if (F.tid < 64) {
        const int e = F.tid & 31;
        const int c = (int)__hip_atomic_load((unsigned*)(F.ctl + CW_CNT + (L * NE + e) * 16), RLX_AGENT);
        int p = (c + 255) & ~255, incl = p;
#pragma unroll
        for (int e2 = 0; e2 < 31; ++e2) { const int v_ = __builtin_amdgcn_readlane(p, e2); incl += (e > e2) ? v_ : 0; }
        if (F.tid < 32) { tab[e] = incl; tab[32 + e] = incl - p; tab[64 + e] = c; if (e == 31) tab[96] = incl >> 8; }
    }
    __syncthreads();
}

namespace att {
typedef short v4i16_t __attribute__((ext_vector_type(4)));
typedef LAS const char* lds_cptr;
__device__ __forceinline__ int crow(int r, int hi) { return (r & 3) + 8 * (r >> 2) + 4 * hi; }
__device__ __forceinline__ void glds16(const void* gsrc, unsigned lds_dst) { unsigned keep;
    asm volatile("s_mov_b32 %0, m0\n\ts_mov_b32 m0, %2\n\ts_nop 0\n\tglobal_load_lds_dwordx4 %1, off\n\ts_mov_b32 m0, %0" : "=&s"(keep) : "v"(gsrc), "s"(lds_dst) : "memory"); }
__device__ __forceinline__ void glds16s(const void* sbase, unsigned voff, unsigned lds_dst) { unsigned keep;
    asm volatile("s_mov_b32 %0, m0\n\ts_mov_b32 m0, %3\n\ts_nop 0\n\tglobal_load_lds_dwordx4 %1, %2\n\ts_mov_b32 m0, %0" : "=&s"(keep) : "v"(voff), "s"(sbase), "s"(lds_dst) : "memory"); }
__device__ __forceinline__ u32x2 vtr2(lds_cptr p) { return __builtin_bit_cast(u32x2, __builtin_amdgcn_ds_read_tr16_b64_v4i16((LAS v4i16_t*)p)); }
__device__ __forceinline__ bf16x8 vcat(u32x2 lo, u32x2 hv) { return __builtin_bit_cast(bf16x8, (u32x4){lo.x, lo.y, hv.x, hv.y}); }
__device__ __forceinline__ s16x4 vtr(lds_cptr p) { return __builtin_bit_cast(s16x4, __builtin_amdgcn_ds_read_tr16_b64_v4i16((LAS v4i16_t*)p)); }
#define ATT_WAIT_BAR(N) asm volatile("s_waitcnt vmcnt(" #N ") lgkmcnt(0)\n\ts_barrier" ::: "memory")
#define ATT_MFMA(a, b, c) __builtin_amdgcn_mfma_f32_32x32x16_bf16((a), (b), (c), 0, 0, 0)
__device__ __forceinline__ bf16x8 pack8(const f32x16& p, int s) {
    u32x4 w; w.x = cvt_pk_bf16(p[8 * s + 0], p[8 * s + 1]); w.y = cvt_pk_bf16(p[8 * s + 2], p[8 * s + 3]); w.z = cvt_pk_bf16(p[8 * s + 4], p[8 * s + 5]); w.w = cvt_pk_bf16(p[8 * s + 6], p[8 * s + 7]);
    return __builtin_bit_cast(bf16x8, w);
}
__device__ __forceinline__ u32x4 pair16(u32x2 w0, u32x2 w1) {
    const auto x = __builtin_amdgcn_permlane32_swap(w0.x, w1.x, false, false);
    const auto y = __builtin_amdgcn_permlane32_swap(w0.y, w1.y, false, false);
    return (u32x4){x[0], y[0], x[1], y[1]};
}
__device__ __forceinline__ float xmax32(float v) { const auto r = __builtin_amdgcn_permlane32_swap(__float_as_uint(v), __float_as_uint(v), false, false); return fmaxf(__uint_as_float(r[0]), __uint_as_float(r[1])); }
__device__ __forceinline__ float xsum32(float v) { const auto r = __builtin_amdgcn_permlane32_swap(__float_as_uint(v), __float_as_uint(v), false, false); return __uint_as_float(r[0]) + __uint_as_float(r[1]); }
__device__ __forceinline__ float max16(const f32x16& p) {
    float a = fmaxf(fmaxf(p[0], p[1]), fmaxf(p[2], p[3])), b = fmaxf(fmaxf(p[4], p[5]), fmaxf(p[6], p[7]));
    float c = fmaxf(fmaxf(p[8], p[9]), fmaxf(p[10], p[11])), d = fmaxf(fmaxf(p[12], p[13]), fmaxf(p[14], p[15]));
    return fmaxf(fmaxf(a, b), fmaxf(c, d));
}
__device__ __forceinline__ float sum16(const f32x16& p) {
    float a = (p[0] + p[1]) + (p[2] + p[3]), b = (p[4] + p[5]) + (p[6] + p[7]), c = (p[8] + p[9]) + (p[10] + p[11]), d = (p[12] + p[13]) + (p[14] + p[15]);
    return (a + b) + (c + d);
}

constexpr int C_KSLOT = 16384, C_VRING = 65536;
#define SBAR() __builtin_amdgcn_sched_barrier(0)
#define PIN(x) asm volatile("" : "+v"(x))
#define MX3(a, b, c) __builtin_fmaxf(__builtin_fmaxf((a), (b)), (c))
#define EX2(v) __builtin_amdgcn_exp2f(v)
#define PAF(k) __builtin_bit_cast(bf16x8, pw##k)
#define VRD(i) do { vl_[i] = vtr2(vp_ + (((i) & 3) * 4096 + ((i) >> 2) * 1024)); vh_[i] = vtr2(vp_ + (((i) & 3) * 4096 + ((i) >> 2) * 1024 + 512)); } while (0)
#define VFR(i) vcat(vl_[i], vh_[i])
#define FMAMK(d, a, K, c) asm("v_fmamk_f32 %0, %1, %3, %2" : "=v"(d) : "v"(a), "v"(c), "i"(__builtin_bit_cast(int, (float)(K))))
#define ATTC_STEP(C0, C1, P0, P1, t, GK, GV, GL) do { SBAR(); \
    const lds_cptr kc_ = kp0 + (((t) & 3) << 14); float sacc = P0[0] + P0[1]; \
    kf[2] = *(const LAS bf16x8*)(KXA(kc_, 1) + 0); C0 = ATT_MFMA(kf[0], qr[0], C0); sacc += P0[2]; sacc += P0[3]; sacc += P0[4]; sacc += P0[5]; PIN(sacc); pw0[0] = cvt_pk_bf16(P0[0], P0[1]); pw0[1] = cvt_pk_bf16(P0[2], P0[3]); PIN(pw0); SBAR(); \
    kf[3] = *(const LAS bf16x8*)(KXA(kc_, 1) + 4096); C1 = ATT_MFMA(kf[1], qr[0], C1); sacc += P0[6]; sacc += P0[7]; sacc += P0[8]; sacc += P0[9]; PIN(sacc); pw0[2] = cvt_pk_bf16(P0[4], P0[5]); pw0[3] = cvt_pk_bf16(P0[6], P0[7]); PIN(pw0); SBAR(); \
    kf[4] = *(const LAS bf16x8*)(KXA(kc_, 2) + 0); C0 = ATT_MFMA(kf[2], qr[1], C0); sacc += P0[10]; sacc += P0[11]; sacc += P0[12]; sacc += P0[13]; PIN(sacc); pw1[0] = cvt_pk_bf16(P0[8], P0[9]); pw1[1] = cvt_pk_bf16(P0[10], P0[11]); PIN(pw1); SBAR(); \
    kf[5] = *(const LAS bf16x8*)(KXA(kc_, 2) + 4096); C1 = ATT_MFMA(kf[3], qr[1], C1); sacc += P0[14]; sacc += P0[15]; sacc += P1[0]; sacc += P1[1]; PIN(sacc); pw1[2] = cvt_pk_bf16(P0[12], P0[13]); pw1[3] = cvt_pk_bf16(P0[14], P0[15]); PIN(pw1); SBAR(); \
    kf[6] = *(const LAS bf16x8*)(KXA(kc_, 3) + 0); C0 = ATT_MFMA(kf[4], qr[2], C0); sacc += P1[2]; sacc += P1[3]; sacc += P1[4]; sacc += P1[5]; PIN(sacc); pw2[0] = cvt_pk_bf16(P1[0], P1[1]); pw2[1] = cvt_pk_bf16(P1[2], P1[3]); PIN(pw2); SBAR(); \
    kf[7] = *(const LAS bf16x8*)(KXA(kc_, 3) + 4096); C1 = ATT_MFMA(kf[5], qr[2], C1); sacc += P1[6]; sacc += P1[7]; sacc += P1[8]; sacc += P1[9]; PIN(sacc); pw2[2] = cvt_pk_bf16(P1[4], P1[5]); pw2[3] = cvt_pk_bf16(P1[6], P1[7]); PIN(pw2); SBAR(); \
    C0 = ATT_MFMA(kf[6], qr[3], C0); sacc += P1[10]; sacc += P1[11]; sacc += P1[12]; sacc += P1[13]; PIN(sacc); pw3[0] = cvt_pk_bf16(P1[8], P1[9]); pw3[1] = cvt_pk_bf16(P1[10], P1[11]); PIN(pw3); SBAR(); \
    C1 = ATT_MFMA(kf[7], qr[3], C1); sacc += P1[14]; sacc += P1[15]; PIN(sacc); pw3[2] = cvt_pk_bf16(P1[12], P1[13]); pw3[3] = cvt_pk_bf16(P1[14], P1[15]); PIN(pw3); SBAR(); \
    l_reg += sacc; \
    if (GK) { C_DMA_K((t) + 3, ((((t) + 3) & 3) << 14)); } if (GV) { C_DMA_V((t) + 1, sl_next); } \
    const lds_cptr vp_ = vp0 + sl_prev; const lds_cptr kn_ = kp0 + ((((t) + 1) & 3) << 14); \
    const int tn_ = (t) + 1; float sg_ = (tn_ < tm) ? slope2 : -slope2; PIN(sg_); \
    u32x2 vl_[16], vh_[16]; \
    VRD(0); VRD(1); SBAR(); \
    VRD(2); o[0] = ATT_MFMA(VFR(0), PAF(0), o[0]); float ma_ = MX3(C0[0], C0[1], C0[2]); float mb_ = MX3(C0[3], C0[4], C0[5]); ma_ = MX3(ma_, C0[6], C0[7]); mb_ = MX3(mb_, C0[8], C0[9]); PIN(ma_); PIN(mb_); SBAR(); \
    VRD(3); o[1] = ATT_MFMA(VFR(1), PAF(0), o[1]); ma_ = MX3(ma_, C0[10], C0[11]); mb_ = MX3(mb_, C0[12], C0[13]); ma_ = MX3(ma_, C0[14], C0[15]); mb_ = MX3(mb_, C1[0], C1[1]); PIN(ma_); PIN(mb_); SBAR(); \
    VRD(4); o[2] = ATT_MFMA(VFR(2), PAF(0), o[2]); ma_ = MX3(ma_, C1[2], C1[3]); mb_ = MX3(mb_, C1[4], C1[5]); ma_ = MX3(ma_, C1[6], C1[7]); mb_ = MX3(mb_, C1[8], C1[9]); PIN(ma_); PIN(mb_); SBAR(); \
    VRD(5); o[3] = ATT_MFMA(VFR(3), PAF(0), o[3]); ma_ = MX3(ma_, C1[10], C1[11]); mb_ = MX3(mb_, C1[12], C1[13]); ma_ = MX3(ma_, C1[14], C1[15]); PIN(ma_); PIN(mb_); SBAR(); \
    { float rm_ = __builtin_fmaxf(ma_, mb_); { auto rr_ = __builtin_amdgcn_permlane32_swap(__float_as_uint(rm_), __float_as_uint(rm_), false, false); rm_ = __builtin_fmaxf(__uint_as_float(rr_[0]), __uint_as_float(rr_[1])); } \
      resc = false; \
      if (__builtin_expect(__any(rm_ > 8.0f), 0)) { const float dl_ = __builtin_fmaxf(rm_, 0.f); m += dl_; \
        _Pragma("unroll") for (int r_ = 0; r_ < 16; ++r_) { C0[r_] -= dl_; C1[r_] -= dl_; } \
        fsc = __builtin_amdgcn_exp2f(-dl_); l_reg *= fsc; resc = true; rm_ -= dl_; } \
      pz = __all(rm_ < -150.0f); } \
    const float ib_ = sg_ * ((float)(64 * tn_ + 4 * hi) - qf) - m; SBAR(); \
    VRD(6); o[0] = ATT_MFMA(VFR(4), PAF(1), o[0]); C0[0] = EX2(C0[0]); C0[1] = EX2(C0[1]); C0[2] = EX2(C0[2]); FMAMK(P0[0], sg_, 0.0f, ib_); FMAMK(P0[1], sg_, 1.0f, ib_); FMAMK(P0[2], sg_, 2.0f, ib_); PIN(C0); PIN(P0); SBAR(); \
    VRD(7); o[1] = ATT_MFMA(VFR(5), PAF(1), o[1]); C0[3] = EX2(C0[3]); C0[4] = EX2(C0[4]); C0[5] = EX2(C0[5]); FMAMK(P0[3], sg_, 3.0f, ib_); FMAMK(P0[4], sg_, 8.0f, ib_); FMAMK(P0[5], sg_, 9.0f, ib_); PIN(C0); PIN(P0); SBAR(); \
    VRD(8); o[2] = ATT_MFMA(VFR(6), PAF(1), o[2]); C0[6] = EX2(C0[6]); C0[7] = EX2(C0[7]); FMAMK(P0[6], sg_, 10.0f, ib_); FMAMK(P0[7], sg_, 11.0f, ib_); PIN(C0); PIN(P0); SBAR(); \
    VRD(9); o[3] = ATT_MFMA(VFR(7), PAF(1), o[3]); C0[8] = EX2(C0[8]); C0[9] = EX2(C0[9]); C0[10] = EX2(C0[10]); FMAMK(P0[8], sg_, 16.0f, ib_); FMAMK(P0[9], sg_, 17.0f, ib_); FMAMK(P0[10], sg_, 18.0f, ib_); PIN(C0); PIN(P0); SBAR(); \
    VRD(10); o[0] = ATT_MFMA(VFR(8), PAF(2), o[0]); C0[11] = EX2(C0[11]); C0[12] = EX2(C0[12]); C0[13] = EX2(C0[13]); FMAMK(P0[11], sg_, 19.0f, ib_); FMAMK(P0[12], sg_, 24.0f, ib_); FMAMK(P0[13], sg_, 25.0f, ib_); PIN(C0); PIN(P0); SBAR(); \
    VRD(11); o[1] = ATT_MFMA(VFR(9), PAF(2), o[1]); C0[14] = EX2(C0[14]); C0[15] = EX2(C0[15]); FMAMK(P0[14], sg_, 26.0f, ib_); FMAMK(P0[15], sg_, 27.0f, ib_); PIN(C0); PIN(P0); SBAR(); \
    if (GL) { kf[0] = *(const LAS bf16x8*)(KXA(kn_, 0) + 0); } VRD(12); o[2] = ATT_MFMA(VFR(10), PAF(2), o[2]); C1[0] = EX2(C1[0]); C1[1] = EX2(C1[1]); C1[2] = EX2(C1[2]); FMAMK(P1[0], sg_, 32.0f, ib_); FMAMK(P1[1], sg_, 33.0f, ib_); FMAMK(P1[2], sg_, 34.0f, ib_); PIN(C1); PIN(P1); SBAR(); \
    if (GL) { kf[1] = *(const LAS bf16x8*)(KXA(kn_, 0) + 4096); } VRD(13); o[3] = ATT_MFMA(VFR(11), PAF(2), o[3]); C1[3] = EX2(C1[3]); C1[4] = EX2(C1[4]); C1[5] = EX2(C1[5]); FMAMK(P1[3], sg_, 35.0f, ib_); FMAMK(P1[4], sg_, 40.0f, ib_); FMAMK(P1[5], sg_, 41.0f, ib_); PIN(C1); PIN(P1); SBAR(); \
    VRD(14); o[0] = ATT_MFMA(VFR(12), PAF(3), o[0]); C1[6] = EX2(C1[6]); C1[7] = EX2(C1[7]); FMAMK(P1[6], sg_, 42.0f, ib_); FMAMK(P1[7], sg_, 43.0f, ib_); PIN(C1); PIN(P1); SBAR(); \
    VRD(15); o[1] = ATT_MFMA(VFR(13), PAF(3), o[1]); C1[8] = EX2(C1[8]); C1[9] = EX2(C1[9]); C1[10] = EX2(C1[10]); FMAMK(P1[8], sg_, 48.0f, ib_); FMAMK(P1[9], sg_, 49.0f, ib_); FMAMK(P1[10], sg_, 50.0f, ib_); PIN(C1); PIN(P1); SBAR(); \
    o[2] = ATT_MFMA(VFR(14), PAF(3), o[2]); C1[11] = EX2(C1[11]); C1[12] = EX2(C1[12]); C1[13] = EX2(C1[13]); FMAMK(P1[11], sg_, 51.0f, ib_); FMAMK(P1[12], sg_, 56.0f, ib_); FMAMK(P1[13], sg_, 57.0f, ib_); PIN(C1); PIN(P1); SBAR(); \
    o[3] = ATT_MFMA(VFR(15), PAF(3), o[3]); C1[14] = EX2(C1[14]); C1[15] = EX2(C1[15]); FMAMK(P1[14], sg_, 58.0f, ib_); FMAMK(P1[15], sg_, 59.0f, ib_); PIN(C1); PIN(P1); SBAR(); \
    if (tn_ == tm) { const float db_ = (float)(64 * tn_ + 4 * hi) - qf; \
      _Pragma("unroll") for (int r_ = 0; r_ < 16; ++r_) { const float c_ = (float)((r_ & 3) + 8 * (r_ >> 2)); \
        P0[r_] = __builtin_fmaf(-__builtin_fabsf(db_ + c_), slope2, -m); P1[r_] = __builtin_fmaf(-__builtin_fabsf(db_ + (32.f + c_)), slope2, -m); } } \
    } while (0)

__device__ __forceinline__ bool attnC_unit(const bf16_t* P, bf16_t* MX, const float* gainv  , int b, int h, int qb, float slope2, float lam, float post, LAS unsigned char* shm, int wid, int lane, int T0, int NT, volatile LAS unsigned* badw) {
    const int r32 = lane & 31, hi = lane >> 5, rg = wid & 3, mp = wid >> 2;
    const size_t rowbase = (size_t)b * SEQ;
    const int q0 = qb * 128 + rg * 32, tm = (q0 >> 6) - T0;
    const bf16_t* qp = P + (rowbase + q0 + r32) * INW + C_QC + h * 128 + mp * 64 + hi * 8;
    bf16x8 qr[4];
#pragma unroll
    for (int d0 = 0; d0 < 4; ++d0) qr[d0] = *(const GAS bf16x8*)(qp + d0 * 16);
    const bf16_t* kbase = P + (rowbase + (size_t)T0 * 64) * INW + C_KC + h * 128;
    const bf16_t* vbase = P + (rowbase + (size_t)T0 * 64) * INW + C_VC + h * 128;
    const int c4 = wid >> 1, ks0 = 2 * (wid & 1);
    const int frow = 8 * wid + (lane >> 3);
    const unsigned voffk = (unsigned)(frow * INW + (((lane & 7) ^ ((frow >> 1) & 7)) * 8)) * 2u;
    const unsigned voffv = (unsigned)((16 * ks0 + (lane >> 2)) * INW + c4 * 32 + (lane & 3) * 8) * 2u;
    const unsigned lds0 = (unsigned)(size_t)shm;
    const unsigned d_k1 = lds0 + wid * 1024, d_k2 = lds0 + 8192 + wid * 1024, d_v0 = lds0 + C_VRING + (2 * wid) * 1024, d_v1 = d_v0 + 1024;
#define C_DMA_K(t, slot) do { const bf16_t* _b = kbase + (size_t)(t) * 64 * INW; \
        glds16s(_b, voffk, (unsigned)__builtin_amdgcn_readfirstlane(d_k1 + (slot))); glds16s(_b + 64, voffk, (unsigned)__builtin_amdgcn_readfirstlane(d_k2 + (slot))); } while (0)
#define C_DMA_V(t, slot) do { const bf16_t* _b = vbase + (size_t)(t) * 64 * INW; \
        glds16s(_b, voffv, (unsigned)__builtin_amdgcn_readfirstlane(d_v0 + (slot))); glds16s(_b + 16 * INW, voffv, (unsigned)__builtin_amdgcn_readfirstlane(d_v1 + (slot))); } while (0)
    const lds_cptr shm3 = (lds_cptr)shm;
    const lds_cptr kp0 = shm3 + mp * 8192 + r32 * 128 + ((hi ^ ((r32 >> 1) & 7)) * 16);
#define KXA(base, d0) ((lds_cptr)(size_t)((unsigned)(size_t)(base) ^ (unsigned)((d0) << 5)))
    const lds_cptr vp0 = shm3 + C_VRING + ((lane >> 4) & 1) * 32 + (lane & 3) * 8 + (4 * hi + ((lane & 15) >> 2)) * 64;
    if (C_TILE_SKIP == 1 && wid == 0 && lane == 0) *badw = 0u;
    C_DMA_K(0, 0); C_DMA_V(0, 0); C_DMA_K(1, C_KSLOT);
    float m = 0.f, l_reg = 0.f, fsc = 1.f; bool resc = false, pz = false; (void)pz;
    f32x16 o[4];
#pragma unroll
    for (int c = 0; c < 4; ++c)
#pragma unroll
        for (int r = 0; r < 16; ++r) o[c][r] = 0.f;
    const float qf = (float)(q0 + r32 - 64 * T0);
    f32x16 pA0, pA1, pB0, pB1; bf16x8 kf[8]; u32x4 pw0, pw1, pw2, pw3;
    int sl_prev = 0, sl_cur = 0, sl_next = C_KSLOT;
#define C_ROT() do { sl_prev = sl_cur; sl_cur = sl_next; sl_next = (sl_next == 2 * C_KSLOT) ? 0 : sl_next + C_KSLOT; } while (0)
#define C_RESC() do { if (resc) { _Pragma("unroll") for (int c_ = 0; c_ < 4; ++c_) _Pragma("unroll") for (int r_ = 0; r_ < 16; ++r_) o[c_][r_] *= fsc; } } while (0)
#define C_INIT(X0, X1, tn) do { const float db_ = (float)(64 * (tn) + 4 * hi) - qf; \
        _Pragma("unroll") for (int r_ = 0; r_ < 16; ++r_) { const float c_ = (float)((r_ & 3) + 8 * (r_ >> 2)); \
            X0[r_] = __builtin_fmaf(-__builtin_fabsf(db_ + c_), slope2, -m); X1[r_] = __builtin_fmaf(-__builtin_fabsf(db_ + (32.f + c_)), slope2, -m); } } while (0)
#define C_KLOAD8(kp) do { _Pragma("unroll") for (int j_ = 0; j_ < 8; ++j_) kf[j_] = *(const LAS bf16x8*)(KXA((kp), j_ >> 1) + (j_ & 1) * 4096); } while (0)
    C_DMA_K(2, 2 * C_KSLOT);
    C_INIT(pA0, pA1, 0);
    ATT_WAIT_BAR(6);
    C_KLOAD8(kp0);
#pragma unroll
    for (int i = 0; i < 8; ++i) { if (i & 1) pA1 = ATT_MFMA(kf[i], qr[i >> 1], pA1); else pA0 = ATT_MFMA(kf[i], qr[i >> 1], pA0); }
    { float rm = fmaxf(max16(pA0), max16(pA1)); rm = xmax32(rm);
      if (__any(rm > 8.0f)) { const float dl = fmaxf(rm, 0.f); m += dl;
#pragma unroll
          for (int r = 0; r < 16; ++r) { pA0[r] -= dl; pA1[r] -= dl; } }
#pragma unroll
      for (int r = 0; r < 16; ++r) { pA0[r] = EX2(pA0[r]); pA1[r] = EX2(pA1[r]); } }
    ATT_WAIT_BAR(0);
    C_DMA_K(3, 3 * C_KSLOT); C_DMA_V(1, C_KSLOT);
    C_ROT();
    { const lds_cptr k1_ = kp0 + C_KSLOT; kf[0] = *(const LAS bf16x8*)(k1_); kf[1] = *(const LAS bf16x8*)(k1_ + 4096); }
    C_INIT(pB0, pB1, 1);
    if (wid >= 4) __builtin_amdgcn_s_setprio(1);
    int t = 1;
    for (; t + 5 < NT; t += 2) {
        ATTC_STEP(pB0, pB1, pA0, pA1, t, true, true, true);     ATT_WAIT_BAR(4); C_RESC(); C_ROT();
        ATTC_STEP(pA0, pA1, pB0, pB1, t + 1, true, true, true); ATT_WAIT_BAR(4); C_RESC(); C_ROT();
    }
#define C_ENDW(tt) do { if ((tt) + 3 < NT) { ATT_WAIT_BAR(4); } else if ((tt) + 2 < NT) { ATT_WAIT_BAR(2); } else { ATT_WAIT_BAR(0); } } while (0)
    for (; t + 1 < NT; t += 2) {
        ATTC_STEP(pB0, pB1, pA0, pA1, t, (t + 3 < NT), (t + 1 < NT), (t + 1 < NT));         C_ENDW(t);     C_RESC(); C_ROT();
        ATTC_STEP(pA0, pA1, pB0, pB1, t + 1, (t + 4 < NT), (t + 2 < NT), (t + 2 < NT));     C_ENDW(t + 1); C_RESC(); C_ROT();
    }
    ATTC_STEP(pB0, pB1, pA0, pA1, NT - 1, false, false, false); C_RESC();
    __builtin_amdgcn_s_setprio(0);
    { l_reg += sum16(pB0) + sum16(pB1);
      const bf16x8 q0_ = pack8(pB0, 0), q1_ = pack8(pB0, 1), q2_ = pack8(pB1, 0), q3_ = pack8(pB1, 1);
      const lds_cptr vp = vp0 + sl_cur;
#pragma unroll
      for (int c = 0; c < 4; ++c)
#pragma unroll
          for (int s = 0; s < 4; ++s) {
              const bf16x8 vf = vcat(vtr2(vp + c * 4096 + s * 1024), vtr2(vp + c * 4096 + s * 1024 + 512));
              o[c] = ATT_MFMA(vf, s == 0 ? q0_ : s == 1 ? q1_ : s == 2 ? q2_ : q3_, o[c]);
          } }
    if (C_TILE_SKIP == 1 && NT < SEQ / 64) {
        const int NF = SEQ / 64 - NT;
        ATT_WAIT_BAR(0);
#define C_FAR(i) (((i) < T0) ? (i) - T0 : (i) - T0 + NT)
#define C_DMA_KF(trel, slot) do { const bf16_t* _b = kbase + (ptrdiff_t)(trel) * 64 * INW; \
        glds16s(_b, voffk, (unsigned)__builtin_amdgcn_readfirstlane(d_k1 + (slot))); glds16s(_b + 64, voffk, (unsigned)__builtin_amdgcn_readfirstlane(d_k2 + (slot))); } while (0)
        const int NP = NF >> 1;
        C_DMA_KF(C_FAR(0), 0); C_DMA_KF(C_FAR(1), C_KSLOT);
        if (NP > 1) { C_DMA_KF(C_FAR(2), 2 * C_KSLOT); C_DMA_KF(C_FAR(3), 3 * C_KSLOT); }
        bool badl = false;
        int s0 = 0, s2 = 4 * C_KSLOT;
        for (int p = 0; p < NP; ++p) {
            if (p + 1 < NP) { ATT_WAIT_BAR(4); } else { ATT_WAIT_BAR(0); }
            if (p + 2 < NP) { C_DMA_KF(C_FAR(2 * p + 4), s2); C_DMA_KF(C_FAR(2 * p + 5), s2 + C_KSLOT); }
            f32x16 c[2][2];
#pragma unroll
            for (int u = 0; u < 2; ++u)
#pragma unroll
                for (int r = 0; r < 16; ++r) { c[u][0][r] = 0.f; c[u][1][r] = 0.f; }
#pragma unroll
            for (int j = 0; j < 8; ++j)
#pragma unroll
                for (int u = 0; u < 2; ++u) { const bf16x8 kfj = *(const LAS bf16x8*)(KXA(kp0 + s0 + u * C_KSLOT, j >> 1) + (j & 1) * 4096);
                    c[u][j & 1] = ATT_MFMA(kfj, qr[j >> 1], c[u][j & 1]); }
#pragma unroll
            for (int u = 0; u < 2; ++u) {
                const int trel = C_FAR(2 * p + u);
                const float dmin = (trel < tm) ? (qf - (float)(64 * trel + 63)) : ((float)(64 * trel) - qf);
                badl |= !(fmaxf(max16(c[u][0]), max16(c[u][1])) - slope2 * dmin - m < -150.0f);
            }
            s0 = (s0 == 4 * C_KSLOT) ? 0 : s0 + 2 * C_KSLOT; s2 = (s2 == 4 * C_KSLOT) ? 0 : s2 + 2 * C_KSLOT;
        }
        if (__any(badl) && lane == 0) *badw = 1u;
#undef C_FAR
#undef C_DMA_KF
    }
#undef C_DMA_K
#undef C_DMA_V
#undef C_ROT
#undef C_RESC
#undef C_INIT
#undef C_KLOAD8
#undef KXA
#undef C_ENDW
    float l = xsum32(l_reg);
    const float inv = 1.0f / l;
    ATT_WAIT_BAR(0);
    LAS float* x2 = (LAS float*)shm + rg * 4096;
    if (mp == 1) {
        const float sc = inv * lam;
#pragma unroll
        for (int c = 0; c < 4; ++c)
#pragma unroll
            for (int r = 0; r < 16; ++r) x2[(c * 16 + r) * 64 + lane] = o[c][r] * sc;
    }
    ATT_WAIT_BAR(0);
    if (mp == 0) {
        float ss = 0.f;
#pragma unroll
        for (int c = 0; c < 4; ++c)
#pragma unroll
            for (int r = 0; r < 16; ++r) { const float v = o[c][r] * inv - x2[(c * 16 + r) * 64 + lane]; o[c][r] = v; ss += v * v; }
        ss = xsum32(ss);
        const float rn = post / sqrtf(ss * (1.0f / 128.0f) + RMS_EPS);
        bf16_t* op = MX + (rowbase + q0 + r32) * DM + 512 + h * 128;
#pragma unroll
        for (int c = 0; c < 4; ++c)
#pragma unroll
            for (int g = 0; g < 4; g += 2) { const f32x4 gv0 = *(const GAS f32x4*)(gainv + 32 * c + 8 * g + 4 * hi), gv1 = *(const GAS f32x4*)(gainv + 32 * c + 8 * g + 8 + 4 * hi);
                u32x2 w0, w1;
                w0.x = cvt_pk_bf16(o[c][4 * g + 0] * rn * gv0.x, o[c][4 * g + 1] * rn * gv0.y); w0.y = cvt_pk_bf16(o[c][4 * g + 2] * rn * gv0.z, o[c][4 * g + 3] * rn * gv0.w);
                w1.x = cvt_pk_bf16(o[c][4 * g + 4] * rn * gv1.x, o[c][4 * g + 5] * rn * gv1.y); w1.y = cvt_pk_bf16(o[c][4 * g + 6] * rn * gv1.z, o[c][4 * g + 7] * rn * gv1.w);
                *(GAS u32x4*)(op + 32 * c + 8 * (g + hi)) = pair16(w0, w1); }
    }
    const bool bad = (C_TILE_SKIP == 1) && (*badw != 0u);
    asm volatile("s_waitcnt lgkmcnt(0)\n\ts_barrier" ::: "memory");
    return bad;
}
#undef SBAR
#undef PIN
#undef MX3
#undef EX2
#undef PAF
#undef VRD
#undef VFR
#undef FMAMK

template <int MODE> __device__ __forceinline__ void band_desc(int n, int q0, int& kb, int& ks, int& W) {
    if (MODE == 1) { if (n < 3) { kb = q0 - 1024 + 1024 * n; ks = 16; W = 1024; } else { kb = q0 - 256 + 256 * (n - 3); ks = 4; W = 256; } }
    else if (MODE == 2) { kb = q0 - 64 + 64 * n; ks = 1; W = 64; }
    else { kb = q0 - 128 + 64 * n; ks = 1; W = 128; }
}
constexpr int BK_S = 1056, BV_OFF = 8 * BK_S, BV_S = 4224;
template <int MODE, int NQ>
__device__ __forceinline__ void band_task(const bf16_t* P, size_t rowbase, int kcol, int vcol, int q0, const float (&slope2)[NQ], int qtok,
                                          const bf16_t* const (&qp)[NQ]  , float (&m)[NQ], float (&l)[NQ], f32x16 (&o)[NQ][2], LAS unsigned char* wl, int lane_in) {
    const int lane = lane_id(); (void)lane_in;
    const int r32 = lane & 31, hi = lane >> 5;
    const unsigned kbase_l = (unsigned)(size_t)((lds_cptr)wl + r32 * 128 + ((hi ^ ((r32 >> 1) & 7)) * 16));
    const lds_cptr vp = (lds_cptr)wl + BV_OFF + ((lane >> 4) & 1) * 32 + (lane & 3) * 8 + (4 * hi + ((lane & 15) >> 2)) * 64;
    const unsigned ldsk = (unsigned)(size_t)wl;
    const float qf = (float)qtok;
    constexpr int NTL = MODE == 1 ? 7 : (MODE == 2 ? 3 : 5);
    unsigned mask = 0u;
#pragma unroll
    for (int n = 0; n < NTL; ++n) { int kb, ks, W; band_desc<MODE>(n, q0, kb, ks, W); if (!(kb + ks * 63 < 0 || kb >= SEQ)) mask |= 1u << n; }
    if (!mask) return;
    u32x4 vr[8];
    const int lrow = lane >> 3, lch = lane & 7;
    LAS unsigned char* vw = wl + BV_OFF + (lch >> 2) * BV_S + lrow * 64 + (lch & 3) * 16;
    const bf16_t* kgb = P + rowbase * INW + kcol; const char* vgb = (const char*)(P + rowbase * INW + vcol);
#define BAND_DMAK(n_) do { int kb_, ks_, W_; band_desc<MODE>((n_), q0, kb_, ks_, W_); \
        _Pragma("unroll") for (int i = 0; i < 8; ++i) { const int row_ = lrow + 8 * i; int kt = kb_ + ks_ * row_; kt = kt < 0 ? 0 : (kt > SEQ - 1 ? SEQ - 1 : kt); \
            glds16s(kgb, (unsigned)(kt * INW + ((lch ^ ((row_ >> 1) & 7)) * 8)) * 2u, (unsigned)__builtin_amdgcn_readfirstlane(ldsk + i * 1024)); } } while (0)
#define BAND_LOADV(n_) do { int kb_, ks_, W_; band_desc<MODE>((n_), q0, kb_, ks_, W_); \
        _Pragma("unroll") for (int i = 0; i < 8; ++i) { int kt = kb_ + ks_ * (lrow + 8 * i); kt = kt < 0 ? 0 : (kt > SEQ - 1 ? SEQ - 1 : kt); \
            vr[i] = *(const GAS u32x4*)(vgb + (unsigned)((kt * INW + lch * 8) * 2)); } } while (0)
    bf16x8 qr[4];
    if (NQ == 1) {
#pragma unroll
        for (int d0 = 0; d0 < 4; ++d0) qr[d0] = *(const GAS bf16x8*)(qp[0] + d0 * 16); }
    LDS_WAIT();
    { const int n0 = __builtin_ctz(mask); BAND_DMAK(n0); BAND_LOADV(n0); }
    while (mask) {
        const int n = __builtin_ctz(mask); mask &= mask - 1u;
        const int nn = mask ? __builtin_ctz(mask) : -1;
        int kb, ks, W; band_desc<MODE>(n, q0, kb, ks, W);
        float ksf = (float)ks; asm volatile("" : "+v"(ksf));
        const float dlo = fmaxf(-qf, -(float)W), dhi = fminf((float)W, (float)(SEQ - 1) - qf);
        VM_WAIT();
#pragma unroll
        for (int i = 0; i < 8; ++i) *(LAS u32x4*)(vw + i * 512) = vr[i];
        if (nn >= 0) BAND_LOADV(nn);
        const float dbase = (float)kb - qf + ksf * (float)(4 * hi);
#pragma unroll
        for (int qi = 0; qi < NQ; ++qi) {
            if (NQ > 1) {
#pragma unroll
                for (int d0 = 0; d0 < 4; ++d0) qr[d0] = *(const GAS bf16x8*)(qp[qi] + d0 * 16); }
            f32x16 p0, p1;
#pragma unroll
            for (int r = 0; r < 16; ++r) { p0[r] = 0.f; p1[r] = 0.f; }
#pragma unroll
            for (int d0 = 0; d0 < 4; ++d0) { const lds_cptr ka_ = (lds_cptr)(size_t)(kbase_l ^ (unsigned)(d0 << 5));
                const bf16x8 a0 = *(const LAS bf16x8*)(ka_), a1 = *(const LAS bf16x8*)(ka_ + 4096);
                p0 = ATT_MFMA(a0, qr[d0], p0); p1 = ATT_MFMA(a1, qr[d0], p1);
            }
            if (qi == NQ - 1 && nn >= 0) { LDS_WAIT(); BAND_DMAK(nn); }
#pragma unroll
            for (int r = 0; r < 16; ++r) { const float c = (float)((r & 3) + 8 * (r >> 2));
                const float d0 = __builtin_fmaf(ksf, c, dbase), d1 = __builtin_fmaf(ksf, 32.f + c, dbase);
                p0[r] = (d0 >= dlo && d0 <= dhi) ? __builtin_fmaf(-__builtin_fabsf(d0), slope2[qi], p0[r]) : -INFINITY;
                p1[r] = (d1 >= dlo && d1 <= dhi) ? __builtin_fmaf(-__builtin_fabsf(d1), slope2[qi], p1[r]) : -INFINITY; }
            float mx = fmaxf(max16(p0), max16(p1));
            mx = xmax32(mx);
            if (__any(mx > m[qi] + 8.0f)) {
                const float mn = fmaxf(m[qi], mx), f = __builtin_amdgcn_exp2f(m[qi] - mn);
                l[qi] *= f; m[qi] = mn;
#pragma unroll
                for (int c = 0; c < 2; ++c)
#pragma unroll
                    for (int r = 0; r < 16; ++r) o[qi][c][r] *= f;
            }
#pragma unroll
            for (int r = 0; r < 16; ++r) { p0[r] = __builtin_amdgcn_exp2f(p0[r] - m[qi]); p1[r] = __builtin_amdgcn_exp2f(p1[r] - m[qi]); }
            l[qi] += sum16(p0) + sum16(p1);
            bf16x8 pw[4]; pw[0] = pack8(p0, 0); pw[1] = pack8(p0, 1); pw[2] = pack8(p1, 0); pw[3] = pack8(p1, 1);
#pragma unroll
            for (int c = 0; c < 2; ++c)
#pragma unroll
                for (int s = 0; s < 4; ++s) {
                    const bf16x8 vf = vcat(vtr2(vp + c * BV_S + s * 1024), vtr2(vp + c * BV_S + s * 1024 + 512));
                    o[qi][c] = ATT_MFMA(vf, pw[s], o[qi][c]);
                }
        }
    }
#undef BAND_DMAK
#undef BAND_LOADV
}
__device__ __forceinline__ void band_store(bf16_t* op  , int hi, const f32x16 (&o)[2], float inv) {
#pragma unroll
    for (int c = 0; c < 2; ++c)
#pragma unroll
        for (int g = 0; g < 4; g += 2) { u32x2 w0, w1;
            w0.x = cvt_pk_bf16(o[c][4 * g + 0] * inv, o[c][4 * g + 1] * inv); w0.y = cvt_pk_bf16(o[c][4 * g + 2] * inv, o[c][4 * g + 3] * inv);
            w1.x = cvt_pk_bf16(o[c][4 * g + 4] * inv, o[c][4 * g + 5] * inv); w1.y = cvt_pk_bf16(o[c][4 * g + 6] * inv, o[c][4 * g + 7] * inv);
            *(GAS u32x4*)(op + 32 * c + 8 * (g + hi)) = pair16(w0, w1); }
}
}

template <int DAB, int DC>
__device__ __forceinline__ void p3_attention(Frame& F, int L) {
    const int lane = F.lane, r32 = lane & 31, hi = lane >> 5, wid = F.wave;
    LAS unsigned char* wl = F.lds + wid * BAND_WL;
    for (int rep = 0; rep < DAB; ++rep) {
    for (int bt = F.vcu; bt < NBATCH * 4 * 16; bt += F.G) {
        const int b = bt >> 6, h = (bt >> 4) & 3, blk = bt & 15;
        const float sl1[1] = {__builtin_amdgcn_exp2f(-2.0f * (float)(h + 1)) * LOG2E};
        const size_t rowbase = (size_t)b * SEQ;
        for (int rr = 0; rr < 2; ++rr) {
            const int lane = lane_id(), r32 = lane & 31, hi = lane >> 5;
            const int q0 = blk * 512 + rr * 8 + wid, qtok = q0 + 16 * r32;
            const bf16_t* const qp[1] = {F.PROJ + (rowbase + qtok) * INW + C_QA + h * 64 + hi * 8};
            float m[1] = {-1e30f}, l[1] = {0.f}; f32x16 o[1][2];
#pragma unroll
            for (int c = 0; c < 2; ++c)
#pragma unroll
                for (int r = 0; r < 16; ++r) o[0][c][r] = 0.f;
            att::band_task<1, 1>(F.PROJ, rowbase, C_KA + h * 64, C_VA + h * 64, q0, sl1, qtok, qp, m, l, o, wl, lane);
            float* pp = F.part + ((rowbase + qtok) * 4 + h) * 68;
#pragma unroll
            for (int c = 0; c < 2; ++c)
#pragma unroll
                for (int g = 0; g < 4; ++g) *(GAS f32x4*)(pp + 32 * c + 8 * g + 4 * hi) = (f32x4){o[0][c][4 * g], o[0][c][4 * g + 1], o[0][c][4 * g + 2], o[0][c][4 * g + 3]};
            if (hi == 0) pp[64] = m[0];
            pp[65 + hi] = l[0];
        }
        VM_WAIT(); __syncthreads(); __builtin_amdgcn_fence(__ATOMIC_ACQUIRE, "agent"); VM_WAIT();
        for (int rr = 0; rr < 2; ++rr) {
            const int lane = lane_id(), r32 = lane & 31, hi = lane >> 5;
            const int q0 = blk * 512 + (rr * 8 + wid) * 32, qtok = q0 + r32;
            const bf16_t* const qp[1] = {F.PROJ + (rowbase + qtok) * INW + C_QA + h * 64 + hi * 8};
            const float* pp = F.part + ((rowbase + qtok) * 4 + h) * 68;
            f32x16 o[1][2];
#pragma unroll
            for (int c = 0; c < 2; ++c)
#pragma unroll
                for (int g = 0; g < 4; ++g) { const f32x4 t = *(const GAS f32x4*)(pp + 32 * c + 8 * g + 4 * hi); o[0][c][4 * g] = t[0]; o[0][c][4 * g + 1] = t[1]; o[0][c][4 * g + 2] = t[2]; o[0][c][4 * g + 3] = t[3]; }
            float m[1] = {pp[64]}, l[1] = {pp[65 + hi]};
            att::band_task<2, 1>(F.PROJ, rowbase, C_KA + h * 64, C_VA + h * 64, q0, sl1, qtok, qp, m, l, o, wl, lane);
            att::band_store(F.MIXED + (rowbase + qtok) * DM + h * 64, hi, o[0], 1.0f / att::xsum32(l[0]));
        }
        __syncthreads();
    }
    for (int bt = F.vcu; bt < NBATCH * 2 * 32; bt += F.G) {
        const int b = bt >> 6, hk = (bt >> 5) & 1, blk = bt & 31;
        const size_t rowbase = (size_t)b * SEQ;
        const int lane = lane_id(), r32 = lane & 31, hi = lane >> 5;
        const int q0 = blk * 256 + wid * 32, qtok = q0 + r32;
        float sl2[2], m[2], l[2]; f32x16 o[2][2];
        const bf16_t* const qp[2] = {F.PROJ + (rowbase + qtok) * INW + C_QB + (2 * hk) * 64 + hi * 8, F.PROJ + (rowbase + qtok) * INW + C_QB + (2 * hk + 1) * 64 + hi * 8};
#pragma unroll
        for (int g = 0; g < 2; ++g) { const int hq = 2 * hk + g;
            sl2[g] = __builtin_amdgcn_exp2f(-2.0f * (float)(hq + 1)) * LOG2E;
            m[g] = F.sinks[L * 4 + hq] * LOG2E; l[g] = 0.5f;
#pragma unroll
            for (int c = 0; c < 2; ++c)
#pragma unroll
                for (int r = 0; r < 16; ++r) o[g][c][r] = 0.f; }
        att::band_task<0, 2>(F.PROJ, rowbase, C_KB + hk * 64, C_VB + hk * 64, q0, sl2, qtok, qp, m, l, o, wl, lane);
#pragma unroll
        for (int g = 0; g < 2; ++g) att::band_store(F.MIXED + (rowbase + qtok) * DM + 256 + (2 * hk + g) * 64, hi, o[g], 1.0f / att::xsum32(l[g]));
    }
    }
    VM_WAIT(); LDS_WAIT();
    __syncthreads();
    {
        float lam_init = 0.8f - 0.6f * __expf(-0.3f * (float)L);
        const float s1 = wave_sum(F.lq1[L * 64 + lane] * F.lk1[L * 64 + lane]), s2 = wave_sum(F.lq2[L * 64 + lane] * F.lk2[L * 64 + lane]);
        const float lam = __expf(s1) - __expf(s2) + lam_init;
        for (int rep = 0; rep < DC; ++rep)
        for (int uid = F.vcu; uid < 2048; uid += F.G) {
            const int i = uid >> 8, v = uid & 255, bh = 4 * (v >> 5) + (i >> 1), qb = (i & 1) * 32 + (v & 31), b = bh >> 2, h = bh & 3;
            const float slope2 = __builtin_amdgcn_exp2f(-2.0f * (float)(h + 1)) * LOG2E;
            int T0 = 0, NT = SEQ / 64;
            if (C_TILE_SKIP) {
                const unsigned* nq = (const unsigned*)(F.ctl + CW_NRM + L * 256) + (b * 2 + 0) * 16 + h * 4; const unsigned* nk = nq + 16;
                float R2 = 0.f;
#pragma unroll
                for (int c = 0; c < 2; ++c) R2 = fmaxf(R2, sqrtf(__uint_as_float(nq[c * 2]) * __uint_as_float(nk[c * 2])) + sqrtf(__uint_as_float(nq[c * 2 + 1]) * __uint_as_float(nk[c * 2 + 1])));
                const float Dstar = (C_TILE_SKIP == 1) ? (150.0f + 8.0f + 0.4f * R2) / slope2
                                                       : (120.0f * LOG2E + 2.0f * 1.02f * R2) / slope2;
                if (Dstar < 16384.f) {
                    const int D = (int)Dstar + 1, qlo = qb * 128, qhi = qb * 128 + 127;
                    int tlo = (qlo - D - 63 + 63) / 64; if (qlo - D - 63 <= 0) tlo = 0;
                    int thi = (qhi + D) / 64; if (thi > SEQ / 64 - 1) thi = SEQ / 64 - 1;
                    if (((thi - tlo + 1) & 1) != 0) { if (tlo > 0) --tlo; else ++thi; }
                    if (thi > SEQ / 64 - 1) { thi = SEQ / 64 - 1; if (((thi - tlo + 1) & 1) != 0) --tlo; }
                    if (thi - tlo + 1 >= 4 && tlo >= 0) { T0 = tlo; NT = thi - tlo + 1; }
                }
            }
            volatile LAS unsigned* badw = (volatile LAS unsigned*)(F.misc + MO_HIST);
            const bool bad = att::attnC_unit(F.PROJ, F.MIXED, F.subln + L * 128, b, h, qb, slope2, lam, 1.0f - lam_init, F.lds, wid, lane, T0, NT, badw);
            if (bad) (void)att::attnC_unit(F.PROJ, F.MIXED, F.subln + L * 128, b, h, qb, slope2, lam, 1.0f - lam_init, F.lds, wid, lane, 0, SEQ / 64, badw);
        }
    }
}

struct Args { const float* in[23]; float* out; unsigned char* ws; };
typedef const __attribute__((address_space(4))) Args* kargs_t;
__device__ __forceinline__ void refresh(Frame& F) {
    kargs_t ap = (kargs_t)__builtin_amdgcn_kernarg_segment_ptr(); asm volatile("" : "+s"(ap));
    int w = F.wave0; asm volatile("" : "+s"(w)); int l = lane_id(); asm volatile("" : "+v"(l));
    F.tid = w * 64 + l; F.lane = l; F.wave = w;
    unsigned char* ws = ap->ws;
    F.ctl = (gu32*)(ws + WS_CTL);
    F.x_in = ap->in[0]; F.c_in = ap->in[1]; F.w_ada = ap->in[2]; F.b_ada = ap->in[3]; F.norm1 = ap->in[4]; F.w_in = ap->in[5]; F.sinks = ap->in[6];
    F.lq1 = ap->in[7]; F.lk1 = ap->in[8]; F.lq2 = ap->in[9]; F.lk2 = ap->in[10]; F.subln = ap->in[11]; F.w_out = ap->in[12]; F.norm2 = ap->in[13];
    F.w_router = ap->in[14]; F.b_router = ap->in[15]; F.w_gate = ap->in[16]; F.b_gate = ap->in[17]; F.w_up = ap->in[18]; F.b_up = ap->in[19];
    F.w_down = ap->in[20]; F.b_down = ap->in[21]; F.norm_f = ap->in[22]; F.out = ap->out;
    F.modp = (float*)(ws + WS_MODP); F.mod = (float*)(ws + WS_MOD); F.ltok = (int*)(ws + WS_LTOK); F.lg = (float*)(ws + WS_LG);
    F.WIN = (bf16_t*)(ws + WS_WIN); F.WOUT = (bf16_t*)(ws + WS_WOUT); F.WGU = (bf16_t*)(ws + WS_WGU); F.WDN = (bf16_t*)(ws + WS_WDN);
    F.H = (bf16_t*)(ws + WS_H); F.PROJ = (bf16_t*)(ws + WS_R1); F.MIXED = (bf16_t*)(ws + WS_MIXED); F.HIDDEN = (bf16_t*)(ws + WS_R1); F.Y = (bf16_t*)(ws + WS_Y); F.XB = (bf16_t*)(ws + WS_XB); F.part = (float*)(ws + WS_PART); F.inv = (int*)(ws + WS_INV);
}
__global__ void __launch_bounds__(NTHREADS, 2) fwd_kernel(Args args) {
    extern __shared__ __attribute__((aligned(16))) unsigned char lds[];
    Frame F;
    F.lds = (LAS unsigned char*)lds; F.misc = F.lds + MISC_OFF;
    F.wave0 = __builtin_amdgcn_readfirstlane((int)threadIdx.x >> 6);
    F.G = gridDim.x; { const int bx = blockIdx.x; F.vcu = (F.G % 8 == 0) ? (bx % 8) * (F.G / 8) + bx / 8 : bx; }
    refresh(F);
    for (int u = F.tid; u < 256; u += NTHREADS) ((LAS unsigned*)F.misc)[u] = 0u;
    __syncthreads();
    XcdBarrier bar = xcd_barrier_post((unsigned*)(F.ctl + CW_BAR), (volatile LAS unsigned*)(F.misc + MO_BAR));
    (void)bar;
#define GRID_BAR() do { kargs_t ap_ = (kargs_t)__builtin_amdgcn_kernarg_segment_ptr(); asm volatile("" : "+s"(ap_)); XcdBarrier b_; \
        b_.bar = (unsigned*)(ap_->ws + WS_CTL) + CW_BAR; b_.x = xb_xcc_id(); b_.st = (volatile LAS unsigned*)(F.misc + MO_BAR); xcd_barrier(b_); } while (0)

#ifndef PH_MASK
#define PH_MASK 0xffff
#endif
#define PH(k) ((PH_MASK >> (k)) & 1)
#ifndef DUP_MASK
#define DUP_MASK 0
#endif
#define DUP(k) (1 + ((DUP_MASK >> (k)) & 1))
    if (PH(0)) { for (int rep = 0; rep < DUP(0); ++rep) { p0_prologue(F); __syncthreads(); } GRID_BAR();
    refresh(F); p0b_modsum(F); GRID_BAR(); }
    for (int L = 0; L < DEPTH; ++L) {
        refresh(F);
        if (PH(1)) { if (L == 0) p1_rows<0>(F, L); else p1_rows<1>(F, L); if (DUP(6) > 1) { __syncthreads(); if (L == 0) p1_rows<0>(F, L); else p1_rows<1>(F, L, 0.0f); } }
        const bool own_panels = false;
        if (own_panels) { VM_WAIT(); __syncthreads(); __builtin_amdgcn_fence(__ATOMIC_ACQUIRE, "agent"); VM_WAIT(); } else { GRID_BAR(); }
        refresh(F);
        if (PH(2)) for (int rep = 0; rep < DUP(1); ++rep) { pg8::Gemm g{F.H, F.WIN + (size_t)L * INW * DM, DM}; EpiProj E{F.PROJ, (unsigned*)(F.ctl + CW_NRM + L * 256)};
          if (own_panels) { pg8::PanelOrder S{INW / 256, NTOK / 256, F.G, F.vcu}; pg8::gemm_phase<EpiProj, pg8::PanelOrder, false>(F.lds, g, S, E, F.wave); }
          else { pg8::StaticOrder S; S.init(NTOK, INW, F.G, (int)blockIdx.x); pg8::gemm_phase<EpiProj, pg8::StaticOrder, false>(F.lds, g, S, E, F.wave); } }
        GRID_BAR();
        refresh(F);
        if (PH(3)) p3_attention<DUP(2), DUP(3)>(F, L);
        GRID_BAR();
        refresh(F);
        const bool own_panels4 = (F.G == NTOK / 256);
        if (PH(4)) for (int rep = 0; rep < DUP(7); ++rep) { pg8::Gemm g{F.MIXED, F.WOUT + (size_t)L * DM * DM, DM}; EpiOut E{F.XB, F.mod + (size_t)L * NBATCH * 6144 + 2 * DM, rep ? 0.0f : 1.0f};
          if (own_panels4) { pg8::PanelOrder S{DM / 256, NTOK / 256, F.G, F.vcu}; pg8::gemm_phase<EpiOut, pg8::PanelOrder, false>(F.lds, g, S, E, F.wave); }
          else { pg8::StaticOrder S; S.init(NTOK, DM, F.G, (int)blockIdx.x); pg8::gemm_phase<EpiOut, pg8::StaticOrder, false>(F.lds, g, S, E, F.wave); } }
        if (own_panels4) { VM_WAIT(); __syncthreads(); __builtin_amdgcn_fence(__ATOMIC_ACQUIRE, "agent"); VM_WAIT(); } else { GRID_BAR(); }
        refresh(F);
        if (PH(5)) { p5_route(F, L, L); if (DUP(8) > 1) { __syncthreads(); p5_route(F, L, L + 4); } }
        GRID_BAR();
        refresh(F);
        moe_table(F, L);
        if (PH(7)) for (int rep = 0; rep < DUP(4); ++rep) { const LAS int* tab = (const LAS int*)(F.misc + MO_TAB);
          pg8::Gemm g{F.H, (const bf16_t*)((const unsigned char*)F.WGU + (size_t)L * NE * 2048 * DM), DM / 2}; MoeSched S{tab, 3, tab[96], F.G, F.vcu, F.ltok};
          EpiGU E{(unsigned char*)F.HIDDEN, F.b_gate + (size_t)L * NE * DM, F.b_up + (size_t)L * NE * DM};
          pg8::gemm_phase<EpiGU, MoeSched, true, true>(F.lds, g, S, E, F.wave); }
        GRID_BAR();
        refresh(F);
        if (PH(8)) for (int rep = 0; rep < DUP(5); ++rep) { const LAS int* tab = (const LAS int*)(F.misc + MO_TAB);
          pg8::Gemm g{F.HIDDEN, (const bf16_t*)((const unsigned char*)F.WDN + (size_t)L * NE * DM * DM), DM / 2}; MoeSched S{tab, 2, tab[96], F.G, F.vcu, F.ltok};
          EpiDown E{(unsigned char*)F.Y, F.b_down + (size_t)L * NE * DM, tab, F.lg, F.misc + EPI_STG};
          pg8::gemm_phase<EpiDown, MoeSched, false, true>(F.lds, g, S, E, F.wave); }
        GRID_BAR();
    }
    refresh(F);
    if (PH(9)) p1_rows<2>(F, DEPTH);
}

extern "C" void kernel_launch(void* const* d_in, const int* in_sizes, int n_in, void* d_out, int out_size, void* d_ws, size_t ws_size, hipStream_t stream) {
    static int grid = 0;
    if (grid == 0) {
        if (n_in != 23 || in_sizes[0] != NTOK * DM || out_size != NTOK * DM || ws_size < WS_END) {
            fprintf(stderr, "kernel_launch: unexpected shapes/workspace: n_in %d in0 %d out %d ws %zu (need %zu); nothing launched\n", n_in, n_in > 0 ? in_sizes[0] : -1, out_size, ws_size, (size_t)WS_END); grid = -1; return; }
        int dev = 0, cus = 0, per_cu = 0;
        if (hipGetDevice(&dev) != hipSuccess || hipDeviceGetAttribute(&cus, hipDeviceAttributeMultiprocessorCount, dev) != hipSuccess) { grid = -1; return; }
        if (hipFuncSetAttribute((const void*)fwd_kernel, hipFuncAttributeMaxDynamicSharedMemorySize, LDS_BYTES) != hipSuccess) { fprintf(stderr, "kernel_launch: hipFuncSetAttribute failed\n"); grid = -1; return; }
        if (hipOccupancyMaxActiveBlocksPerMultiprocessor(&per_cu, (const void*)fwd_kernel, NTHREADS, LDS_BYTES) != hipSuccess || per_cu < 1)
            fprintf(stderr, "kernel_launch: note: occupancy query reports %d workgroups per CU\n", per_cu);
        (void)hipGetLastError();
        grid = cus;
    }
    if (grid < 0) return;
    if (hipMemsetAsync((char*)d_ws + WS_CTL, 0, CTL_ZERO_BYTES, stream) != hipSuccess) return;
    Args a{};
    for (int i = 0; i < 23; ++i) a.in[i] = (const float*)d_in[i];
    a.out = (float*)d_out; a.ws = (unsigned char*)d_ws;
    hipLaunchKernelGGL(fwd_kernel, dim3(grid), dim3(NTHREADS), LDS_BYTES, stream, a);
}
```
